# Optimizing an MI355X kernel written in HIP

```python
import jax, jax.numpy as jnp
from jax import lax
import numpy as np

D_MODEL = 1024
BATCH = 8
SEQ = 4096
DEPTH = 4

GRID_W = 64
CTX_LEN = 256
EPS = 1e-6

FNET_GROUPS = 4
FNET_GROUP_DIM = 128
FNET_WIDTH = FNET_GROUPS * FNET_GROUP_DIM
HG_HEADS = 4
HG_DK = 128
HG_DV = 128
HG_KW = HG_HEADS * HG_DK
HG_VW = HG_HEADS * HG_DV
HG_CHUNK = 64
AB_SPLITS = [FNET_WIDTH, FNET_WIDTH + HG_KW, FNET_WIDTH + 2 * HG_KW, FNET_WIDTH + 3 * HG_KW,
             FNET_WIDTH + 3 * HG_KW + HG_VW]
AB_IN = FNET_WIDTH + 3 * HG_KW + 2 * HG_VW
AB_OUT = FNET_WIDTH + HG_VW
ATT_HEADS = 8
ATT_KV_HEADS = 2
ATT_GROUP = ATT_HEADS // ATT_KV_HEADS
HEAD_DIM = 128
ATT_WIDTH = ATT_HEADS * HEAD_DIM
ATT_KV_WIDTH = ATT_KV_HEADS * HEAD_DIM
ATT_IN = ATT_WIDTH + 2 * ATT_KV_WIDTH
Q_BLOCK = 128
ROPE_THETA = 10000.0
D_FF = 2816
CONV_K = 3

N_EVEN = (DEPTH + 1) // 2
N_ODD = DEPTH // 2

kernel_name = "hybrid_fourier_hgrn2_gqa_prefix_dit"


def rms_norm(x, gain=None):
    x32 = x.astype(jnp.float32)
    y = x32 * lax.rsqrt(jnp.mean(x32 * x32, axis=-1, keepdims=True) + EPS)
    if gain is not None:
        y = y * gain.astype(jnp.float32)
    return y.astype(x.dtype)


def modulate(x, shift, scale):
    return rms_norm(x) * (1 + scale) + shift


def modulation(cond, w_mod, b_mod):
    m = jax.nn.silu(cond) @ w_mod + b_mod
    return jnp.split(m, 6, axis=-1)


def axial_rope(x):
    L = x.shape[1]
    t = jnp.arange(L)
    row = (t // GRID_W).astype(jnp.float32)
    col = (t % GRID_W).astype(jnp.float32)
    n_freq = HEAD_DIM // 4
    freqs = ROPE_THETA ** (-jnp.arange(n_freq, dtype=jnp.float32) / n_freq)
    ang = jnp.concatenate([row[:, None] * freqs, col[:, None] * freqs], axis=-1)
    cos = jnp.cos(ang)[None, :, None, :]
    sin = jnp.sin(ang)[None, :, None, :]
    xp = x.astype(jnp.float32).reshape(*x.shape[:-1], HEAD_DIM // 2, 2)
    x0, x1 = xp[..., 0], xp[..., 1]
    out = jnp.stack([x0 * cos - x1 * sin, x0 * sin + x1 * cos], axis=-1).reshape(x.shape)
    return out.astype(x.dtype)


def block_attention(q, k, v):
    B, Lq = q.shape[:2]
    nb = Lq // Q_BLOCK
    qb = q.reshape(B, nb, Q_BLOCK, ATT_KV_HEADS, ATT_GROUP, HEAD_DIM).transpose(1, 0, 2, 3, 4, 5)
    scale = HEAD_DIM ** -0.5

    def one_block(qi):
        s = jnp.einsum('bqhgd,bkhd->bhgqk', qi, k, preferred_element_type=jnp.float32) * scale
        p = jax.nn.softmax(s, axis=-1)
        return jnp.einsum('bhgqk,bkhd->bqhgd', p.astype(v.dtype), v)

    o = lax.map(one_block, qb)
    return o.transpose(1, 0, 2, 3, 4, 5).reshape(B, Lq, ATT_WIDTH)


def gla_chunk_scan(q, k, v, log_f, s0):
    B, L, H, _ = q.shape
    DV = v.shape[-1]
    n = L // HG_CHUNK

    def to_chunks(t):
        return t.reshape(B, n, HG_CHUNK, H, t.shape[-1]).transpose(1, 0, 3, 2, 4)

    lower = jnp.tril(jnp.ones((HG_CHUNK, HG_CHUNK), dtype=bool))[None, None, :, :, None]

    def step(S, inp):
        qc, kc, vc, lfc = inp
        b = jnp.cumsum(lfc, axis=2)
        inter = jnp.einsum('bhtk,bhkv->bhtv', qc * jnp.exp(b), S)
        rel = jnp.where(lower, b[:, :, :, None, :] - b[:, :, None, :, :], -jnp.inf)
        att = jnp.einsum('bhtk,bhtsk,bhsk->bhts', qc, jnp.exp(rel), kc)
        o = inter + jnp.einsum('bhts,bhsv->bhtv', att, vc)
        b_last = b[:, :, -1:, :]
        S = jnp.exp(b_last[:, :, 0, :, None]) * S + jnp.einsum('bhsk,bhsv->bhkv', kc * jnp.exp(b_last - b), vc)
        return S, o

    S, o = lax.scan(step, s0, (to_chunks(q), to_chunks(k), to_chunks(v), to_chunks(log_f)))
    return o.transpose(1, 0, 3, 2, 4).reshape(B, L, H, DV), S


def fourier_mix(a):
    B, L, _ = a.shape
    ag = a.astype(jnp.float32).reshape(B, L, FNET_GROUPS, FNET_GROUP_DIM)
    y = jnp.fft.fft2(ag, axes=(1, 3), norm='ortho').real
    return y.reshape(B, L, FNET_WIDTH).astype(a.dtype)


def fourier_hgrn_mixer(h_lat, h_ctx, w_in, w_out, lb, gn_gain, need_ctx):
    B = h_lat.shape[0]

    def parts(h):
        p = h @ w_in
        a, q, zf0, zf1, i, g = jnp.split(p, AB_SPLITS, axis=-1)
        heads = lambda t, d: t.reshape(*t.shape[:2], HG_HEADS, d).astype(jnp.float32)
        return a, heads(jax.nn.silu(q), HG_DK), (heads(zf0, HG_DK), heads(zf1, HG_DK)), heads(i, HG_DV), g

    a_l, q_l, zf_l, v_l, g_l = parts(h_lat)
    a_c, q_c, zf_c, v_c, g_c = parts(h_ctx)

    def forget(z, lb_d):
        f = lb_d + (1.0 - lb_d) * jax.nn.sigmoid(z)
        return jnp.log(f), 1.0 - f

    outs_l, outs_c = [], []
    for d in range(2):
        lb_d = lb[d].reshape(HG_HEADS, HG_DK).astype(jnp.float32)
        lf_l, k_l = forget(zf_l[d], lb_d)
        lf_c, k_c = forget(zf_c[d], lb_d)
        seq_c = [q_c, k_c, v_c, lf_c]
        seq_l = [q_l, k_l, v_l, lf_l]
        if d == 1:
            seq_c = [jnp.flip(t, axis=1) for t in seq_c]
            seq_l = [jnp.flip(t, axis=1) for t in seq_l]
        s0 = jnp.zeros((B, HG_HEADS, HG_DK, HG_DV), jnp.float32)
        oc, s_ctx = gla_chunk_scan(*seq_c, s0)
        ol, _ = gla_chunk_scan(*seq_l, s_ctx)
        if d == 1:
            oc, ol = jnp.flip(oc, axis=1), jnp.flip(ol, axis=1)
        outs_c.append(oc)
        outs_l.append(ol)

    def gated_out(o, g):
        o = rms_norm(o, gn_gain.reshape(HG_HEADS, HG_DV))
        return (o.reshape(*o.shape[:2], HG_VW) * jax.nn.silu(g.astype(jnp.float32))).astype(g.dtype)

    y_lat = jnp.concatenate([fourier_mix(a_l), gated_out(outs_l[0] + outs_l[1], g_l)], axis=-1) @ w_out
    y_ctx = None
    if need_ctx:
        y_ctx = jnp.concatenate([fourier_mix(a_c), gated_out(outs_c[0] + outs_c[1], g_c)], axis=-1) @ w_out
    return y_lat, y_ctx


def attention_mixer(h_lat, h_ctx, w_qkv, qn_g, kn_g, w_out, need_ctx):
    def qkv(h, rope):
        B, L, _ = h.shape
        p = h @ w_qkv
        q, k, v = jnp.split(p, [ATT_WIDTH, ATT_WIDTH + ATT_KV_WIDTH], axis=-1)
        q = rms_norm(q.reshape(B, L, ATT_HEADS, HEAD_DIM), qn_g)
        k = rms_norm(k.reshape(B, L, ATT_KV_HEADS, HEAD_DIM), kn_g)
        v = v.reshape(B, L, ATT_KV_HEADS, HEAD_DIM)
        if rope:
            q, k = axial_rope(q), axial_rope(k)
        return q, k, v

    q_l, k_l, v_l = qkv(h_lat, True)
    q_c, k_c, v_c = qkv(h_ctx, False)
    o_l = block_attention(q_l, jnp.concatenate([k_l, k_c], axis=1), jnp.concatenate([v_l, v_c], axis=1))
    y_lat = o_l @ w_out
    y_ctx = None
    if need_ctx:
        y_ctx = block_attention(q_c, k_c, v_c) @ w_out
    return y_lat, y_ctx


def conv_ffn(h, w_up, conv_w, conv_b, w_down, on_grid):
    B, L, _ = h.shape
    gate, val = jnp.split(h @ w_up, [D_FF], axis=-1)
    w = conv_w.astype(h.dtype)
    if on_grid:
        rows = L // GRID_W
        g2 = gate.reshape(B, rows, GRID_W, D_FF)
        conv = lax.conv_general_dilated(g2, w[:, :, None, :], (1, 1), 'SAME',
                                        dimension_numbers=('NHWC', 'HWIO', 'NHWC'),
                                        feature_group_count=D_FF).reshape(B, L, D_FF)
    else:
        conv = lax.conv_general_dilated(gate, w[CONV_K // 2][:, None, :], (1,), 'SAME',
                                        dimension_numbers=('NWC', 'WIO', 'NWC'),
                                        feature_group_count=D_FF)
    act = jax.nn.silu(conv + conv_b.astype(h.dtype)) * val
    return act @ w_down


def setup_inputs(seed: int = 0) -> dict:
    key = jax.random.key(seed)
    ks = jax.random.split(key, 20)
    nrm = lambda k, shape, scale: jax.random.normal(k, shape, jnp.float32) * scale
    return {
        "x": nrm(ks[0], (BATCH, SEQ, D_MODEL), 1.0),
        "c": nrm(ks[1], (BATCH, D_MODEL), 1.0),
        "ctx": nrm(ks[2], (BATCH, CTX_LEN, D_MODEL), 1.0),
        "c_ctx": nrm(ks[3], (D_MODEL,), 1.0),
        "w_mod": nrm(ks[4], (DEPTH, D_MODEL, 6 * D_MODEL), D_MODEL ** -0.5),
        "b_mod": nrm(ks[5], (DEPTH, 6 * D_MODEL), 0.01),
        "w_in_ab": nrm(ks[6], (N_EVEN, D_MODEL, AB_IN), D_MODEL ** -0.5),
        "w_out_ab": nrm(ks[7], (N_EVEN, AB_OUT, D_MODEL), AB_OUT ** -0.5),
        "hg_lb_logits": nrm(ks[8], (N_EVEN, 2, HG_KW), 0.5),
        "hg_norm_g": 1.0 + nrm(ks[9], (N_EVEN, HG_VW), 0.02),
        "w_qkv": nrm(ks[10], (N_ODD, D_MODEL, ATT_IN), D_MODEL ** -0.5),
        "q_norm_g": 1.0 + nrm(ks[11], (N_ODD, HEAD_DIM), 0.02),
        "k_norm_g": 1.0 + nrm(ks[12], (N_ODD, HEAD_DIM), 0.02),
        "w_out_att": nrm(ks[13], (N_ODD, ATT_WIDTH, D_MODEL), ATT_WIDTH ** -0.5),
        "w_up": nrm(ks[14], (DEPTH, D_MODEL, 2 * D_FF), D_MODEL ** -0.5),
        "conv_w": nrm(ks[15], (DEPTH, CONV_K, CONV_K, D_FF), 1.0 / CONV_K),
        "conv_b": nrm(ks[16], (DEPTH, D_FF), 0.01),
        "w_down": nrm(ks[17], (DEPTH, D_FF, D_MODEL), D_FF ** -0.5),
        "final_norm_g": 1.0 + nrm(ks[18], (D_MODEL,), 0.02),
    }


def reference(x, c, ctx, c_ctx, w_mod, b_mod, w_in_ab, w_out_ab, hg_lb_logits, hg_norm_g,
              w_qkv, q_norm_g, k_norm_g, w_out_att, w_up, conv_w, conv_b, w_down, final_norm_g):
    lbp = jax.nn.softmax(hg_lb_logits.astype(jnp.float32), axis=0)
    lower_bounds = jnp.cumsum(lbp, axis=0) - lbp[0]

    for layer in range(DEPTH):
        last = layer == DEPTH - 1
        sh1, sc1, g1, sh2, sc2, g2 = [t[:, None, :] for t in modulation(c, w_mod[layer], b_mod[layer])]
        ch1, cs1, cg1, ch2, cs2, cg2 = modulation(c_ctx, w_mod[layer], b_mod[layer])
        h_lat = modulate(x, sh1, sc1)
        h_ctx = modulate(ctx, ch1, cs1)
        if layer % 2 == 0:
            e = layer // 2
            y_lat, y_ctx = fourier_hgrn_mixer(h_lat, h_ctx, w_in_ab[e], w_out_ab[e], lower_bounds[e],
                                              hg_norm_g[e], not last)
        else:
            o = layer // 2
            y_lat, y_ctx = attention_mixer(h_lat, h_ctx, w_qkv[o], q_norm_g[o], k_norm_g[o],
                                           w_out_att[o], not last)
        x = x + g1 * y_lat
        x = x + g2 * conv_ffn(modulate(x, sh2, sc2), w_up[layer], conv_w[layer], conv_b[layer],
                              w_down[layer], True)
        if not last:
            ctx = ctx + cg1 * y_ctx
            ctx = ctx + cg2 * conv_ffn(modulate(ctx, ch2, cs2), w_up[layer], conv_w[layer], conv_b[layer],
                                       w_down[layer], False)
    return rms_norm(x, final_norm_g)
```

```cpp
#include <hip/hip_runtime.h>
#include <hip/hip_bf16.h>
#include <hip/hip_cooperative_groups.h>
#include <cstdio>
namespace cg = cooperative_groups;

#ifndef REP_FILL
#define REP_FILL 1
#endif
#ifndef REP_MASK
#define REP_MASK 0
#endif
#ifndef MULTI
#define MULTI 0
#endif

typedef unsigned short bf16_t;
typedef short bf16x8 __attribute__((ext_vector_type(8)));
typedef short s16x4 __attribute__((ext_vector_type(4)));
typedef float f32x4 __attribute__((ext_vector_type(4)));
typedef float f32x16 __attribute__((ext_vector_type(16)));
typedef unsigned u32x4 __attribute__((ext_vector_type(4)));
typedef unsigned u32x2 __attribute__((ext_vector_type(2)));
typedef _Float16 h16x8 __attribute__((ext_vector_type(8)));

constexpr int NLAT = 32768, NCTX = 2048, NTOK = 34816;
constexpr float EPS = 1e-6f;

constexpr size_t OFF_CTXR = 0;
constexpr size_t OFF_MOD = OFF_CTXR + 8388608;
constexpr size_t OFF_LB = OFF_MOD + 1048576;
constexpr size_t OFF_CM256 = OFF_LB + 8192;
constexpr size_t OFF_HB = OFF_CM256 + 262144;
constexpr size_t OFF_W1 = OFF_HB + 71303168;
constexpr size_t OFF_W2 = OFF_W1 + 7340032;
constexpr size_t OFF_W3 = OFF_W2 + 2097152;
constexpr size_t OFF_W4 = OFF_W3 + 11534336;
constexpr size_t OFF_AL = OFF_W4 + 5767168;
constexpr size_t OFF_GATE = OFF_AL;
constexpr size_t OFF_VAL = OFF_GATE + 196083712;
constexpr size_t OFF_MIX = OFF_AL;
constexpr size_t OFF_MX = OFF_MIX + 71303168;
constexpr size_t OFF_Q = OFF_MX;
constexpr size_t OFF_V = OFF_Q + 35651584;
constexpr size_t OFF_G = OFF_V + 35651584;
constexpr size_t OFF_LF0 = OFF_G + 35651584;
constexpr size_t OFF_LF1 = OFF_LF0 + 35651584;
constexpr size_t OFF_O0 = OFF_LF1 + 35651584;
constexpr size_t OFF_O1 = OFF_O0 + 71303168;
constexpr size_t OFF_ZT = OFF_O0;
constexpr size_t OFF_ZTC = OFF_ZT + 67108864;
constexpr size_t OFF_ZF = OFF_ZTC + 4194304;
constexpr size_t OFF_CM2 = OFF_ZF + 33554432;
constexpr size_t OFF_CM = OFF_CM2;
constexpr size_t OFF_QB = OFF_MX;
constexpr size_t OFF_KB = OFF_QB + 71303168;
constexpr size_t OFF_VB = OFF_KB + 17825792;
constexpr size_t OFF_ST = OFF_O0;
constexpr size_t OFF_DEC = OFF_VAL + 196083712;
constexpr size_t OFF_W4B = OFF_DEC + 2228224;
constexpr size_t OFF_BAR = OFF_W4B + 5767168;
constexpr size_t OFF_ROPE = OFF_BAR + 16384;
constexpr size_t WS_END = OFF_ROPE + 16384;
static_assert(OFF_O1 + 71303168 <= OFF_DEC && OFF_CM2 + 33554432 <= OFF_DEC && OFF_VB + 17825792 <= WS_END, "alias region");

struct P {
  const float *x, *c, *ctx, *c_ctx, *w_mod, *b_mod, *w_in_ab, *w_out_ab, *hg_lb, *hg_ng, *w_qkv, *qn_g, *kn_g, *w_out_att, *w_up, *conv_w, *conv_b, *w_down, *fn_g;
  float* out; unsigned char* ws;
};

typedef __bf16 bf16v2_t __attribute__((ext_vector_type(2)));
typedef float f32v2_t __attribute__((ext_vector_type(2)));
__device__ __forceinline__ unsigned cvt_pk_bf16(float lo, float hi) { const f32v2_t v = {lo, hi}; const bf16v2_t r = __builtin_convertvector(v, bf16v2_t); return __builtin_bit_cast(unsigned, r); }
__device__ __forceinline__ bf16_t f2bf(float f) { return (bf16_t)(cvt_pk_bf16(f, 0.f) & 0xffffu); }
__device__ __forceinline__ float bflo(unsigned w) { return __uint_as_float(w << 16); }
__device__ __forceinline__ float bfhi(unsigned w) { return __uint_as_float(w & 0xffff0000u); }
__device__ __forceinline__ float bf2f(bf16_t v) { return __uint_as_float(((unsigned)v) << 16); }
#define GA __attribute__((address_space(1)))
#define LAS3 __attribute__((address_space(3)))
#define UNPK(w, j) (((j) & 1) ? bfhi((w)[(j) >> 1]) : bflo((w)[(j) >> 1]))
__device__ __forceinline__ float silu_f(float v) { return v * __builtin_amdgcn_rcpf(1.f + __expf(-v)); }
__device__ __forceinline__ float wave_sum(float v) {
#pragma unroll
  for (int o = 32; o > 0; o >>= 1) v += __shfl_xor(v, o);
  return v;
}
__device__ __forceinline__ int tid_() { int t = threadIdx.x; asm volatile("" : "+v"(t)); return t; }
__device__ __forceinline__ int bid_() { int b = blockIdx.x; asm volatile("" : "+s"(b)); return b; }
__device__ __forceinline__ int kvrow(int row) { return row < NLAT ? (row >> 12) * 4352 + (row & 4095) : ((row - NLAT) >> 8) * 4352 + 4096 + ((row - NLAT) & 255); }

#define XB_TMO      128
#define XB_XCNT(j)  (256  + 64 * (j))
#define XB_XSUB(j)  (1280 + 64 * (j))
#define XB_XGEN(j)  (2304 + 64 * (j))
#define XB_TOP      3328
#define XB_TOPGEN   3392
#define XCD_BAR_WORDS 3456
#define XB_SPIN_CAP (1u << 22)
__device__ __forceinline__ unsigned xb_ld(unsigned* p)              { return __hip_atomic_load(p, __ATOMIC_RELAXED, __HIP_MEMORY_SCOPE_AGENT); }
__device__ __forceinline__ unsigned xb_add(unsigned* p, unsigned v) { return __hip_atomic_fetch_add(p, v, __ATOMIC_RELAXED, __HIP_MEMORY_SCOPE_AGENT); }
__device__ __forceinline__ unsigned xb_xcc_id() { return (unsigned)__builtin_amdgcn_s_getreg((3 << 11) | 20) & 0xFu; }
#define XB_SPIN(cond, bar) do { unsigned _sp = 0; while (cond) { __builtin_amdgcn_s_sleep(1); \
    if ((++_sp & 255u) == 0u) { if (xb_ld(&(bar)[XB_TMO])) break; if (_sp > XB_SPIN_CAP) { atomicAdd(&(bar)[XB_TMO], 1u); break; } } } } while (0)
struct XcdBarrier { unsigned* bar; unsigned x; volatile LAS3 unsigned* st; };
__device__ __forceinline__ XcdBarrier xcd_barrier_post(unsigned* bar, volatile LAS3 unsigned* st) {
  XcdBarrier b; b.bar = bar; b.x = xb_xcc_id(); b.st = st;
  if (threadIdx.x == 0) (void)xb_add(&bar[XB_XCNT(b.x)], 1u);
  return b;
}
__device__ __forceinline__ void xcd_barrier_complete(unsigned* bar, unsigned x, unsigned& nloc, unsigned& nx) {
  const unsigned G = gridDim.x * gridDim.y * gridDim.z;
  unsigned sum, cnt, mine, sp = 0u;
  for (;;) {
    sum = 0u; cnt = 0u; mine = 0u;
#pragma unroll
    for (unsigned j = 0; j < 16; ++j) { const unsigned c = xb_ld(&bar[XB_XCNT(j)]); sum += c; cnt += (c > 0u) ? 1u : 0u; mine = (j == x) ? c : mine; }
    if (sum == G) break;
    __builtin_amdgcn_s_sleep(1);
    if ((++sp & 255u) == 0u) { if (xb_ld(&bar[XB_TMO])) break; if (sp > XB_SPIN_CAP) { atomicAdd(&bar[XB_TMO], 1u); break; } }
  }
  nloc = mine > 0u ? mine : 1u; nx = cnt > 0u ? cnt : 1u;
}
__device__ __forceinline__ void xcd_barrier(const XcdBarrier& b) {
  asm volatile("s_waitcnt vmcnt(0)" ::: "memory");
  __syncthreads();
  if (threadIdx.x == 0) {
    unsigned* bar = b.bar; unsigned bx = __builtin_amdgcn_readfirstlane(b.x);
    asm volatile("" : "+s"(bar), "+s"(bx));
    __builtin_amdgcn_s_waitcnt(0);
    unsigned nloc = b.st[0], nx = b.st[1];
    if (nloc == 0u) { xcd_barrier_complete(bar, bx, nloc, nx); b.st[0] = nloc; b.st[1] = nx; }
    const unsigned old = xb_add(&bar[XB_XSUB(bx)], 1u);
    const unsigned gen = old / nloc;
    if (old + 1u == (gen + 1u) * nloc) {
      __builtin_amdgcn_fence(__ATOMIC_RELEASE, "agent");
      asm volatile("s_waitcnt vmcnt(0)" ::: "memory");
      const unsigned og = xb_add(&bar[XB_TOP], 1u);
      const unsigned tg = og / nx;
      if (og + 1u == (tg + 1u) * nx) xb_add(&bar[XB_TOPGEN], 1u);
      else XB_SPIN(xb_ld(&bar[XB_TOPGEN]) == tg, bar);
      __builtin_amdgcn_fence(__ATOMIC_ACQUIRE, "agent");
      xb_add(&bar[XB_XGEN(bx)], 1u);
      asm volatile("s_waitcnt vmcnt(0)" ::: "memory");
    } else {
      XB_SPIN(xb_ld(&bar[XB_XGEN(bx)]) == gen, bar);
      __builtin_amdgcn_fence(__ATOMIC_ACQUIRE, "agent");
      asm volatile("s_waitcnt vmcnt(0)" ::: "memory");
    }
  }
  __syncthreads();
}

namespace pg8 {
#define PG8_LAS __attribute__((address_space(3)))
constexpr int BM = 256, BK = 64, HALF = 128, HTB = HALF * BK * 2, STAGE_BYTES = 8 * HTB, NXCD = 8, WGM = 8;
__device__ __forceinline__ int lds_byte(int r, int c) { const int st = (r >> 4) * 2 + (c >> 5), rr = r & 15, cc = c & 31, ob = rr * 64 + cc * 2; return st * 1024 + (ob ^ (((ob >> 9) & 1) << 5)); }
__device__ __forceinline__ void stage_rc(int b, int& R, int& C) { const int st = b / 1024, sb = b % 1024, swz = sb ^ (((sb >> 9) & 1) << 5); R = (st >> 1) * 16 + swz / 64; C = (st & 1) * 32 + (swz % 64) / 2; }
__device__ __forceinline__ int perm32(int rho) { const int n = rho >> 4, i = rho & 15; return 8 * (i >> 2) + 4 * n + (i & 3); }
struct Unit { int pm, pn, ko; };
struct Gemm { const bf16_t* A; const bf16_t* Bt; int M, N, K, ldk; };
struct StaticOrder {
  int nM, nN, nwg, G, c;
  __device__ void init(int M, int N, int G_, int c_) { nM = M / BM; nN = N / BM; nwg = nM * nN; G = G_; c = c_; }
  __device__ bool next(int i, Unit& u) const {
    const long L = (long)i * G + c; if (L >= nwg) return false;
    int wgid = (int)L; { const int q = nwg / NXCD, r = nwg % NXCD, xcd = wgid % NXCD, off = wgid / NXCD; wgid = (xcd < r ? xcd * (q + 1) : r * (q + 1) + (xcd - r) * q) + off; }
    const int nig = WGM * nN, gid = wgid / nig, fm = gid * WGM, gsz = (nM - fm) < WGM ? (nM - fm) : WGM;
    u.pm = fm + ((wgid % nig) % gsz); u.pn = (wgid % nig) / gsz; u.ko = 0; return true;
  }
};
struct SplitKOrder {
  int nN, ns, nwg, G, c, ksub;
  __device__ void init(int M, int N, int ns_, int ksub_, int G_, int c_) { nN = N / BM; ns = ns_; ksub = ksub_; nwg = (M / BM) * nN * ns; G = G_; c = c_; }
  __device__ bool next(int i, Unit& u) const {
    const int L = i * G + c; if (L >= nwg) return false;
    u.ko = (L % ns) * ksub; u.pn = (L / ns) % nN; u.pm = L / (ns * nN); return true;
  }
};

#ifndef GEMM_SP2
#define GEMM_SP2 1
#endif
#ifndef GEMM_ALIGN
#define GEMM_ALIGN 1
#endif
template <class Epi, class Sched>
__device__ __forceinline__ void gemm_phase(PG8_LAS unsigned char* lds, const Gemm g, const Sched& S, const Epi& E) {
  const int tid = tid_(), wid = __builtin_amdgcn_readfirstlane(tid >> 6), lane = tid & 63, wr = wid >> 2, wc = wid & 3, fr = lane & 15, fq = lane >> 4;
  const int K = g.ldk, nt = g.K / BK;
  unsigned voffA[2], voffB[2];
#pragma unroll
  for (int i = 0; i < 2; ++i) { int R, C; stage_rc(tid * 16 + i * 8192, R, C); const int Rb = Epi::PERM ? ((R & ~31) + perm32(R & 31)) : R;
    voffA[i] = (unsigned)(R * K + C) * 2u; voffB[i] = (unsigned)(Rb * K + C) * 2u; }
  const size_t kstep = (size_t)(BK * 2);
  const size_t hstep = (size_t)HALF * K * 2;
  const size_t tstep = 2 * hstep;
  const unsigned ldsw = (unsigned)wid * 1024u;
  const int aoff = lds_byte(wr * 64 + fr, fq * 8), boff = lds_byte(wc * 32 + fr, fq * 8);
#define PG8_SA(b, h) (((b) * 2 + (h)) * HTB)
#define PG8_SB(b, h) ((4 + (b) * 2 + (h)) * HTB)
#define PG8_STAGE(bufoff, gbase, voff) do { _Pragma("unroll") for (int _i = 0; _i < 2; ++_i) \
    __builtin_amdgcn_global_load_lds((const unsigned*)((const char*)(gbase) + (voff)[_i]), (PG8_LAS unsigned*)(lds + (bufoff) + ldsw + _i * 8192), 16, 0, 0); } while (0)
#define PG8_LDA(dst, b, h) do { _Pragma("unroll") for (int m = 0; m < 4; ++m) _Pragma("unroll") for (int k = 0; k < 2; ++k) dst[m][k] = *(const PG8_LAS bf16x8*)(lds + PG8_SA(b, h) + aoff + m * 2048 + k * 1024); } while (0)
#define PG8_LDB(dst, b, h) do { _Pragma("unroll") for (int n = 0; n < 2; ++n) _Pragma("unroll") for (int k = 0; k < 2; ++k) dst[n][k] = *(const PG8_LAS bf16x8*)(lds + PG8_SB(b, h) + boff + n * 2048 + k * 1024); } while (0)
#define PG8_MMA(ai, bj, At, Bt) do { __builtin_amdgcn_s_setprio(1); _Pragma("unroll") for (int m = 0; m < 4; ++m) _Pragma("unroll") for (int n = 0; n < 2; ++n) _Pragma("unroll") for (int k = 0; k < 2; ++k) \
    acc[ai][bj][m][n] = __builtin_amdgcn_mfma_f32_16x16x32_bf16(Bt[n][k], At[m][k], acc[ai][bj][m][n], 0, 0, 0); __builtin_amdgcn_s_setprio(0); } while (0)
#define PG8_WAIT_V(n) asm volatile("s_waitcnt vmcnt(" #n ")" ::: "memory")
#define PG8_WAIT_L(n) asm volatile("s_waitcnt lgkmcnt(" #n ")" ::: "memory")
#define PG8_BAR __builtin_amdgcn_s_barrier()
#define PG8_SCHED __builtin_amdgcn_sched_barrier(0)
  Unit cur, nxt; int ui = 0;
  if (!S.next(0, cur)) return;
  f32x4 acc[2][2][4][2];
#pragma unroll
  for (int a = 0; a < 2; ++a)
#pragma unroll
    for (int b = 0; b < 2; ++b)
#pragma unroll
      for (int m = 0; m < 4; ++m)
#pragma unroll
        for (int n = 0; n < 2; ++n) acc[a][b][m][n] = (f32x4){0.f, 0.f, 0.f, 0.f};
  bf16x8 At[4][2], B0[2][2], B1[2][2];
  const char* cA = (const char*)g.A + (size_t)cur.pm * tstep + (size_t)cur.ko * 2; const char* cB = (const char*)g.Bt + (size_t)cur.pn * tstep + (size_t)cur.ko * 2;
#if GEMM_SP2
  PG8_STAGE(PG8_SB(0, 0), cB, voffB); PG8_STAGE(PG8_SB(0, 1), cB + hstep, voffB); PG8_STAGE(PG8_SA(0, 0), cA, voffA); PG8_STAGE(PG8_SA(0, 1), cA + hstep, voffA);
  if (wr == 1) PG8_BAR;
  PG8_WAIT_V(2); PG8_BAR;
  PG8_STAGE(PG8_SB(1, 0), cB + kstep, voffB); PG8_STAGE(PG8_SA(1, 0), cA + kstep, voffA); PG8_STAGE(PG8_SB(1, 1), cB + hstep + kstep, voffB);
  PG8_WAIT_V(6); PG8_BAR;
#else
  PG8_STAGE(PG8_SB(0, 0), cB, voffB); PG8_STAGE(PG8_SA(0, 0), cA, voffA); PG8_STAGE(PG8_SB(0, 1), cB + hstep, voffB); PG8_STAGE(PG8_SA(0, 1), cA + hstep, voffA);
  if (wr == 1) PG8_BAR;
  PG8_WAIT_V(4); PG8_BAR;
  PG8_STAGE(PG8_SB(1, 0), cB + kstep, voffB); PG8_STAGE(PG8_SA(1, 0), cA + kstep, voffA); PG8_STAGE(PG8_SB(1, 1), cB + hstep + kstep, voffB);
  PG8_WAIT_V(6); PG8_BAR;
#endif
  for (;;) {
    const bool has_next = S.next(ui + 1, nxt);
    const char* nA = has_next ? (const char*)g.A + (size_t)nxt.pm * tstep + (size_t)nxt.ko * 2 : cA; const char* nB = has_next ? (const char*)g.Bt + (size_t)nxt.pn * tstep + (size_t)nxt.ko * 2 : cB;
    for (int t = 0; t < nt; t += 2) {
      const bool last = (t == nt - 2);
      const char* a1 = cA + (size_t)(t + 1) * kstep;
      const char* a2 = last ? nA : cA + (size_t)(t + 2) * kstep; const char* b2 = last ? nB : cB + (size_t)(t + 2) * kstep;
      const char* a3 = a2 + kstep; const char* b3 = b2 + kstep;
#if GEMM_SP2
      PG8_LDB(B0, 0, 0); PG8_LDB(B1, 0, 1); PG8_SCHED; PG8_LDA(At, 0, 0); PG8_STAGE(PG8_SA(1, 1), a1 + hstep, voffA);
      PG8_WAIT_V(8); PG8_WAIT_L(0); PG8_BAR; PG8_MMA(0, 0, At, B0); PG8_MMA(0, 1, At, B1); PG8_BAR; PG8_SCHED;
      PG8_LDA(At, 0, 1); PG8_STAGE(PG8_SB(0, 0), b2, voffB); PG8_STAGE(PG8_SB(0, 1), b2 + hstep, voffB); PG8_STAGE(PG8_SA(0, 0), a2, voffA);
      PG8_WAIT_V(8); PG8_WAIT_L(0); PG8_BAR; PG8_MMA(1, 0, At, B0); PG8_MMA(1, 1, At, B1); PG8_BAR; PG8_SCHED;
      PG8_LDB(B0, 1, 0); PG8_LDB(B1, 1, 1); PG8_SCHED; PG8_LDA(At, 1, 0); PG8_STAGE(PG8_SA(0, 1), a2 + hstep, voffA);
      PG8_WAIT_V(8); PG8_WAIT_L(0); PG8_BAR; PG8_MMA(0, 0, At, B0); PG8_MMA(0, 1, At, B1); PG8_BAR; PG8_SCHED;
      PG8_LDA(At, 1, 1); PG8_STAGE(PG8_SB(1, 0), b3, voffB); PG8_STAGE(PG8_SB(1, 1), b3 + hstep, voffB); PG8_STAGE(PG8_SA(1, 0), a3, voffA);
      PG8_WAIT_V(8); PG8_WAIT_L(0); PG8_BAR; PG8_MMA(1, 0, At, B0); PG8_MMA(1, 1, At, B1); PG8_BAR; PG8_SCHED;
#else
      PG8_LDB(B0, 0, 0); PG8_SCHED; PG8_LDA(At, 0, 0); PG8_STAGE(PG8_SA(1, 1), a1 + hstep, voffA);
      PG8_WAIT_L(8); PG8_BAR; PG8_WAIT_L(0); PG8_MMA(0, 0, At, B0); PG8_BAR; PG8_SCHED;
      PG8_LDB(B1, 0, 1); PG8_STAGE(PG8_SB(0, 0), b2, voffB);
      PG8_BAR; PG8_WAIT_L(0); PG8_MMA(0, 1, At, B1); PG8_BAR;
      PG8_LDA(At, 0, 1); PG8_STAGE(PG8_SA(0, 0), a2, voffA);
      PG8_BAR; PG8_WAIT_L(0); PG8_MMA(1, 0, At, B0); PG8_BAR; PG8_SCHED;
      PG8_STAGE(PG8_SB(0, 1), b2 + hstep, voffB);
      PG8_WAIT_V(6); PG8_BAR; PG8_MMA(1, 1, At, B1); PG8_BAR;
      PG8_LDB(B0, 1, 0); PG8_SCHED; PG8_LDA(At, 1, 0); PG8_STAGE(PG8_SA(0, 1), a2 + hstep, voffA);
      PG8_WAIT_L(8); PG8_BAR; PG8_WAIT_L(0); PG8_MMA(0, 0, At, B0); PG8_BAR; PG8_SCHED;
      PG8_LDB(B1, 1, 1); PG8_STAGE(PG8_SB(1, 0), b3, voffB);
      PG8_BAR; PG8_WAIT_L(0); PG8_MMA(0, 1, At, B1); PG8_BAR;
      PG8_LDA(At, 1, 1); PG8_STAGE(PG8_SA(1, 0), a3, voffA);
      PG8_BAR; PG8_WAIT_L(0); PG8_MMA(1, 0, At, B0); PG8_BAR; PG8_SCHED;
      PG8_STAGE(PG8_SB(1, 1), b3 + hstep, voffB);
      PG8_WAIT_V(6); PG8_BAR; PG8_MMA(1, 1, At, B1); PG8_BAR;
#endif
    }
#if GEMM_ALIGN
    if (wr == 0) PG8_BAR;
#endif
    E(acc, cur, wr, wc, fr, fq);
    if (!has_next) break;
#pragma unroll
    for (int a = 0; a < 2; ++a)
#pragma unroll
      for (int b = 0; b < 2; ++b)
#pragma unroll
        for (int m = 0; m < 4; ++m)
#pragma unroll
          for (int n = 0; n < 2; ++n) acc[a][b][m][n] = (f32x4){0.f, 0.f, 0.f, 0.f};
    cur = nxt; cA = nA; cB = nB; ++ui;
#if GEMM_ALIGN
    if (wr == 1) PG8_BAR;
#endif
  }
  PG8_WAIT_V(0);
#if !GEMM_ALIGN
  if (wr == 0) PG8_BAR;
#endif
  PG8_BAR;
#undef PG8_SA
#undef PG8_SB
#undef PG8_STAGE
#undef PG8_LDA
#undef PG8_LDB
#undef PG8_MMA
#undef PG8_WAIT_V
#undef PG8_WAIT_L
#undef PG8_BAR
#undef PG8_SCHED
}
}

typedef const f32x4 (&AccRef)[2][2][4][2];
__device__ __forceinline__ u32x4 pack8(f32x4 v0, f32x4 v1) { u32x4 w; w.x = cvt_pk_bf16(v0[0], v0[1]); w.y = cvt_pk_bf16(v0[2], v0[3]); w.z = cvt_pk_bf16(v1[0], v1[1]); w.w = cvt_pk_bf16(v1[2], v1[3]); return w; }

struct EpiZ {
  static constexpr bool PERM = true;
  bf16_t* Z; bf16_t* ZTC;
  __device__ __forceinline__ void operator()(AccRef acc, const pg8::Unit& u, int wr, int wc, int fr, int fq) const {
#pragma unroll
    for (int ai = 0; ai < 2; ++ai)
#pragma unroll
      for (int m = 0; m < 4; ++m) {
        const int row = u.pm * 256 + ai * 128 + wr * 64 + m * 16 + fr;
        if (row < NLAT) {
          bf16_t* dst = Z + (size_t)row * 1024 + u.pn * 256 + wc * 32 + fq * 8;
#pragma unroll
          for (int bj = 0; bj < 2; ++bj) *(u32x4*)(dst + bj * 128) = pack8(acc[ai][bj][m][0], acc[ai][bj][m][1]);
        } else {
          const int rr = row - NLAT; bf16_t* base = ZTC + (size_t)(rr >> 8) * 512 * 512 + (rr & 255);
#pragma unroll
          for (int bj = 0; bj < 2; ++bj)
#pragma unroll
            for (int n = 0; n < 2; ++n)
#pragma unroll
              for (int j = 0; j < 4; ++j) { const int col = u.pn * 256 + bj * 128 + wc * 32 + fq * 8 + n * 4 + j;
                base[(size_t)(col & 511) * 512 + (col >> 9) * 256] = f2bf(acc[ai][bj][m][n][j]); }
        }
      }
  }
};
struct EpiHG {
  static constexpr bool PERM = true;
  bf16_t *Q, *V, *G; _Float16 *LF0, *LF1; const float* LB;
  __device__ __forceinline__ void operator()(AccRef acc, const pg8::Unit& u, int wr, int wc, int fr, int fq) const {
    const int region = u.pn >> 1;
#pragma unroll
    for (int bj = 0; bj < 2; ++bj) {
      const int cl = (u.pn & 1) * 256 + bj * 128 + wc * 32 + fq * 8;
      float lb[8];
      if (region == 1 || region == 2) {
        const f32x4 a = *(const f32x4*)(LB + (region - 1) * 512 + cl), b = *(const f32x4*)(LB + (region - 1) * 512 + cl + 4);
        lb[0] = a[0]; lb[1] = a[1]; lb[2] = a[2]; lb[3] = a[3]; lb[4] = b[0]; lb[5] = b[1]; lb[6] = b[2]; lb[7] = b[3];
      } else {
#pragma unroll
        for (int j = 0; j < 8; ++j) lb[j] = 0.f;
      }
#pragma unroll
      for (int ai = 0; ai < 2; ++ai)
#pragma unroll
        for (int m = 0; m < 4; ++m) {
          const size_t off = (size_t)(u.pm * 256 + ai * 128 + wr * 64 + m * 16 + fr) * 512 + cl;
          f32x4 v0 = acc[ai][bj][m][0], v1 = acc[ai][bj][m][1];
          if (region == 0) {
#pragma unroll
            for (int j = 0; j < 4; ++j) { v0[j] = silu_f(v0[j]); v1[j] = silu_f(v1[j]); }
            *(u32x4*)(Q + off) = pack8(v0, v1);
          } else if (region == 1 || region == 2) {
            h16x8 hv;
#pragma unroll
            for (int j = 0; j < 4; ++j) {
              const float f0 = lb[j] + (1.f - lb[j]) * __builtin_amdgcn_rcpf(1.f + __expf(-v0[j])), f1 = lb[4 + j] + (1.f - lb[4 + j]) * __builtin_amdgcn_rcpf(1.f + __expf(-v1[j]));
              hv[j] = (_Float16)__logf(fmaxf(f0, 1e-30f)); hv[4 + j] = (_Float16)__logf(fmaxf(f1, 1e-30f));
            }
            *(h16x8*)((region == 1 ? LF0 : LF1) + off) = hv;
          } else if (region == 3) { *(u32x4*)(V + off) = pack8(v0, v1); }
          else { *(u32x4*)(G + off) = pack8(v0, v1); }
        }
    }
  }
};
struct EpiAB {
  static constexpr bool PERM = true;
  EpiZ z; EpiHG hg;
  __device__ __forceinline__ void operator()(AccRef acc, const pg8::Unit& u, int wr, int wc, int fr, int fq) const {
    if (u.pn < 4) z(acc, u, wr, wc, fr, fq);
    else { pg8::Unit v = u; v.pn = u.pn - 4; hg(acc, v, wr, wc, fr, fq); }
  }
};
struct EpiQKV {
  static constexpr bool PERM = true;
  bf16_t *QB, *KB, *VB;
  __device__ __forceinline__ void operator()(AccRef acc, const pg8::Unit& u, int wr, int wc, int fr, int fq) const {
#pragma unroll
    for (int ai = 0; ai < 2; ++ai)
#pragma unroll
      for (int m = 0; m < 4; ++m) {
        const int row = u.pm * 256 + ai * 128 + wr * 64 + m * 16 + fr;
        bf16_t* dst;
        if (u.pn < 4) dst = QB + (size_t)row * 1024 + u.pn * 256;
        else dst = (u.pn == 4 ? KB : VB) + (size_t)kvrow(row) * 256;
#pragma unroll
        for (int bj = 0; bj < 2; ++bj) *(u32x4*)(dst + bj * 128 + wc * 32 + fq * 8) = pack8(acc[ai][bj][m][0], acc[ai][bj][m][1]);
      }
  }
};
struct EpiRes {
  static constexpr bool PERM = false;
  float* X; float* CX; const float* gate;
  __device__ __forceinline__ void operator()(AccRef acc, const pg8::Unit& u, int wr, int wc, int fr, int fq) const {
    const int row0 = u.pm * 256;
    const int mr = row0 < NLAT ? (row0 >> 12) : 8;
    const int colb = u.pn * 256 + wc * 32 + fq * 4;
    f32x4 gv[2][2];
#pragma unroll
    for (int bj = 0; bj < 2; ++bj)
#pragma unroll
      for (int n = 0; n < 2; ++n) gv[bj][n] = *(const f32x4*)(gate + (size_t)mr * 6144 + colb + bj * 128 + n * 16);
#pragma unroll
    for (int ai = 0; ai < 2; ++ai)
#pragma unroll
      for (int m = 0; m < 4; ++m) {
        const int row = row0 + ai * 128 + wr * 64 + m * 16 + fr;
        float* dst = (row < NLAT ? X + (size_t)row * 1024 : CX + (size_t)(row - NLAT) * 1024) + colb;
#pragma unroll
        for (int bj = 0; bj < 2; ++bj)
#pragma unroll
          for (int n = 0; n < 2; ++n) { f32x4 xv = *(f32x4*)(dst + bj * 128 + n * 16); xv += gv[bj][n] * acc[ai][bj][m][n]; *(f32x4*)(dst + bj * 128 + n * 16) = xv; }
      }
  }
};
struct EpiPart {
  static constexpr bool PERM = false;
  float* PART; int ksub;
  __device__ __forceinline__ void operator()(AccRef acc, const pg8::Unit& u, int wr, int wc, int fr, int fq) const {
    float* base = PART + (size_t)(u.ko / ksub) * NCTX * 1024 + u.pn * 256 + wc * 32 + fq * 4;
#pragma unroll
    for (int ai = 0; ai < 2; ++ai)
#pragma unroll
      for (int m = 0; m < 4; ++m) {
        float* dst = base + (size_t)(u.pm * 256 + ai * 128 + wr * 64 + m * 16 + fr) * 1024;
#pragma unroll
        for (int bj = 0; bj < 2; ++bj)
#pragma unroll
          for (int n = 0; n < 2; ++n) *(f32x4*)(dst + bj * 128 + n * 16) = acc[ai][bj][m][n];
      }
  }
};
struct EpiUp {
  static constexpr bool PERM = true;
  bf16_t *GATE, *VAL;
  __device__ __forceinline__ void operator()(AccRef acc, const pg8::Unit& u, int wr, int wc, int fr, int fq) const {
    bf16_t* base = (u.pn < 11 ? GATE + u.pn * 256 : VAL + (u.pn - 11) * 256) + wc * 32 + fq * 8;
#pragma unroll
    for (int ai = 0; ai < 2; ++ai)
#pragma unroll
      for (int m = 0; m < 4; ++m) {
        bf16_t* dst = base + (size_t)(u.pm * 256 + ai * 128 + wr * 64 + m * 16 + fr) * 2816;
#pragma unroll
        for (int bj = 0; bj < 2; ++bj) *(u32x4*)(dst + bj * 128) = pack8(acc[ai][bj][m][0], acc[ai][bj][m][1]);
      }
  }
};
struct EpiDFT {
  static constexpr bool PERM = true;
  bf16_t* MIX; int ctxmode;
  __device__ __forceinline__ void operator()(AccRef acc, const pg8::Unit& u, int wr, int wc, int fr, int fq) const {
    const int b = u.pn >> 1;
    const int tok0 = ctxmode ? NLAT + b * 256 : b * 4096 + u.pm * 256;
    bf16_t* base = MIX + (u.pn & 1) * 256 + wc * 32 + fq * 8;
#pragma unroll
    for (int ai = 0; ai < 2; ++ai)
#pragma unroll
      for (int m = 0; m < 4; ++m) {
        bf16_t* dst = base + (size_t)(tok0 + ai * 128 + wr * 64 + m * 16 + fr) * 1024;
#pragma unroll
        for (int bj = 0; bj < 2; ++bj) *(u32x4*)(dst + bj * 128) = pack8(acc[ai][bj][m][0], acc[ai][bj][m][1]);
      }
  }
};
template <class Epi> __device__ __forceinline__ void run_gemm(unsigned char* lds, const bf16_t* A, const bf16_t* Bt, int M, int N, int K, const Epi& E) {
  pg8::Gemm g{A, Bt, M, N, K, K}; pg8::StaticOrder S; S.init(M, N, (int)gridDim.x, bid_());
  pg8::gemm_phase<Epi, pg8::StaticOrder>((PG8_LAS unsigned char*)lds, g, S, E);
}
template <class Epi> __device__ __forceinline__ void run_gemm_splitk(unsigned char* lds, const bf16_t* A, const bf16_t* Bt, int M, int N, int K, int ns, const Epi& E) {
  pg8::Gemm g{A, Bt, M, N, K / ns, K}; pg8::SplitKOrder S; S.init(M, N, ns, K / ns, (int)gridDim.x, bid_());
  pg8::gemm_phase<Epi, pg8::SplitKOrder>((PG8_LAS unsigned char*)lds, g, S, E);
}

namespace att {
constexpr int D = 128, NW = 8, QBLK = 32, KVBLK = 64;
constexpr float SCALE = 0.088388347648318440f;
constexpr float THR = 8.f;
constexpr int LDQ = 1024, LDK = 256, LDO = 1024;
constexpr size_t SHM_V = KVBLK * D * 2, SHM_K = KVBLK * D * 2;
#define KSWZ(row, colB) ((row) * 256 + ((colB) ^ (((row) & 7) << 4)))
#define SBAR() __builtin_amdgcn_sched_barrier(0)
__device__ __forceinline__ int crow(int r, int hi) { return (r & 3) + 8 * (r >> 2) + 4 * hi; }
__device__ __forceinline__ unsigned cvtpk(float lo, float hi) { return cvt_pk_bf16(lo, hi); }
__device__ __forceinline__ void partialSM(f32x16& p0, f32x16& p1, float& m_reg, float& mn, float& alpha) {
  constexpr float C = SCALE * 1.4426950408889634f;
  float pmax = p0[0]; _Pragma("unroll") for (int r = 1; r < 16; ++r) pmax = fmaxf(pmax, p0[r]); _Pragma("unroll") for (int r = 0; r < 16; ++r) pmax = fmaxf(pmax, p1[r]);
  { auto rr = __builtin_amdgcn_permlane32_swap(__float_as_uint(pmax), __float_as_uint(pmax), false, false);
    pmax = fmaxf(__uint_as_float(rr[0]), __uint_as_float(rr[1])); }
  if (__builtin_expect(__all(pmax - m_reg <= THR / SCALE), 1)) { mn = m_reg; alpha = 1.f; }
  else { mn = fmaxf(m_reg, pmax); alpha = __builtin_amdgcn_exp2f((m_reg - mn) * C); m_reg = mn; }
  float mnC = -mn * C;
  _Pragma("unroll") for (int r = 0; r < 16; ++r) p0[r] = fmaf(p0[r], C, mnC); _Pragma("unroll") for (int r = 0; r < 16; ++r) p1[r] = fmaf(p1[r], C, mnC);
  _Pragma("unroll") for (int r = 0; r < 16; ++r) p0[r] = __builtin_amdgcn_exp2f(p0[r]);
}
__device__ __forceinline__ void finishSM(f32x16& p0, f32x16& p1, float alpha, float& l_reg, bf16x8& pa0, bf16x8& pa1, bf16x8& pa2, bf16x8& pa3) {
  _Pragma("unroll") for (int r = 0; r < 16; ++r) p1[r] = __builtin_amdgcn_exp2f(p1[r]);
  float ps = 0; _Pragma("unroll") for (int r = 0; r < 16; ++r) ps += p0[r]; _Pragma("unroll") for (int r = 0; r < 16; ++r) ps += p1[r];
  { auto rr = __builtin_amdgcn_permlane32_swap(__float_as_uint(ps), __float_as_uint(ps), false, false);
    ps = __uint_as_float(rr[0]) + __uint_as_float(rr[1]); }
  l_reg = l_reg * alpha + ps;
#define PK4(Pv, BASE, OUT) do { unsigned a0 = cvtpk(Pv[BASE + 0], Pv[BASE + 1]), a1 = cvtpk(Pv[BASE + 2], Pv[BASE + 3]);   \
    unsigned b0 = cvtpk(Pv[BASE + 4], Pv[BASE + 5]), b1 = cvtpk(Pv[BASE + 6], Pv[BASE + 7]);                              \
    auto r0 = __builtin_amdgcn_permlane32_swap(a0, b0, false, false); auto r1 = __builtin_amdgcn_permlane32_swap(a1, b1, false, false); \
    u32x4 w = {r0[0], r1[0], r0[1], r1[1]}; OUT = *reinterpret_cast<bf16x8*>(&w); } while (0)
  PK4(p0, 0, pa0); PK4(p0, 8, pa1); PK4(p1, 0, pa2); PK4(p1, 8, pa3);
#undef PK4
}
__device__ __forceinline__ void qkt(f32x16& p0, f32x16& p1, const bf16_t* Ks, const bf16x8* qr, int r32, int hi) {
  p0 = f32x16{}; p1 = f32x16{};
  _Pragma("unroll") for (int d0 = 0; d0 < 8; ++d0) { int cb = (d0 * 16 + hi * 8) * 2;
    bf16x8 b0 = *reinterpret_cast<const bf16x8*>((const char*)Ks + KSWZ(r32, cb));
    bf16x8 b1 = *reinterpret_cast<const bf16x8*>((const char*)Ks + KSWZ(32 + r32, cb));
    p0 = __builtin_amdgcn_mfma_f32_32x32x16_bf16(b0, qr[d0], p0, 0, 0, 0);
    p1 = __builtin_amdgcn_mfma_f32_32x32x16_bf16(b1, qr[d0], p1, 0, 0, 0); }
}
__device__ __forceinline__ int v_st(int k, int c) { const int kk = (k & ~0xC) | ((k & 4) << 1) | ((k & 8) >> 1); return ((kk >> 3) * 4 + (c >> 5)) * 512 + ((kk & 7) * 32 + (c & 31)) * 2; }
__device__ __forceinline__ int v_rd_base(int lane) { return ((lane & 3) << 3) | (((lane >> 2) & 3) << 6) | (((lane >> 4) & 1) << 5) | (((lane >> 5) & 1) << 8); }
constexpr int v_rd_off(int d0, int ks, int half) { return d0 * 512 + ks * 4096 + half * 2048; }
template <int OFF> __device__ __forceinline__ s16x4 tr_read(int vb) {
  s16x4 r; asm volatile("ds_read_b64_tr_b16 %0, %1 offset:%2" : "=&v"(r) : "v"(vb), "i"(OFF) : "memory"); return r;
}
template <int D0> __device__ __forceinline__ void pv_one(f32x16& od, int vb, bf16x8 pa0, bf16x8 pa1, bf16x8 pa2, bf16x8 pa3) {
  const s16x4 l0 = tr_read<v_rd_off(D0, 0, 0)>(vb), h0 = tr_read<v_rd_off(D0, 0, 1)>(vb), l1 = tr_read<v_rd_off(D0, 1, 0)>(vb), h1 = tr_read<v_rd_off(D0, 1, 1)>(vb);
  const s16x4 l2 = tr_read<v_rd_off(D0, 2, 0)>(vb), h2 = tr_read<v_rd_off(D0, 2, 1)>(vb), l3 = tr_read<v_rd_off(D0, 3, 0)>(vb), h3 = tr_read<v_rd_off(D0, 3, 1)>(vb);
  asm volatile("s_waitcnt lgkmcnt(0)" ::: "memory"); SBAR();
#define PK(L, H) (bf16x8){L[0], L[1], L[2], L[3], H[0], H[1], H[2], H[3]}
  od = __builtin_amdgcn_mfma_f32_32x32x16_bf16(pa0, PK(l0, h0), od, 0, 0, 0);
  od = __builtin_amdgcn_mfma_f32_32x32x16_bf16(pa1, PK(l1, h1), od, 0, 0, 0);
  od = __builtin_amdgcn_mfma_f32_32x32x16_bf16(pa2, PK(l2, h2), od, 0, 0, 0);
  od = __builtin_amdgcn_mfma_f32_32x32x16_bf16(pa3, PK(l3, h3), od, 0, 0, 0);
#undef PK
}
__device__ __forceinline__ void pv_d0(f32x16* o, int vb, bf16x8 pa0, bf16x8 pa1, bf16x8 pa2, bf16x8 pa3) {
  pv_one<0>(o[0], vb, pa0, pa1, pa2, pa3); pv_one<1>(o[1], vb, pa0, pa1, pa2, pa3); pv_one<2>(o[2], vb, pa0, pa1, pa2, pa3); pv_one<3>(o[3], vb, pa0, pa1, pa2, pa3);
}
__device__ __forceinline__ void attn_dense_body(const bf16_t* __restrict__ Qb, const bf16_t* __restrict__ Kh, const bf16_t* __restrict__ Vh,
                                                bf16_t* __restrict__ Ob, int seq, char* lds) {
  const int tid = tid_(), wid = tid >> 6, lane = tid & 63, r32 = lane & 31, hi = lane >> 5;
  bf16_t* V_lds = (bf16_t*)lds; bf16_t* K_lds = (bf16_t*)(lds + 2 * SHM_V);
  float* ws = (float*)(lds + 2 * SHM_V + 2 * SHM_K) + wid * 64; float* li_l = ws; float* al_l = ws + 32;
  float m_reg = -1e30f, l_reg = 0; f32x16 o[4] = {}; bf16x8 qr[8];
  const bf16_t* Qw = Qb + (long)(wid * QBLK + r32) * LDQ + hi * 8;
_Pragma("unroll") for (int d0 = 0; d0 < 8; ++d0) qr[d0] = *reinterpret_cast<const bf16x8*>(Qw + d0 * 16);
  const int sr = tid >> 4, sc = (tid & 15) * 8, vst0 = v_st(sr, sc), vst1 = v_st(32 + sr, sc);
  const int vb0 = (int)(uintptr_t)V_lds + v_rd_base(lane);
  struct { bf16x8 vs0, vs1, ks0, ks1; } sr_[2];
#define SLOAD(i, k0) do { sr_[i].vs0 = *(const bf16x8*)(&Vh[(long)((k0) + sr) * LDK + sc]); sr_[i].vs1 = *(const bf16x8*)(&Vh[(long)((k0) + 32 + sr) * LDK + sc]); \
    sr_[i].ks0 = *(const bf16x8*)(&Kh[(long)((k0) + sr) * LDK + sc]); sr_[i].ks1 = *(const bf16x8*)(&Kh[(long)((k0) + 32 + sr) * LDK + sc]); } while (0)
#define SWRITE(b, i) do { *(bf16x8*)((char*)V_lds + (b) * SHM_V + vst0) = sr_[i].vs0;          \
    *(bf16x8*)((char*)V_lds + (b) * SHM_V + vst1) = sr_[i].vs1; int kc = sc * 2;               \
    *(bf16x8*)((char*)K_lds + (b) * SHM_K + KSWZ(sr, kc)) = sr_[i].ks0;                       \
    *(bf16x8*)((char*)K_lds + (b) * SHM_K + KSWZ(32 + sr, kc)) = sr_[i].ks1; } while (0)
#define SWAIT() asm volatile("s_waitcnt vmcnt(4)" ::: "memory")
#define RESC(a) do { if (__any((a) < 1.f)) { if (hi == 0) al_l[r32] = (a); asm volatile("s_waitcnt lgkmcnt(0)" ::: "memory"); \
    _Pragma("unroll") for (int d = 0; d < 4; ++d) _Pragma("unroll") for (int r = 0; r < 16; ++r) o[d][r] *= al_l[crow(r, hi)]; } } while (0)
  f32x16 pA0, pA1, pB0, pB1; float mnA, mnB, alA, alB; bf16x8 pa0, pa1, pa2, pa3; const int NT = seq / KVBLK;
  constexpr int SE = 0, SO = 1;
  SLOAD(SE, 0); asm volatile("s_waitcnt vmcnt(0)" ::: "memory"); SWRITE(0, SE); __syncthreads();
  qkt(pA0, pA1, K_lds, qr, r32, hi); partialSM(pA0, pA1, m_reg, mnA, alA);
  SLOAD(SO, KVBLK); if (2 < NT) SLOAD(SE, 2 * KVBLK);
  SWAIT(); SWRITE(1, SO); __syncthreads();
  for (int j = 1; j + 1 < NT; j += 2) {
    SBAR(); qkt(pB0, pB1, (bf16_t*)((char*)K_lds + SHM_K), qr, r32, hi);
    finishSM(pA0, pA1, alA, l_reg, pa0, pa1, pa2, pa3); SBAR();
    SLOAD(SO, (j + 2) * KVBLK); SBAR();
    pv_d0(o, vb0, pa0, pa1, pa2, pa3); partialSM(pB0, pB1, m_reg, mnB, alB);
    __syncthreads(); SWAIT(); SWRITE(0, SE);
    RESC(alB); __syncthreads();
    SBAR(); qkt(pA0, pA1, K_lds, qr, r32, hi);
    finishSM(pB0, pB1, alB, l_reg, pa0, pa1, pa2, pa3); SBAR();
    if (j + 3 < NT) SLOAD(SE, (j + 3) * KVBLK); SBAR();
    pv_d0(o, vb0 + (int)SHM_V, pa0, pa1, pa2, pa3); partialSM(pA0, pA1, m_reg, mnA, alA);
    __syncthreads(); SWAIT(); SWRITE(1, SO);
    RESC(alA); __syncthreads();
  }
  SBAR(); qkt(pB0, pB1, (bf16_t*)((char*)K_lds + SHM_K), qr, r32, hi);
  finishSM(pA0, pA1, alA, l_reg, pa0, pa1, pa2, pa3); SBAR();
  pv_d0(o, vb0, pa0, pa1, pa2, pa3); partialSM(pB0, pB1, m_reg, mnB, alB);
  __syncthreads(); RESC(alB);
  finishSM(pB0, pB1, alB, l_reg, pa0, pa1, pa2, pa3); SBAR();
  pv_d0(o, vb0 + (int)SHM_V, pa0, pa1, pa2, pa3);
  if (hi == 0) li_l[r32] = l_reg; asm volatile("s_waitcnt lgkmcnt(0)" ::: "memory");
  float rli[16];
_Pragma("unroll") for (int r = 0; r < 16; ++r) rli[r] = __builtin_amdgcn_rcpf(li_l[crow(r, hi)]);
  bf16_t* Ow = Ob + (long)(wid * QBLK) * LDO;
_Pragma("unroll") for (int r = 0; r < 16; ++r) { int orow = crow(r, hi);
    _Pragma("unroll") for (int d0 = 0; d0 < 4; ++d0) Ow[(long)orow * LDO + d0 * 32 + r32] = f2bf(o[d0][r] * rli[r]); }
#undef SLOAD
#undef SWRITE
#undef SWAIT
#undef RESC
}
}

__device__ __forceinline__ void mod_gemv(const P& p, unsigned char* lds, int l_lo, int l_hi, int wg, int nwg) {
  const int tid = tid_();
  float* MOD = (float*)(p.ws + OFF_MOD);
  float* sc = (float*)lds;
  float* red = sc + 9 * 1024;
  for (int i = tid; i < 9 * 1024; i += 512) { const int r = i >> 10, k = i & 1023; const float v = r < 8 ? p.c[r * 1024 + k] : p.c_ctx[k]; sc[i] = v / (1.f + expf(-v)); }
  __syncthreads();
  const int ng = tid & 31, kg = tid >> 5;
  for (int it = wg < 0 ? l_hi * 48 : l_lo * 48 + wg; it < l_hi * 48; it += nwg) {
    const int l = it / 48, nb = (it % 48) * 128;
    const float* w = p.w_mod + ((size_t)l * 1024 + kg * 64) * 6144 + nb + ng * 4;
    float acc[9][4];
#pragma unroll
    for (int r = 0; r < 9; ++r) { acc[r][0] = 0.f; acc[r][1] = 0.f; acc[r][2] = 0.f; acc[r][3] = 0.f; }
#pragma unroll 4
    for (int k = 0; k < 64; ++k) {
      const f32x4 wv = *(const f32x4*)(w + (size_t)k * 6144);
#pragma unroll
      for (int r = 0; r < 9; ++r) { const float s = sc[r * 1024 + kg * 64 + k]; acc[r][0] += s * wv[0]; acc[r][1] += s * wv[1]; acc[r][2] += s * wv[2]; acc[r][3] += s * wv[3]; }
    }
#pragma unroll
    for (int r = 0; r < 9; ++r) { float* d = red + (kg * 9 + r) * 128 + ng * 4; d[0] = acc[r][0]; d[1] = acc[r][1]; d[2] = acc[r][2]; d[3] = acc[r][3]; }
    __syncthreads();
    for (int o = tid; o < 9 * 128; o += 512) { const int r = o >> 7, n = o & 127; float s = 0.f;
      for (int g = 0; g < 16; ++g) s += red[(g * 9 + r) * 128 + n];
      MOD[(size_t)(l * 9 + r) * 6144 + nb + n] = s + p.b_mod[l * 6144 + nb + n]; }
    __syncthreads();
  }
}
__device__ __forceinline__ void ph0(const P& p, unsigned char* lds) {
  mod_gemv(p, lds, 0, 1, bid_(), (int)gridDim.x);
  const int tid = tid_();
  const int gtid = bid_() * 512 + tid, gsz = gridDim.x * 512;
  float* LB = (float*)(p.ws + OFF_LB);
  for (int i = gtid; i < 1024; i += gsz) { const float a0 = p.hg_lb[i], a1 = p.hg_lb[1024 + i]; LB[i] = 0.f; LB[1024 + i] = 1.f / (1.f + expf(a0 - a1)); }
  { float* ROPE = (float*)(p.ws + OFF_ROPE);
    for (int i = gtid; i < 64 * 32; i += gsz) { const int pos = i >> 5, j = i & 31; const float fr = exp2f(-(float)j * (13.287712379549449f / 32.f)); float sn, cs; sincosf((float)pos * fr, &sn, &cs); ROPE[2 * i] = cs; ROPE[2 * i + 1] = sn; } }
  bf16_t* CM256 = (bf16_t*)(p.ws + OFF_CM256);
  for (int i = gtid; i < 256 * 256; i += gsz) { const int k = i >> 8, j = i & 255; float s, c; sincospif((float)((k * j) & 255) * (1.f / 128.f), &s, &c);
    CM256[k * 512 + j] = f2bf(c * 0.0625f); CM256[k * 512 + 256 + j] = f2bf(-s * 0.0625f); }
}

__device__ __forceinline__ void modulate_rows(const P& p, int l, int which, int nrows, bool first, const float* fixP, const float* fixG) {
  const int tid = tid_(), wave = tid >> 6, lane = tid & 63;
  const GA float* MOD = (const GA float*)(p.ws + OFF_MOD);
  GA float* CX = (GA float*)(p.ws + OFF_CTXR);
  GA bf16_t* HB = (GA bf16_t*)(p.ws + OFF_HB);
  for (int row0 = bid_() * 16 + wave; row0 < nrows; row0 += gridDim.x * 16) {
    const bool lat = row0 < NLAT;
    const GA float* src = (const GA float*)(first ? (lat ? p.x + (size_t)row0 * 1024 : p.ctx + (size_t)(row0 - NLAT) * 1024) : (lat ? p.out + (size_t)row0 * 1024 : (float*)CX + (size_t)(row0 - NLAT) * 1024));
    f32x4 v[2][4]; float ss0 = 0.f, ss1 = 0.f;
#pragma unroll
    for (int j = 0; j < 4; ++j) { v[0][j] = *(const GA f32x4*)(src + j * 256 + lane * 4); v[1][j] = *(const GA f32x4*)(src + 8 * 1024 + j * 256 + lane * 4); }
    if (!lat && fixP) {
      const GA float* P0 = (const GA float*)fixP + (size_t)(row0 - NLAT) * 1024; const GA float* G0 = (const GA float*)fixG; GA float* xw = CX + (size_t)(row0 - NLAT) * 1024;
#pragma unroll
      for (int j = 0; j < 4; ++j) { const int col = j * 256 + lane * 4; const f32x4 g4 = *(const GA f32x4*)(G0 + col);
        v[0][j] += g4 * (*(const GA f32x4*)(P0 + col) + *(const GA f32x4*)(P0 + (size_t)NCTX * 1024 + col));
        v[1][j] += g4 * (*(const GA f32x4*)(P0 + 8 * 1024 + col) + *(const GA f32x4*)(P0 + (size_t)NCTX * 1024 + 8 * 1024 + col));
        *(GA f32x4*)(xw + col) = v[0][j]; *(GA f32x4*)(xw + 8 * 1024 + col) = v[1][j]; }
    }
    const GA float* sh = MOD + (size_t)(l * 9 + (lat ? (row0 >> 12) : 8)) * 6144 + (which ? 3072 : 0);
    f32x4 s4[4], c4[4];
#pragma unroll
    for (int j = 0; j < 4; ++j) { s4[j] = *(const GA f32x4*)(sh + j * 256 + lane * 4); c4[j] = *(const GA f32x4*)(sh + 1024 + j * 256 + lane * 4); }
#pragma unroll
    for (int j = 0; j < 4; ++j) { ss0 += v[0][j][0] * v[0][j][0] + v[0][j][1] * v[0][j][1] + v[0][j][2] * v[0][j][2] + v[0][j][3] * v[0][j][3];
      ss1 += v[1][j][0] * v[1][j][0] + v[1][j][1] * v[1][j][1] + v[1][j][2] * v[1][j][2] + v[1][j][3] * v[1][j][3]; }
    ss0 = wave_sum(ss0); ss1 = wave_sum(ss1);
    const float rs0 = rsqrtf(ss0 * (1.f / 1024.f) + EPS), rs1 = rsqrtf(ss1 * (1.f / 1024.f) + EPS);
    if (first) { GA float* dst = (GA float*)(lat ? p.out + (size_t)row0 * 1024 : (float*)CX + (size_t)(row0 - NLAT) * 1024);
#pragma unroll
      for (int j = 0; j < 4; ++j) { *(GA f32x4*)(dst + j * 256 + lane * 4) = v[0][j]; *(GA f32x4*)(dst + 8 * 1024 + j * 256 + lane * 4) = v[1][j]; } }
#pragma unroll
    for (int j = 0; j < 4; ++j) { const int col = j * 256 + lane * 4;
      f32x4 h0, h1; for (int q = 0; q < 4; ++q) { h0[q] = v[0][j][q] * rs0 * (1.f + c4[j][q]) + s4[j][q]; h1[q] = v[1][j][q] * rs1 * (1.f + c4[j][q]) + s4[j][q]; }
      u32x2 w0, w1; w0.x = cvt_pk_bf16(h0[0], h0[1]); w0.y = cvt_pk_bf16(h0[2], h0[3]); w1.x = cvt_pk_bf16(h1[0], h1[1]); w1.y = cvt_pk_bf16(h1[2], h1[3]);
      *(GA u32x2*)(HB + (size_t)row0 * 1024 + col) = w0; *(GA u32x2*)(HB + (size_t)(row0 + 8) * 1024 + col) = w1; }
  }
}

__device__ __forceinline__ void convert_weights(const P& p, int l, unsigned char* lds, int wg, int nwg, int jlo = 0, int jhi = 4) {
  float* tile = (float*)lds;
  const int tid = tid_(), e = l >> 1; const bool even = !(l & 1);
  bf16_t* W1 = (bf16_t*)(p.ws + OFF_W1); bf16_t* W2 = (bf16_t*)(p.ws + OFF_W2); bf16_t* W3 = (bf16_t*)(p.ws + OFF_W3); bf16_t* W4 = (bf16_t*)(p.ws + ((l & 1) ? OFF_W4B : OFF_W4));
  if (wg < 0) return;
  int base = 0;
#pragma unroll 1
  for (int j = jlo; j < jhi; ++j) {
    const float* W; int K, N, ldw; bf16_t* Wt;
    if (j == 0) { if (even) { W = p.w_in_ab + (size_t)e * 1024 * 3072 + 512; K = 1024; N = 2560; ldw = 3072; Wt = W1 + 1024 * 1024; } else { W = p.w_qkv + (size_t)e * 1024 * 1536; K = 1024; N = 1536; ldw = 1536; Wt = W1; } }
    else if (j == 1) { W = (even ? p.w_out_ab : p.w_out_att) + (size_t)e * 1024 * 1024; K = 1024; N = 1024; ldw = 1024; Wt = W2; }
    else if (j == 2) { W = p.w_up + (size_t)l * 1024 * 5632; K = 1024; N = 5632; ldw = 5632; Wt = W3; }
    else { W = p.w_down + (size_t)l * 2816 * 1024; K = 2816; N = 1024; ldw = 1024; Wt = W4; }
    const int tn = N / 64, nt = (K / 64) * tn;
    int t0 = (wg - base) % nwg; if (t0 < 0) t0 += nwg;
    for (int t = t0; t < nt; t += nwg) {
      const int k0 = (t / tn) * 64, n0 = (t % tn) * 64;
#pragma unroll
      for (int i = 0; i < 2; ++i) { const int idx = tid + i * 512, kr = idx >> 4, nc = (idx & 15) * 4;
        const f32x4 v = *(const f32x4*)(W + (size_t)(k0 + kr) * ldw + n0 + nc);
        tile[kr * 65 + nc] = v[0]; tile[kr * 65 + nc + 1] = v[1]; tile[kr * 65 + nc + 2] = v[2]; tile[kr * 65 + nc + 3] = v[3]; }
      __syncthreads();
      { const int n = tid >> 3, kg = (tid & 7) * 8; u32x4 w;
        w.x = cvt_pk_bf16(tile[(kg + 0) * 65 + n], tile[(kg + 1) * 65 + n]); w.y = cvt_pk_bf16(tile[(kg + 2) * 65 + n], tile[(kg + 3) * 65 + n]);
        w.z = cvt_pk_bf16(tile[(kg + 4) * 65 + n], tile[(kg + 5) * 65 + n]); w.w = cvt_pk_bf16(tile[(kg + 6) * 65 + n], tile[(kg + 7) * 65 + n]);
        *(u32x4*)(Wt + (size_t)(n0 + n) * K + k0 + kg) = w; }
      __syncthreads();
    }
    base = (base + nt) % nwg;
  }
}

__device__ __forceinline__ void fold_dft(const P& p, int e, unsigned char* lds, int wg, int nwg) {
  LAS3 float* wt = (LAS3 float*)lds;
  LAS3 float* tc = wt + 16 * 129; LAS3 float* ts = tc + 128;
  const int tid = tid_();
  GA bf16_t* W1 = (GA bf16_t*)(p.ws + OFF_W1);
  const GA float* Wa = (const GA float*)(p.w_in_ab + (size_t)e * 1024 * 3072);
  __syncthreads();
  if (tid < 128) { float s, c; sincospif((float)tid * (1.f / 64.f), &s, &c); tc[tid] = c * 0.08838834764831845f; ts[tid] = s * 0.08838834764831845f; }
  for (int t = wg < 0 ? 256 : wg; t < 256; t += nwg) {
    const int kk0 = (t >> 2) * 16, g = t & 3;
    __syncthreads();
    for (int i = tid; i < 16 * 128; i += 512) { const int r = i >> 7, c = i & 127; wt[r * 129 + c] = Wa[(size_t)(kk0 + r) * 3072 + g * 128 + c]; }
    __syncthreads();
    const int kk = tid & 15, mw = tid >> 4;
    float ac[4], as[4];
#pragma unroll
    for (int i = 0; i < 4; ++i) { ac[i] = 0.f; as[i] = 0.f; }
    for (int c = 0; c < 128; ++c) { const float w = wt[kk * 129 + c];
#pragma unroll
      for (int i = 0; i < 4; ++i) { const int idx = (c * (mw + 32 * i)) & 127; ac[i] += w * tc[idx]; as[i] += w * ts[idx]; } }
#pragma unroll
    for (int i = 0; i < 4; ++i) { const int m = mw + 32 * i;
      W1[(size_t)(g * 128 + m) * 1024 + kk0 + kk] = f2bf(ac[i]); W1[(size_t)(512 + g * 128 + m) * 1024 + kk0 + kk] = f2bf(as[i]); }
  }
  __syncthreads();
}
__device__ __forceinline__ void gen_cm(const P& p, unsigned char* lds) {
  LAS3 bf16_t* tcos = (LAS3 bf16_t*)lds; LAS3 bf16_t* tsin = tcos + 4096;
  const int tid = tid_();
  __syncthreads();
  for (int j = tid; j < 4096; j += 512) { float s, c; sincospif((float)j * (1.f / 2048.f), &s, &c); tcos[j] = f2bf(c * 0.015625f); tsin[j] = f2bf(-s * 0.015625f); }
  __syncthreads();
  GA bf16_t* CM2 = (GA bf16_t*)(p.ws + OFF_CM2);
  const int gsz = gridDim.x * 512;
  for (int it = bid_() * 512 + tid; it < 4096 * 512; it += gsz) {
    const int k = it >> 9, j0 = (it & 511) * 8; unsigned w[4];
    const bool sinp = j0 >= 2048; const int jb = sinp ? j0 - 2048 : j0;
#pragma unroll
    for (int j = 0; j < 4; ++j) { const int i0 = (k * (jb + 2 * j)) & 4095, i1 = (i0 + k) & 4095;
      unsigned lo = sinp ? (unsigned)tsin[i0] : (unsigned)tcos[i0]; const unsigned hi = sinp ? (unsigned)tsin[i1] : (unsigned)tcos[i1];
      if (j == 0 && j0 == 2048) lo = (unsigned)tcos[(k * 2048) & 4095];
      w[j] = lo | (hi << 16); }
    u32x4 wv = {w[0], w[1], w[2], w[3]};
    *(GA u32x4*)(CM2 + (size_t)k * 4096 + j0) = wv;
  }
  __syncthreads();
}
__device__ __forceinline__ void ph_fold(const P& p, unsigned char* lds) {
  LAS3 bf16_t* T = (LAS3 bf16_t*)lds;
  const int tid = tid_();
  const GA bf16_t* Z = (const GA bf16_t*)(p.ws + OFF_ZT); GA bf16_t* ZF = (GA bf16_t*)(p.ws + OFF_ZF);
  const int tl = tid >> 3, mg = (tid & 7) * 8;
  const int mo = tid >> 3, tg = (tid & 7) * 8;
  for (int it = bid_(); it < 4096; it += gridDim.x) {
    const int part = it & 1, mt = (it >> 1) & 7, tt = (it >> 4) & 31, b = it >> 9;
    const int t = tt * 64 + tl, m0 = mt * 64;
    const GA bf16_t* zb = Z + (size_t)b * 4096 * 1024 + part * 512 + m0 + mg;
    u32x4 A = *(const GA u32x4*)(zb + (size_t)t * 1024);
    const u32x4 Bm = *(const GA u32x4*)(zb + (size_t)((4096 - t) & 4095) * 1024);
    if (part == 1 && t == 0) A = *(const GA u32x4*)(Z + ((size_t)b * 4096 + 2048) * 1024 + m0 + mg);
    unsigned o[4];
#pragma unroll
    for (int q = 0; q < 4; ++q) {
      float lo = bflo(A[q]), hi = bfhi(A[q]);
      if (t != 0) { if (part == 0) { lo += bflo(Bm[q]); hi += bfhi(Bm[q]); } else { lo -= bflo(Bm[q]); hi -= bfhi(Bm[q]); } }
      o[q] = cvt_pk_bf16(lo, hi);
    }
    __syncthreads();
#pragma unroll
    for (int q = 0; q < 4; ++q) *(LAS3 unsigned*)(T + tl * 66 + mg + 2 * q) = o[q];
    __syncthreads();
    unsigned w[4];
#pragma unroll
    for (int q = 0; q < 4; ++q) w[q] = (unsigned)T[(tg + 2 * q) * 66 + mo] | ((unsigned)T[(tg + 2 * q + 1) * 66 + mo] << 16);
    u32x4 wv = {w[0], w[1], w[2], w[3]};
    *(GA u32x4*)(ZF + ((size_t)b * 512 + m0 + mo) * 4096 + part * 2048 + tt * 64 + tg) = wv;
  }
  __syncthreads();
}

__device__ __forceinline__ int tcidx(int tb, int dir) { return dir ? (tb < 4 ? 3 - tb : 71 - tb) : tb; }
__device__ __forceinline__ int rowbase_of(int b, int tb) { return tb < 4 ? NLAT + b * 256 + tb * 64 : b * 4096 + (tb - 4) * 64; }
__device__ __forceinline__ void chunk_cumsum(const GA _Float16* LFc, int rowbase, int dir, int tq, int kch, LAS3 float* totl, float (&lf)[16], float (&bc)[16], float& T0, float& T1, float& T2, float& T3) {
#pragma unroll
  for (int i = 0; i < 16; ++i) { const int tau = 16 * tq + i, pp = dir ? 63 - tau : tau; lf[i] = (float)LFc[(size_t)(rowbase + pp) * 512]; }
  float run = 0.f;
#pragma unroll
  for (int i = 0; i < 16; ++i) { run += lf[i]; bc[i] = run; }
  totl[tq * 128 + kch] = run;
  __syncthreads();
  T0 = totl[kch]; T1 = totl[128 + kch]; T2 = totl[256 + kch]; T3 = totl[384 + kch];
  const float off = tq == 0 ? 0.f : (tq == 1 ? T0 : (tq == 2 ? T0 + T1 : T0 + T1 + T2));
#pragma unroll
  for (int i = 0; i < 16; ++i) bc[i] += off;
}
typedef unsigned short us2_t __attribute__((ext_vector_type(2)));
#define US2U(v) __builtin_bit_cast(unsigned, v)
__device__ __forceinline__ void ld16(unsigned& r, const bf16_t* sbase, unsigned voff) { asm volatile("global_load_ushort %0, %1, %2" : "=v"(r) : "v"(voff), "s"(sbase)); }
#define RAW_WAIT16(a) asm volatile("s_waitcnt vmcnt(0)" : "+v"(a[0]), "+v"(a[1]), "+v"(a[2]), "+v"(a[3]), "+v"(a[4]), "+v"(a[5]), "+v"(a[6]), "+v"(a[7]), \
    "+v"(a[8]), "+v"(a[9]), "+v"(a[10]), "+v"(a[11]), "+v"(a[12]), "+v"(a[13]), "+v"(a[14]), "+v"(a[15]) :: "memory")
__device__ __forceinline__ void pack2(const unsigned (&r)[16], us2_t (&pk)[8]) {
#pragma unroll
  for (int i = 0; i < 8; ++i) { pk[i].x = (unsigned short)r[2 * i]; pk[i].y = (unsigned short)r[2 * i + 1]; }
}
__device__ __forceinline__ void h1_load_raw(const P& p, int rowbase, int h, int dir, int tq, int kch, unsigned (&lfr)[16], unsigned (&vr)[16]) {
  const bf16_t* LFb = (const bf16_t*)(p.ws + (dir ? OFF_LF1 : OFF_LF0)) + (size_t)rowbase * 512 + h * 128;
  const bf16_t* Vb = (const bf16_t*)(p.ws + OFF_V) + (size_t)rowbase * 512 + h * 128;
#pragma unroll
  for (int i = 0; i < 16; ++i) { const int tau = 16 * tq + i, pp = dir ? 63 - tau : tau; const unsigned o0 = (unsigned)(pp * 1024 + kch * 2); ld16(lfr[i], LFb, o0); ld16(vr[i], Vb, o0); }
}
__device__ __forceinline__ void h3_load_raw(const P& p, int rowbase, int h, int dir, int tq, int kch, unsigned (&lfr)[16], unsigned (&qr)[16]) {
  const bf16_t* LFb = (const bf16_t*)(p.ws + (dir ? OFF_LF1 : OFF_LF0)) + (size_t)rowbase * 512 + h * 128;
  const bf16_t* Qb = (const bf16_t*)(p.ws + OFF_Q) + (size_t)rowbase * 512 + h * 128;
#pragma unroll
  for (int i = 0; i < 16; ++i) { const int tau = 16 * tq + i, pp = dir ? 63 - tau : tau; const unsigned o0 = (unsigned)(pp * 1024 + kch * 2); ld16(lfr[i], LFb, o0); ld16(qr[i], Qb, o0); }
}
__device__ __forceinline__ void h_load_raw(const P& p, int rowbase, int h, int dir, int tq, int kch, bool needq, us2_t (&lfr)[8], us2_t (&vr)[8], us2_t (&qr)[8]) {
  const GA bf16_t* LFc = (const GA bf16_t*)(p.ws + (dir ? OFF_LF1 : OFF_LF0)) + h * 128 + kch;
  const GA bf16_t* V = (const GA bf16_t*)(p.ws + OFF_V) + h * 128 + kch; const GA bf16_t* Q = (const GA bf16_t*)(p.ws + OFF_Q) + h * 128 + kch;
#pragma unroll
  for (int i = 0; i < 8; ++i) { const int tau = 16 * tq + 2 * i, p0 = dir ? 63 - tau : tau, p1 = dir ? p0 - 1 : p0 + 1; const size_t g0 = (size_t)(rowbase + p0) * 512, g1 = (size_t)(rowbase + p1) * 512;
    lfr[i].x = LFc[g0]; lfr[i].y = LFc[g1]; vr[i].x = V[g0]; vr[i].y = V[g1]; if (needq) { qr[i].x = Q[g0]; qr[i].y = Q[g1]; } }
}
__device__ __forceinline__ float h16bits(unsigned short w) { return (float)__builtin_bit_cast(_Float16, w); }
__device__ __forceinline__ void chunk_cumsum_raw(const us2_t (&lfr)[8], int tq, int kch, LAS3 float* totl, float (&lf)[16], float (&bc)[16], float& T0, float& T1, float& T2, float& T3) {
  float run = 0.f;
#pragma unroll
  for (int i = 0; i < 16; ++i) { lf[i] = h16bits((i & 1) ? lfr[i >> 1].y : lfr[i >> 1].x); run += lf[i]; bc[i] = run; }
  totl[tq * 128 + kch] = run;
  __syncthreads();
  T0 = totl[kch]; T1 = totl[128 + kch]; T2 = totl[256 + kch]; T3 = totl[384 + kch];
  const float off = tq == 0 ? 0.f : (tq == 1 ? T0 : (tq == 2 ? T0 + T1 : T0 + T1 + T2));
#pragma unroll
  for (int i = 0; i < 16; ++i) bc[i] += off;
}
__device__ __forceinline__ void ph_h1(const P& p, unsigned char* lds) {
  const int tid = tid_(), wid = tid >> 6, lane = tid & 63, r32 = lane & 31, hi = lane >> 5, kch = tid & 127, tq = tid >> 7;
  LAS3 bf16_t* KD = (LAS3 bf16_t*)lds;
  LAS3 bf16_t* VT = KD + 128 * 72;
  LAS3 float* totl = (LAS3 float*)(VT + 128 * 72);
  const GA bf16_t* V = (const GA bf16_t*)(p.ws + OFF_V);
  GA bf16_t* ST = (GA bf16_t*)(p.ws + OFF_ST); GA float* DEC = (GA float*)(p.ws + OFF_DEC);
  const int ti = wid >> 1;
  const int GS = gridDim.x;
  us2_t lfA[8], vv[8]; unsigned lfN[16], vN[16];
  { const int it0 = bid_(); if (it0 < 4352) { const int rest = it0 >> 3; h1_load_raw(p, rowbase_of(rest / 68, rest % 68), (it0 >> 1) & 3, it0 & 1, tq, kch, lfN, vN); RAW_WAIT16(lfN); RAW_WAIT16(vN); pack2(lfN, lfA); pack2(vN, vv); } }
  for (int it = bid_(); it < 4352; it += GS) {
    const int dir = it & 1, h = (it >> 1) & 3, rest = it >> 3, tb = rest % 68, b = rest / 68;
    const int tc = tcidx(tb, dir), stream = (b * 4 + h) * 2 + dir;
    { const int itn = it + GS; if (itn < 4352) { const int restn = itn >> 3; h1_load_raw(p, rowbase_of(restn / 68, restn % 68), (itn >> 1) & 3, itn & 1, tq, kch, lfN, vN); } }
    float lf[16], bc[16], T0, T1, T2, T3;
    chunk_cumsum_raw(lfA, tq, kch, totl, lf, bc, T0, T1, T2, T3);
    const float blast = T0 + T1 + T2 + T3;
    float kd[16];
#pragma unroll
    for (int i = 0; i < 16; ++i) kd[i] = (1.f - __expf(lf[i])) * __expf(blast - bc[i]);
    u32x4 w0, w1;
    w0.x = cvt_pk_bf16(kd[0], kd[1]); w0.y = cvt_pk_bf16(kd[2], kd[3]); w0.z = cvt_pk_bf16(kd[4], kd[5]); w0.w = cvt_pk_bf16(kd[6], kd[7]);
    w1.x = cvt_pk_bf16(kd[8], kd[9]); w1.y = cvt_pk_bf16(kd[10], kd[11]); w1.z = cvt_pk_bf16(kd[12], kd[13]); w1.w = cvt_pk_bf16(kd[14], kd[15]);
    *(LAS3 u32x4*)(KD + kch * 72 + 16 * tq) = w0; *(LAS3 u32x4*)(KD + kch * 72 + 16 * tq + 8) = w1;
    w0.x = US2U(vv[0]); w0.y = US2U(vv[1]); w0.z = US2U(vv[2]); w0.w = US2U(vv[3]); w1.x = US2U(vv[4]); w1.y = US2U(vv[5]); w1.z = US2U(vv[6]); w1.w = US2U(vv[7]);
    *(LAS3 u32x4*)(VT + kch * 72 + 16 * tq) = w0; *(LAS3 u32x4*)(VT + kch * 72 + 16 * tq + 8) = w1;
    if (tq == 0) DEC[(size_t)(stream * 68 + tc) * 128 + kch] = __expf(blast);
    __syncthreads();
    GA bf16_t* UT = ST + (size_t)(stream * 68 + tc) * 16384;
#pragma unroll
    for (int jj = 0; jj < 2; ++jj) {
      const int tj = (wid & 1) * 2 + jj;
      f32x16 acc = {};
#pragma unroll
      for (int ks = 0; ks < 4; ++ks) {
        const bf16x8 a = *(const LAS3 bf16x8*)(KD + (32 * ti + r32) * 72 + ks * 16 + hi * 8);
        const bf16x8 bq = *(const LAS3 bf16x8*)(VT + (32 * tj + r32) * 72 + ks * 16 + hi * 8);
        acc = __builtin_amdgcn_mfma_f32_32x32x16_bf16(a, bq, acc, 0, 0, 0);
      }
#pragma unroll
      for (int rg = 0; rg < 4; ++rg) { u32x2 w; w.x = cvt_pk_bf16(acc[4 * rg], acc[4 * rg + 1]); w.y = cvt_pk_bf16(acc[4 * rg + 2], acc[4 * rg + 3]);
        *(GA u32x2*)(UT + (size_t)(32 * tj + r32) * 128 + 32 * ti + 8 * rg + 4 * hi) = w; }
    }
    if (it + GS < 4352) { RAW_WAIT16(lfN); RAW_WAIT16(vN); pack2(lfN, lfA); pack2(vN, vv); }
  }
}
__device__ __forceinline__ void ph_h2(const P& p) {
  GA bf16_t* ST = (GA bf16_t*)(p.ws + OFF_ST); const GA float* DEC = (const GA float*)(p.ws + OFF_DEC);
  for (int idx = bid_() * 512 + tid_(); idx < 64 * 2048; idx += gridDim.x * 512) {
    const int stream = idx >> 11, e8 = idx & 2047, k0 = (e8 & 15) * 8;
    GA bf16_t* base = ST + (size_t)stream * 68 * 16384 + e8 * 8; const GA float* dec = DEC + (size_t)stream * 68 * 128 + k0;
    float S[8];
#pragma unroll
    for (int j = 0; j < 8; ++j) S[j] = 0.f;
#pragma unroll 1
    for (int t0 = 0; t0 < 68; t0 += 4) {
      u32x4 u[4]; f32x4 d0[4], d1[4];
#pragma unroll
      for (int q = 0; q < 4; ++q) { u[q] = *(const GA u32x4*)(base + (size_t)(t0 + q) * 16384); d0[q] = *(const GA f32x4*)(dec + (t0 + q) * 128); d1[q] = *(const GA f32x4*)(dec + (t0 + q) * 128 + 4); }
#pragma unroll
      for (int q = 0; q < 4; ++q) {
        u32x4 w; w.x = cvt_pk_bf16(S[0], S[1]); w.y = cvt_pk_bf16(S[2], S[3]); w.z = cvt_pk_bf16(S[4], S[5]); w.w = cvt_pk_bf16(S[6], S[7]);
        *(GA u32x4*)(base + (size_t)(t0 + q) * 16384) = w;
        S[0] = d0[q][0] * S[0] + bflo(u[q].x); S[1] = d0[q][1] * S[1] + bfhi(u[q].x); S[2] = d0[q][2] * S[2] + bflo(u[q].y); S[3] = d0[q][3] * S[3] + bfhi(u[q].y);
        S[4] = d1[q][0] * S[4] + bflo(u[q].z); S[5] = d1[q][1] * S[5] + bfhi(u[q].z); S[6] = d1[q][2] * S[6] + bflo(u[q].w); S[7] = d1[q][3] * S[7] + bfhi(u[q].w);
      }
    }
  }
}
__device__ __forceinline__ void ph_h3(const P& p, int e, unsigned char* lds) {
  const int tid = tid_(), wid = tid >> 6, lane = tid & 63, r32 = lane & 31, hi = lane >> 5, kch = tid & 127, tq = tid >> 7;
  LAS3 bf16_t* QBt = (LAS3 bf16_t*)lds;
  LAS3 bf16_t* QXt = QBt + 64 * 136;
  LAS3 bf16_t* KXt = QXt + 64 * 136;
  LAS3 bf16_t* YTt = KXt + 64 * 136;
  LAS3 bf16_t* VTt = YTt + 64 * 136;
  LAS3 bf16_t* ATt = VTt + 128 * 72;
  LAS3 float* totl = (LAS3 float*)(ATt + 64 * 72);
  LAS3 float* OT = (LAS3 float*)lds;
  const GA bf16_t* Q = (const GA bf16_t*)(p.ws + OFF_Q); const GA bf16_t* V = (const GA bf16_t*)(p.ws + OFF_V); const GA bf16_t* G = (const GA bf16_t*)(p.ws + OFF_G);
  const GA bf16_t* ST = (const GA bf16_t*)(p.ws + OFF_ST); GA bf16_t* MIX = (GA bf16_t*)(p.ws + OFF_MIX);
  const GA float* gn = (const GA float*)(p.hg_ng + e * 512);
  const int ti = wid >> 2, tj = wid & 3;
  const int GS = gridDim.x;
  us2_t lfA[8], qraw[8]; unsigned lfN[16], qN[16];
  { const int it0 = bid_(); if (it0 < 2176) { const int rest = it0 >> 2; h3_load_raw(p, rowbase_of(rest / 68, rest % 68), it0 & 3, 0, tq, kch, lfN, qN); RAW_WAIT16(lfN); RAW_WAIT16(qN); pack2(lfN, lfA); pack2(qN, qraw); } }
  const int ppv = tid >> 3, cgv = tid & 7;
  for (int it = bid_(); it < 2176; it += GS) {
    const int h = it & 3, rest = it >> 2, tb = rest % 68, b = rest / 68;
    const int rowbase = rowbase_of(b, tb);
    f32x16 o = {};
#pragma unroll 1
    for (int dir = 0; dir < 2; ++dir) {
      const int tc = tcidx(tb, dir), stream = (b * 4 + h) * 2 + dir;
      const GA bf16_t* Sg = ST + (size_t)(stream * 68 + tc) * 16384;
      bf16x8 sfr[8];
#pragma unroll
      for (int ks = 0; ks < 8; ++ks) sfr[ks] = *(const GA bf16x8*)(Sg + (size_t)(32 * tj + r32) * 128 + ks * 16 + hi * 8);
      u32x4 vw0, vw1;
      if (dir == 0) { const GA bf16_t* vp = V + (size_t)(rowbase + ppv) * 512 + h * 128 + cgv * 16; vw0 = *(const GA u32x4*)vp; vw1 = *(const GA u32x4*)(vp + 8); }
      if (dir == 0) h3_load_raw(p, rowbase, h, 1, tq, kch, lfN, qN);
      else { const int itn = it + GS; if (itn < 2176) { const int restn = itn >> 2; h3_load_raw(p, rowbase_of(restn / 68, restn % 68), itn & 3, 0, tq, kch, lfN, qN); } }
      float lf[16], bc[16], T0, T1, T2, T3;
      chunk_cumsum_raw(lfA, tq, kch, totl, lf, bc, T0, T1, T2, T3);
      const float R31 = T0 + T1, refx = tq < 2 ? T0 : R31 + T2;
#pragma unroll 1
      for (int rep_ = 0; rep_ < REP_FILL; ++rep_)
#pragma unroll
      for (int i = 0; i < 16; ++i) {
        const int tau = 16 * tq + i, pp = dir ? 63 - tau : tau;
        const float qv = bf2f((i & 1) ? qraw[i >> 1].y : qraw[i >> 1].x), kkv = 1.f - __expf(lf[i]), bi = bc[i];
        QBt[pp * 136 + kch] = f2bf(qv * __expf(bi));
        QXt[pp * 136 + kch] = f2bf(qv * __expf(fminf(bi - refx, 80.f)));
        KXt[pp * 136 + kch] = f2bf(kkv * __expf(fminf(refx - bi, 80.f)));
        YTt[pp * 136 + kch] = tq < 2 ? f2bf(kkv * __expf(R31 - bi)) : f2bf(qv * __expf(bi - R31));
      }
      if (dir == 0) {
#pragma unroll
        for (int j = 0; j < 8; ++j) { VTt[(cgv * 16 + j) * 72 + ppv] = (bf16_t)((j & 1) ? (vw0[j >> 1] >> 16) : (vw0[j >> 1] & 0xffffu)); VTt[(cgv * 16 + 8 + j) * 72 + ppv] = (bf16_t)((j & 1) ? (vw1[j >> 1] >> 16) : (vw1[j >> 1] & 0xffffu)); }
      }
      __syncthreads();
#pragma unroll
      for (int ks = 0; ks < 8; ++ks) {
        const bf16x8 a = *(const LAS3 bf16x8*)(QBt + (32 * ti + r32) * 136 + ks * 16 + hi * 8);
        o = __builtin_amdgcn_mfma_f32_32x32x16_bf16(a, sfr[ks], o, 0, 0, 0);
      }
      if (wid < 4) {
        const int I = wid >> 1, J = wid & 1;
        const bool diag = (I == J), offd = dir ? (I == 0 && J == 1) : (I == 1 && J == 0);
        f32x16 acc = {};
        if (diag || offd) {
          const LAS3 bf16_t* Ap = diag ? QXt : YTt; const LAS3 bf16_t* Bp = diag ? KXt : YTt;
#pragma unroll
          for (int ks = 0; ks < 8; ++ks) {
            const bf16x8 a = *(const LAS3 bf16x8*)(Ap + (32 * I + r32) * 136 + ks * 16 + hi * 8);
            const bf16x8 bq = *(const LAS3 bf16x8*)(Bp + (32 * J + r32) * 136 + ks * 16 + hi * 8);
            acc = __builtin_amdgcn_mfma_f32_32x32x16_bf16(a, bq, acc, 0, 0, 0);
          }
        }
#pragma unroll
        for (int r = 0; r < 16; ++r) { const int t = (r & 3) + 8 * (r >> 2) + 4 * hi;
          const bool keep = !diag || (dir ? (r32 >= t) : (r32 <= t));
          ATt[(32 * I + t) * 72 + 32 * J + r32] = f2bf(keep ? acc[r] : 0.f); }
      }
      __syncthreads();
#pragma unroll
      for (int ks = 0; ks < 4; ++ks) {
        const bf16x8 a = *(const LAS3 bf16x8*)(ATt + (32 * ti + r32) * 72 + ks * 16 + hi * 8);
        const bf16x8 bq = *(const LAS3 bf16x8*)(VTt + (32 * tj + r32) * 72 + ks * 16 + hi * 8);
        o = __builtin_amdgcn_mfma_f32_32x32x16_bf16(a, bq, o, 0, 0, 0);
      }
      if (dir == 0 || it + GS < 2176) { RAW_WAIT16(lfN); RAW_WAIT16(qN); pack2(lfN, lfA); pack2(qN, qraw); }
    }
#pragma unroll
    for (int r = 0; r < 16; ++r) OT[(32 * ti + (r & 3) + 8 * (r >> 2) + 4 * hi) * 132 + 32 * tj + r32] = o[r];
    __syncthreads();
    {
      const int pp = tid >> 3, seg = tid & 7, row = rowbase + pp;
      float ov[16]; float ss = 0.f;
#pragma unroll
      for (int q = 0; q < 4; ++q) { const f32x4 v4 = *(const LAS3 f32x4*)(OT + pp * 132 + seg * 16 + q * 4); ov[q * 4] = v4[0]; ov[q * 4 + 1] = v4[1]; ov[q * 4 + 2] = v4[2]; ov[q * 4 + 3] = v4[3];
        ss += v4[0] * v4[0] + v4[1] * v4[1] + v4[2] * v4[2] + v4[3] * v4[3]; }
      ss += __shfl_xor(ss, 1); ss += __shfl_xor(ss, 2); ss += __shfl_xor(ss, 4);
      const float rs = rsqrtf(ss * (1.f / 128.f) + EPS);
      const u32x4 g0 = *(const GA u32x4*)(G + (size_t)row * 512 + h * 128 + seg * 16), g1 = *(const GA u32x4*)(G + (size_t)row * 512 + h * 128 + seg * 16 + 8);
      float y[16];
#pragma unroll
      for (int j = 0; j < 8; ++j) { y[j] = ov[j] * rs * gn[h * 128 + seg * 16 + j] * silu_f(UNPK(g0, j)); y[8 + j] = ov[8 + j] * rs * gn[h * 128 + seg * 16 + 8 + j] * silu_f(UNPK(g1, j)); }
      u32x4 w0, w1;
      w0.x = cvt_pk_bf16(y[0], y[1]); w0.y = cvt_pk_bf16(y[2], y[3]); w0.z = cvt_pk_bf16(y[4], y[5]); w0.w = cvt_pk_bf16(y[6], y[7]);
      w1.x = cvt_pk_bf16(y[8], y[9]); w1.y = cvt_pk_bf16(y[10], y[11]); w1.z = cvt_pk_bf16(y[12], y[13]); w1.w = cvt_pk_bf16(y[14], y[15]);
      GA bf16_t* dst = MIX + (size_t)row * 1024 + 512 + h * 128 + seg * 16;
      *(GA u32x4*)dst = w0; *(GA u32x4*)(dst + 8) = w1;
    }
    __syncthreads();
  }
}

__device__ __forceinline__ void ph_normrope(const P& p, int o) {
  const int tid = tid_(), wave = tid >> 6, lane = tid & 63;
  GA bf16_t* QB = (GA bf16_t*)(p.ws + OFF_QB); GA bf16_t* KB = (GA bf16_t*)(p.ws + OFF_KB);
  const GA float* ROPE = (const GA float*)(p.ws + OFF_ROPE);
  const float gq0 = p.qn_g[o * 128 + lane * 2], gq1 = p.qn_g[o * 128 + lane * 2 + 1], gk0 = p.kn_g[o * 128 + lane * 2], gk1 = p.kn_g[o * 128 + lane * 2 + 1];
  for (int row = bid_() * 8 + wave; row < NTOK; row += gridDim.x * 8) {
    GA bf16_t* qp = QB + (size_t)row * 1024 + lane * 2; GA bf16_t* kp = KB + (size_t)kvrow(row) * 256 + lane * 2;
    unsigned w[10];
#pragma unroll
    for (int s_ = 0; s_ < 8; ++s_) w[s_] = *(const GA unsigned*)(qp + s_ * 128);
    w[8] = *(const GA unsigned*)kp; w[9] = *(const GA unsigned*)(kp + 128);
    float cs = 1.f, sn = 0.f;
    if (row < NLAT) { const int t = row & 4095; const int pos = lane < 32 ? (t >> 6) : (t & 63); const GA float* cs2 = ROPE + 2 * (pos * 32 + (lane & 31)); cs = cs2[0]; sn = cs2[1]; }
#pragma unroll
    for (int s_ = 0; s_ < 10; ++s_) {
      const float x0 = bflo(w[s_]), x1 = bfhi(w[s_]);
      const float ss = wave_sum(x0 * x0 + x1 * x1);
      const float rs = rsqrtf(ss * (1.f / 128.f) + EPS);
      const float y0 = x0 * rs * (s_ < 8 ? gq0 : gk0), y1 = x1 * rs * (s_ < 8 ? gq1 : gk1);
      const unsigned ow = cvt_pk_bf16(y0 * cs - y1 * sn, y0 * sn + y1 * cs);
      if (s_ < 8) *(GA unsigned*)(qp + s_ * 128) = ow; else *(GA unsigned*)(kp + (s_ - 8) * 128) = ow;
    }
  }
}

__device__ __forceinline__ void ph_attn(const P& p, bool last, unsigned char* lds) {
  const bf16_t* QB = (const bf16_t*)(p.ws + OFF_QB); const bf16_t* KB = (const bf16_t*)(p.ws + OFF_KB); const bf16_t* VB = (const bf16_t*)(p.ws + OFF_VB);
  bf16_t* MIX = (bf16_t*)(p.ws + OFF_MIX);
#pragma unroll 1
  for (int r = 0; r < (last ? 4 : 5); ++r) {
    const int w = bid_(), bb = w & 7, jj = w >> 3;
    size_t qoff, koff; int seq;
    if (r < 4) { const int idx = r * 32 + jj, h = idx >> 4, qb = idx & 15; qoff = (size_t)(bb * 4096 + qb * 256) * 1024 + h * 128; koff = (size_t)bb * 4352 * 256 + (h >> 2) * 128; seq = 4352; }
    else { if (jj >= 8) break; const int h = jj; qoff = (size_t)(NLAT + bb * 256) * 1024 + h * 128; koff = ((size_t)bb * 4352 + 4096) * 256 + (h >> 2) * 128; seq = 256; }
    att::attn_dense_body(QB + qoff, KB + koff, VB + koff, MIX + qoff, seq, (char*)lds);
    __syncthreads();
  }
}

__device__ __forceinline__ void ph_conv(const P& p, int l, bool last) {
  const bf16_t* GATE = (const bf16_t*)(p.ws + OFF_GATE); bf16_t* VAL = (bf16_t*)(p.ws + OFF_VAL);
  const float* cw = p.conv_w + (size_t)l * 9 * 2816; const float* cb = p.conv_b + (size_t)l * 2816;
  const int gsz = gridDim.x * 512, gtid = bid_() * 512 + tid_();
  const u32x4 Z4 = {0u, 0u, 0u, 0u};
  for (int it = gtid; it < 2 * 8 * 64 * 352; it += gsz) {
    const int cg8 = it % 352; int rest = it / 352; const int col = rest & 63; rest >>= 6; const int b = rest & 7, seg = rest >> 3;
    const int c0 = cg8 * 8;
    float w[9][8], bias[8];
#pragma unroll
    for (int k = 0; k < 9; ++k) { const f32x4 a = *(const f32x4*)(cw + k * 2816 + c0), bq = *(const f32x4*)(cw + k * 2816 + c0 + 4);
      w[k][0] = a[0]; w[k][1] = a[1]; w[k][2] = a[2]; w[k][3] = a[3]; w[k][4] = bq[0]; w[k][5] = bq[1]; w[k][6] = bq[2]; w[k][7] = bq[3]; }
    { const f32x4 a = *(const f32x4*)(cb + c0), bq = *(const f32x4*)(cb + c0 + 4); bias[0] = a[0]; bias[1] = a[1]; bias[2] = a[2]; bias[3] = a[3]; bias[4] = bq[0]; bias[5] = bq[1]; bias[6] = bq[2]; bias[7] = bq[3]; }
    const size_t tb = (size_t)b * 4096;
#define LD3(r, A, Mi, C) do { if ((r) < 0 || (r) > 63) { A = Z4; Mi = Z4; C = Z4; } else { const bf16_t* q_ = GATE + (tb + (r) * 64 + col) * 2816 + c0; \
      Mi = *(const u32x4*)q_; A = col > 0 ? *(const u32x4*)(q_ - 2816) : Z4; C = col < 63 ? *(const u32x4*)(q_ + 2816) : Z4; } } while (0)
    u32x4 p0, p1, p2, q0, q1, q2, n0, n1, n2;
    const int r0 = seg * 32;
    LD3(r0 - 1, p0, p1, p2); LD3(r0, q0, q1, q2);
    for (int r = r0; r < r0 + 32; ++r) {
      LD3(r + 1, n0, n1, n2);
      bf16_t* vp = VAL + (tb + r * 64 + col) * 2816 + c0;
      const u32x4 vv = *(const u32x4*)vp;
      float a[8];
#pragma unroll
      for (int j = 0; j < 8; ++j) {
        float s = bias[j];
        s += w[0][j] * UNPK(p0, j) + w[1][j] * UNPK(p1, j) + w[2][j] * UNPK(p2, j);
        s += w[3][j] * UNPK(q0, j) + w[4][j] * UNPK(q1, j) + w[5][j] * UNPK(q2, j);
        s += w[6][j] * UNPK(n0, j) + w[7][j] * UNPK(n1, j) + w[8][j] * UNPK(n2, j);
        a[j] = silu_f(s) * UNPK(vv, j);
      }
      u32x4 ow; ow.x = cvt_pk_bf16(a[0], a[1]); ow.y = cvt_pk_bf16(a[2], a[3]); ow.z = cvt_pk_bf16(a[4], a[5]); ow.w = cvt_pk_bf16(a[6], a[7]);
      *(u32x4*)vp = ow;
      p0 = q0; p1 = q1; p2 = q2; q0 = n0; q1 = n1; q2 = n2;
    }
#undef LD3
  }
  if (!last) {
    for (int it = gtid; it < 8 * 32 * 352; it += gsz) {
      const int cg8 = it % 352, rest = it / 352, seg = rest & 31, b = rest >> 5, c0 = cg8 * 8, j0 = seg * 8;
      float w3[3][8], bias[8];
#pragma unroll
      for (int k = 0; k < 3; ++k) { const f32x4 wa = *(const f32x4*)(cw + (3 + k) * 2816 + c0), wb = *(const f32x4*)(cw + (3 + k) * 2816 + c0 + 4);
        w3[k][0] = wa[0]; w3[k][1] = wa[1]; w3[k][2] = wa[2]; w3[k][3] = wa[3]; w3[k][4] = wb[0]; w3[k][5] = wb[1]; w3[k][6] = wb[2]; w3[k][7] = wb[3]; }
      { const f32x4 wa = *(const f32x4*)(cb + c0), wb = *(const f32x4*)(cb + c0 + 4); bias[0] = wa[0]; bias[1] = wa[1]; bias[2] = wa[2]; bias[3] = wa[3]; bias[4] = wb[0]; bias[5] = wb[1]; bias[6] = wb[2]; bias[7] = wb[3]; }
      const size_t row0 = (size_t)NLAT + b * 256 + j0;
      const bf16_t* gq = GATE + row0 * 2816 + c0; bf16_t* vq = VAL + row0 * 2816 + c0;
      u32x4 g[10], vv[8];
#pragma unroll
      for (int i = 0; i < 10; ++i) { const int j = j0 - 1 + i; g[i] = (j >= 0 && j <= 255) ? *(const u32x4*)(gq + (ptrdiff_t)(i - 1) * 2816) : Z4; }
#pragma unroll
      for (int i = 0; i < 8; ++i) vv[i] = *(const u32x4*)(vq + (size_t)i * 2816);
#pragma unroll
      for (int i = 0; i < 8; ++i) {
        float a[8];
#pragma unroll
        for (int j = 0; j < 8; ++j) {
          const float sacc = bias[j] + w3[0][j] * UNPK(g[i], j) + w3[1][j] * UNPK(g[i + 1], j) + w3[2][j] * UNPK(g[i + 2], j);
          a[j] = silu_f(sacc) * UNPK(vv[i], j);
        }
        u32x4 ow; ow.x = cvt_pk_bf16(a[0], a[1]); ow.y = cvt_pk_bf16(a[2], a[3]); ow.z = cvt_pk_bf16(a[4], a[5]); ow.w = cvt_pk_bf16(a[6], a[7]);
        *(u32x4*)(vq + (size_t)i * 2816) = ow;
      }
    }
  }
}

__device__ __forceinline__ void ph_final(const P& p) {
  const int tid = tid_(), wave = tid >> 6, lane = tid & 63;
  f32x4 g4[4];
#pragma unroll
  for (int j = 0; j < 4; ++j) g4[j] = *(const GA f32x4*)((const GA float*)p.fn_g + j * 256 + lane * 4);
  for (int row = bid_() * 16 + wave; row < NLAT; row += gridDim.x * 16) {
    GA float* src = (GA float*)(p.out + (size_t)row * 1024);
    f32x4 v[2][4]; float ss0 = 0.f, ss1 = 0.f;
#pragma unroll
    for (int j = 0; j < 4; ++j) { v[0][j] = *(const GA f32x4*)(src + j * 256 + lane * 4); v[1][j] = *(const GA f32x4*)(src + 8 * 1024 + j * 256 + lane * 4); }
#pragma unroll
    for (int j = 0; j < 4; ++j) { ss0 += v[0][j][0] * v[0][j][0] + v[0][j][1] * v[0][j][1] + v[0][j][2] * v[0][j][2] + v[0][j][3] * v[0][j][3];
      ss1 += v[1][j][0] * v[1][j][0] + v[1][j][1] * v[1][j][1] + v[1][j][2] * v[1][j][2] + v[1][j][3] * v[1][j][3]; }
    ss0 = wave_sum(ss0); ss1 = wave_sum(ss1);
    const float rs0 = rsqrtf(ss0 * (1.f / 1024.f) + EPS), rs1 = rsqrtf(ss1 * (1.f / 1024.f) + EPS);
#pragma unroll
    for (int j = 0; j < 4; ++j) { f32x4 o0, o1; for (int q = 0; q < 4; ++q) { o0[q] = v[0][j][q] * rs0 * g4[j][q]; o1[q] = v[1][j][q] * rs1 * g4[j][q]; }
      *(GA f32x4*)(src + j * 256 + lane * 4) = o0; *(GA f32x4*)(src + 8 * 1024 + j * 256 + lane * 4) = o1; }
  }
}

__device__ __forceinline__ void run_phase(const P& p_in, int l, int ph, unsigned char* lds) {
  const bool even = !(l & 1), last = (l == 3); const int e = l >> 1;
  P p = p_in; asm volatile("" : "+s"(p.ws), "+s"(p.out));
  unsigned char* ws = p.ws;
  const float* MOD = (const float*)(ws + OFF_MOD);
  bf16_t* HB = (bf16_t*)(ws + OFF_HB); bf16_t* MIX = (bf16_t*)(ws + OFF_MIX);
  bf16_t* W1 = (bf16_t*)(ws + OFF_W1); bf16_t* W2 = (bf16_t*)(ws + OFF_W2); bf16_t* W3 = (bf16_t*)(ws + OFF_W3); bf16_t* W4 = (bf16_t*)(ws + OFF_W4);
  const int Mres = last ? NLAT : NTOK;
  if (ph == 0) {
    modulate_rows(p, l, 0, NTOK, l == 0, l > 0 ? (const float*)(ws + OFF_GATE) : nullptr, MOD + (size_t)((l > 0 ? l - 1 : 0) * 9 + 8) * 6144 + 5120);
    if (l == 0) { convert_weights(p, 0, lds, bid_(), (int)gridDim.x); fold_dft(p, 0, lds, bid_(), (int)gridDim.x); }
    if (even) gen_cm(p, lds);
  } else if (ph == 7) {
    EpiRes E{p.out, (float*)(ws + OFF_CTXR), MOD + (size_t)l * 9 * 6144 + 2048};
    run_gemm(lds, MIX, W2, NLAT, 1024, 1024, E);
    if (!last) { EpiPart Ep{(float*)(ws + OFF_MX), 512}; run_gemm_splitk(lds, MIX + (size_t)NLAT * 1024, W2, NCTX, 1024, 1024, 2, Ep); }
  } else if (ph == 8) {
    modulate_rows(p, l, 1, Mres, false, (const float*)(ws + OFF_MX), MOD + (size_t)(l * 9 + 8) * 6144 + 2048);
  } else if (ph == 9) {
    EpiUp E{(bf16_t*)(ws + OFF_GATE), (bf16_t*)(ws + OFF_VAL)};
    run_gemm(lds, HB, W3, Mres, 5632, 1024, E);
    if (!last) {
      __syncthreads();
      convert_weights(p, l + 1, lds, (int)bid_() - 176, (int)gridDim.x - 176, 0, 2);
    }
  } else if (ph == 10) {
    ph_conv(p, l, last);
  } else if (ph == 11) {
    EpiRes E{p.out, (float*)(ws + OFF_CTXR), MOD + (size_t)l * 9 * 6144 + 5120};
    run_gemm(lds, (const bf16_t*)(ws + OFF_VAL), (const bf16_t*)(ws + ((l & 1) ? OFF_W4B : OFF_W4)), NLAT, 1024, 2816, E);
    if (!last) { EpiPart Ep{(float*)(ws + OFF_GATE), 1408}; run_gemm_splitk(lds, (const bf16_t*)(ws + OFF_VAL) + (size_t)NLAT * 2816, (const bf16_t*)(ws + ((l & 1) ? OFF_W4B : OFF_W4)), NCTX, 1024, 2816, 2, Ep); }
    if (!last) {
      const int wg = (int)bid_() - 64, nwg = (int)gridDim.x - 64;
      __syncthreads();
      convert_weights(p, l + 1, lds, wg, nwg, 2, 4);
      if (l & 1) fold_dft(p, (l + 1) >> 1, lds, wg, nwg);
    }
  } else if (even) {
    if (ph == 1) { EpiAB E{EpiZ{(bf16_t*)(ws + OFF_ZT), (bf16_t*)(ws + OFF_ZTC)},
                           EpiHG{(bf16_t*)(ws + OFF_Q), (bf16_t*)(ws + OFF_V), (bf16_t*)(ws + OFF_G), (_Float16*)(ws + OFF_LF0), (_Float16*)(ws + OFF_LF1), (const float*)(ws + OFF_LB) + e * 1024}};
      run_gemm(lds, HB, W1, NTOK, 3584, 1024, E);
      if (l == 0) { __syncthreads(); mod_gemv(p, lds, 1, 4, (int)bid_() - 112, (int)gridDim.x - 112); } }
    else if (ph == 12) ph_fold(p, lds);
    else if (ph == 2) {
      { EpiDFT E{MIX, 0}; run_gemm(lds, (const bf16_t*)(ws + OFF_CM2), (const bf16_t*)(ws + OFF_ZF), 4096, 4096, 4096, E); }
      { EpiDFT E{MIX, 1}; run_gemm(lds, (const bf16_t*)(ws + OFF_CM256), (const bf16_t*)(ws + OFF_ZTC), 256, 4096, 512, E); }
    }
    else if (ph == 4) ph_h1(p, lds);
    else if (ph == 5) ph_h2(p);
    else if (ph == 6) ph_h3(p, e, lds);
  } else {
    if (ph == 1) { EpiQKV E{(bf16_t*)(ws + OFF_QB), (bf16_t*)(ws + OFF_KB), (bf16_t*)(ws + OFF_VB)}; run_gemm(lds, HB, W1, NTOK, 1536, 1024, E); }
    else if (ph == 2) ph_normrope(p, e);
    else if (ph == 3) ph_attn(p, last, lds);
  }
}

#if MULTI
__global__ void __launch_bounds__(512, 2) k_phase(P p, int l, int ph) {
  extern __shared__ __attribute__((aligned(16))) unsigned char lds[];
  if (l < 0) ph0(p, lds); else if (l >= 4) ph_final(p); else run_phase(p, l, ph, lds);
}
#else
__global__ void __launch_bounds__(512, 2) k_mega(P p) {
  extern __shared__ __attribute__((aligned(16))) unsigned char lds[];
  cg::grid_group grid = cg::this_grid();
  volatile LAS3 unsigned* st = (volatile LAS3 unsigned*)((LAS3 unsigned char*)lds + 131072);
  if (threadIdx.x == 0) { st[0] = 0u; st[1] = 0u; st[2] = 0u; st[3] = 0u; }
  __syncthreads();
  XcdBarrier bar = xcd_barrier_post((unsigned*)(p.ws + OFF_BAR), st);
  grid.sync();
  ph0(p, lds); xcd_barrier(bar);
#pragma unroll 1
  for (int l = 0; l < 4; ++l) {
#pragma unroll 1
    for (int sq = 0; sq <= 12; ++sq) {
      const int ph = sq < 2 ? sq : (sq == 2 ? 12 : sq - 1);
      if ((l & 1) ? ((ph >= 4 && ph <= 6) || ph == 12) : (ph == 3)) continue;
      run_phase(p, l, ph, lds);
      xcd_barrier(bar);
#if REP_MASK != 0
      if (((REP_MASK >> ph) & 1) && !(ph == 2 && (l & 1))) { run_phase(p, l, ph, lds); xcd_barrier(bar); }
#endif
    }
  }
  ph_final(p);
}
#endif

constexpr int LDS_BYTES = 131072 + 16;
extern "C" void kernel_launch(void* const* d_in, const int* in_sizes, int n_in, void* d_out, int out_size, void* d_ws, size_t ws_size, hipStream_t stream) {
  static int ok = 0;
  if (!ok) {
    if (n_in != 19 || ws_size < WS_END) { fprintf(stderr, "kernel_launch: unexpected n_in %d / ws %zu (need %zu)\n", n_in, ws_size, (size_t)WS_END); return; }
#if MULTI
    if (hipFuncSetAttribute((const void*)k_phase, hipFuncAttributeMaxDynamicSharedMemorySize, LDS_BYTES) != hipSuccess) { fprintf(stderr, "hipFuncSetAttribute failed\n"); return; }
#else
    if (hipFuncSetAttribute((const void*)k_mega, hipFuncAttributeMaxDynamicSharedMemorySize, LDS_BYTES) != hipSuccess) { fprintf(stderr, "hipFuncSetAttribute failed\n"); return; }
#endif
    ok = 1;
  }
  P p{};
  p.x = (const float*)d_in[0]; p.c = (const float*)d_in[1]; p.ctx = (const float*)d_in[2]; p.c_ctx = (const float*)d_in[3]; p.w_mod = (const float*)d_in[4]; p.b_mod = (const float*)d_in[5];
  p.w_in_ab = (const float*)d_in[6]; p.w_out_ab = (const float*)d_in[7]; p.hg_lb = (const float*)d_in[8]; p.hg_ng = (const float*)d_in[9]; p.w_qkv = (const float*)d_in[10];
  p.qn_g = (const float*)d_in[11]; p.kn_g = (const float*)d_in[12]; p.w_out_att = (const float*)d_in[13]; p.w_up = (const float*)d_in[14]; p.conv_w = (const float*)d_in[15];
  p.conv_b = (const float*)d_in[16]; p.w_down = (const float*)d_in[17]; p.fn_g = (const float*)d_in[18];
  p.out = (float*)d_out; p.ws = (unsigned char*)d_ws;
#if MULTI
  hipLaunchKernelGGL(k_phase, dim3(256), dim3(512), LDS_BYTES, stream, p, -1, 0);
  for (int l = 0; l < 4; ++l) for (int ph = 0; ph <= 11; ++ph) { if ((l & 1) && (ph >= 4 && ph <= 6)) continue; hipLaunchKernelGGL(k_phase, dim3(256), dim3(512), LDS_BYTES, stream, p, l, ph); }
  hipLaunchKernelGGL(k_phase, dim3(256), dim3(512), LDS_BYTES, stream, p, 4, 0);
#else
  if (hipMemsetAsync((char*)d_ws + OFF_BAR, 0, 16384, stream) != hipSuccess) { fprintf(stderr, "memset failed\n"); return; }
  void* args[] = {&p};
  hipError_t e = hipLaunchCooperativeKernel((const void*)k_mega, dim3(256), dim3(512), args, LDS_BYTES, stream);
  if (e != hipSuccess) fprintf(stderr, "cooperative launch failed: %s\n", hipGetErrorString(e));
#endif
}
```

```cpp
#include <hip/hip_runtime.h>
#include <hip/hip_bf16.h>
#include <hip/hip_cooperative_groups.h>
#include <cstdio>
namespace cg = cooperative_groups;

#ifndef REP_FILL
#define REP_FILL 1
#endif
#ifndef REP_MASK
#define REP_MASK 0
#endif
#ifndef MULTI
#define MULTI 0
#endif

typedef unsigned short bf16_t;
typedef short bf16x8 __attribute__((ext_vector_type(8)));
typedef short s16x4 __attribute__((ext_vector_type(4)));
typedef float f32x4 __attribute__((ext_vector_type(4)));
typedef float f32x16 __attribute__((ext_vector_type(16)));
typedef unsigned u32x4 __attribute__((ext_vector_type(4)));
typedef unsigned u32x2 __attribute__((ext_vector_type(2)));
typedef _Float16 h16x8 __attribute__((ext_vector_type(8)));

constexpr int NLAT = 32768, NCTX = 2048, NTOK = 34816;
constexpr float EPS = 1e-6f;

constexpr size_t OFF_CTXR = 0;
constexpr size_t OFF_MOD = OFF_CTXR + 8388608;
constexpr size_t OFF_LB = OFF_MOD + 1048576;
constexpr size_t OFF_CM256 = OFF_LB + 8192;
constexpr size_t OFF_HB = OFF_CM256 + 262144;
constexpr size_t OFF_W1 = OFF_HB + 71303168;
constexpr size_t OFF_W2 = OFF_W1 + 7340032;
constexpr size_t OFF_W3 = OFF_W2 + 2097152;
constexpr size_t OFF_W4 = OFF_W3 + 11534336;
constexpr size_t OFF_AL = OFF_W4 + 5767168;
constexpr size_t OFF_GATE = OFF_AL;
constexpr size_t OFF_VAL = OFF_GATE + 196083712;
constexpr size_t OFF_MIX = OFF_AL;
constexpr size_t OFF_MX = OFF_MIX + 71303168;
constexpr size_t OFF_Q = OFF_MX;
constexpr size_t OFF_V = OFF_Q + 35651584;
constexpr size_t OFF_G = OFF_V + 35651584;
constexpr size_t OFF_LF0 = OFF_G + 35651584;
constexpr size_t OFF_LF1 = OFF_LF0 + 35651584;
constexpr size_t OFF_O0 = OFF_LF1 + 35651584;
constexpr size_t OFF_O1 = OFF_O0 + 71303168;
constexpr size_t OFF_ZT = OFF_O0;
constexpr size_t OFF_ZTC = OFF_ZT + 67108864;
constexpr size_t OFF_ZF = OFF_ZTC + 4194304;
constexpr size_t OFF_CM2 = OFF_ZF + 33554432;
constexpr size_t OFF_CM = OFF_CM2;
constexpr size_t OFF_QB = OFF_MX;
constexpr size_t OFF_KB = OFF_QB + 71303168;
constexpr size_t OFF_VB = OFF_KB + 17825792;
constexpr size_t OFF_ST = OFF_O0;
constexpr size_t OFF_DEC = OFF_VAL + 196083712;
constexpr size_t OFF_W4B = OFF_DEC + 2228224;
constexpr size_t OFF_BAR = OFF_W4B + 5767168;
constexpr size_t OFF_ROPE = OFF_BAR + 16384;
constexpr size_t WS_END = OFF_ROPE + 16384;
static_assert(OFF_O1 + 71303168 <= OFF_DEC && OFF_CM2 + 33554432 <= OFF_DEC && OFF_VB + 17825792 <= WS_END, "alias region");

struct P {
  const float *x, *c, *ctx, *c_ctx, *w_mod, *b_mod, *w_in_ab, *w_out_ab, *hg_lb, *hg_ng, *w_qkv, *qn_g, *kn_g, *w_out_att, *w_up, *conv_w, *conv_b, *w_down, *fn_g;
  float* out; unsigned char* ws;
};

typedef __bf16 bf16v2_t __attribute__((ext_vector_type(2)));
typedef float f32v2_t __attribute__((ext_vector_type(2)));
__device__ __forceinline__ unsigned cvt_pk_bf16(float lo, float hi) { const f32v2_t v = {lo, hi}; const bf16v2_t r = __builtin_convertvector(v, bf16v2_t); return __builtin_bit_cast(unsigned, r); }
__device__ __forceinline__ bf16_t f2bf(float f) { return (bf16_t)(cvt_pk_bf16(f, 0.f) & 0xffffu); }
__device__ __forceinline__ float bflo(unsigned w) { return __uint_as_float(w << 16); }
__device__ __forceinline__ float bfhi(unsigned w) { return __uint_as_float(w & 0xffff0000u); }
__device__ __forceinline__ float bf2f(bf16_t v) { return __uint_as_float(((unsigned)v) << 16); }
#define GA __attribute__((address_space(1)))
#define LAS3 __attribute__((address_space(3)))
#define UNPK(w, j) (((j) & 1) ? bfhi((w)[(j) >> 1]) : bflo((w)[(j) >> 1]))
__device__ __forceinline__ float silu_f(float v) { return v * __builtin_amdgcn_rcpf(1.f + __expf(-v)); }
__device__ __forceinline__ float wave_sum(float v) {
#pragma unroll
  for (int o = 32; o > 0; o >>= 1) v += __shfl_xor(v, o);
  return v;
}
__device__ __forceinline__ int tid_() { int t = threadIdx.x; asm volatile("" : "+v"(t)); return t; }
__device__ __forceinline__ int bid_() { int b = blockIdx.x; asm volatile("" : "+s"(b)); return b; }
__device__ __forceinline__ int kvrow(int row) { return row < NLAT ? (row >> 12) * 4352 + (row & 4095) : ((row - NLAT) >> 8) * 4352 + 4096 + ((row - NLAT) & 255); }

#define XB_TMO      128
#define XB_XCNT(j)  (256  + 64 * (j))
#define XB_XSUB(j)  (1280 + 64 * (j))
#define XB_XGEN(j)  (2304 + 64 * (j))
#define XB_TOP      3328
#define XB_TOPGEN   3392
#define XCD_BAR_WORDS 3456
#define XB_SPIN_CAP (1u << 22)
__device__ __forceinline__ unsigned xb_ld(unsigned* p)              { return __hip_atomic_load(p, __ATOMIC_RELAXED, __HIP_MEMORY_SCOPE_AGENT); }
__device__ __forceinline__ unsigned xb_add(unsigned* p, unsigned v) { return __hip_atomic_fetch_add(p, v, __ATOMIC_RELAXED, __HIP_MEMORY_SCOPE_AGENT); }
__device__ __forceinline__ unsigned xb_xcc_id() { return (unsigned)__builtin_amdgcn_s_getreg((3 << 11) | 20) & 0xFu; }
#define XB_SPIN(cond, bar) do { unsigned _sp = 0; while (cond) { __builtin_amdgcn_s_sleep(1); \
    if ((++_sp & 255u) == 0u) { if (xb_ld(&(bar)[XB_TMO])) break; if (_sp > XB_SPIN_CAP) { atomicAdd(&(bar)[XB_TMO], 1u); break; } } } } while (0)
struct XcdBarrier { unsigned* bar; unsigned x; volatile LAS3 unsigned* st; };
__device__ __forceinline__ XcdBarrier xcd_barrier_post(unsigned* bar, volatile LAS3 unsigned* st) {
  XcdBarrier b; b.bar = bar; b.x = xb_xcc_id(); b.st = st;
  if (threadIdx.x == 0) (void)xb_add(&bar[XB_XCNT(b.x)], 1u);
  return b;
}
__device__ __forceinline__ void xcd_barrier_complete(unsigned* bar, unsigned x, unsigned& nloc, unsigned& nx) {
  const unsigned G = gridDim.x * gridDim.y * gridDim.z;
  unsigned sum, cnt, mine, sp = 0u;
  for (;;) {
    sum = 0u; cnt = 0u; mine = 0u;
#pragma unroll
    for (unsigned j = 0; j < 16; ++j) { const unsigned c = xb_ld(&bar[XB_XCNT(j)]); sum += c; cnt += (c > 0u) ? 1u : 0u; mine = (j == x) ? c : mine; }
    if (sum == G) break;
    __builtin_amdgcn_s_sleep(1);
    if ((++sp & 255u) == 0u) { if (xb_ld(&bar[XB_TMO])) break; if (sp > XB_SPIN_CAP) { atomicAdd(&bar[XB_TMO], 1u); break; } }
  }
  nloc = mine > 0u ? mine : 1u; nx = cnt > 0u ? cnt : 1u;
}
__device__ __forceinline__ void xcd_barrier(const XcdBarrier& b) {
  asm volatile("s_waitcnt vmcnt(0)" ::: "memory");
  __syncthreads();
  if (threadIdx.x == 0) {
    unsigned* bar = b.bar; unsigned bx = __builtin_amdgcn_readfirstlane(b.x);
    asm volatile("" : "+s"(bar), "+s"(bx));
    __builtin_amdgcn_s_waitcnt(0);
    unsigned nloc = b.st[0], nx = b.st[1];
    if (nloc == 0u) { xcd_barrier_complete(bar, bx, nloc, nx); b.st[0] = nloc; b.st[1] = nx; }
    const unsigned old = xb_add(&bar[XB_XSUB(bx)], 1u);
    const unsigned gen = old / nloc;
    if (old + 1u == (gen + 1u) * nloc) {
      __builtin_amdgcn_fence(__ATOMIC_RELEASE, "agent");
      asm volatile("s_waitcnt vmcnt(0)" ::: "memory");
      const unsigned og = xb_add(&bar[XB_TOP], 1u);
      const unsigned tg = og / nx;
      if (og + 1u == (tg + 1u) * nx) xb_add(&bar[XB_TOPGEN], 1u);
      else XB_SPIN(xb_ld(&bar[XB_TOPGEN]) == tg, bar);
      __builtin_amdgcn_fence(__ATOMIC_ACQUIRE, "agent");
      xb_add(&bar[XB_XGEN(bx)], 1u);
      asm volatile("s_waitcnt vmcnt(0)" ::: "memory");
    } else {
      XB_SPIN(xb_ld(&bar[XB_XGEN(bx)]) == gen, bar);
      __builtin_amdgcn_fence(__ATOMIC_ACQUIRE, "agent");
      asm volatile("s_waitcnt vmcnt(0)" ::: "memory");
    }
  }
  __syncthreads();
}

namespace pg8 {
#define PG8_LAS __attribute__((address_space(3)))
constexpr int BM = 256, BK = 64, HALF = 128, HTB = HALF * BK * 2, STAGE_BYTES = 8 * HTB, NXCD = 8, WGM = 8;
__device__ __forceinline__ int lds_byte(int r, int c) { const int st = (r >> 4) * 2 + (c >> 5), rr = r & 15, cc = c & 31, ob = rr * 64 + cc * 2; return st * 1024 + (ob ^ (((ob >> 9) & 1) << 5)); }
__device__ __forceinline__ void stage_rc(int b, int& R, int& C) { const int st = b / 1024, sb = b % 1024, swz = sb ^ (((sb >> 9) & 1) << 5); R = (st >> 1) * 16 + swz / 64; C = (st & 1) * 32 + (swz % 64) / 2; }
__device__ __forceinline__ int perm32(int rho) { const int n = rho >> 4, i = rho & 15; return 8 * (i >> 2) + 4 * n + (i & 3); }
struct Unit { int pm, pn, ko; };
struct Gemm { const bf16_t* A; const bf16_t* Bt; int M, N, K, ldk; };
struct StaticOrder {
  int nM, nN, nwg, G, c;
  __device__ void init(int M, int N, int G_, int c_) { nM = M / BM; nN = N / BM; nwg = nM * nN; G = G_; c = c_; }
  __device__ bool next(int i, Unit& u) const {
    const long L = (long)i * G + c; if (L >= nwg) return false;
    int wgid = (int)L; { const int q = nwg / NXCD, r = nwg % NXCD, xcd = wgid % NXCD, off = wgid / NXCD; wgid = (xcd < r ? xcd * (q + 1) : r * (q + 1) + (xcd - r) * q) + off; }
    const int nig = WGM * nN, gid = wgid / nig, fm = gid * WGM, gsz = (nM - fm) < WGM ? (nM - fm) : WGM;
    u.pm = fm + ((wgid % nig) % gsz); u.pn = (wgid % nig) / gsz; u.ko = 0; return true;
  }
};
struct SplitKOrder {
  int nN, ns, nwg, G, c, ksub;
  __device__ void init(int M, int N, int ns_, int ksub_, int G_, int c_) { nN = N / BM; ns = ns_; ksub = ksub_; nwg = (M / BM) * nN * ns; G = G_; c = c_; }
  __device__ bool next(int i, Unit& u) const {
    const int L = i * G + c; if (L >= nwg) return false;
    u.ko = (L % ns) * ksub; u.pn = (L / ns) % nN; u.pm = L / (ns * nN); return true;
  }
};

#ifndef GEMM_SP2
#define GEMM_SP2 1
#endif
#ifndef GEMM_ALIGN
#define GEMM_ALIGN 1
#endif
template <class Epi, class Sched>
__device__ __forceinline__ void gemm_phase(PG8_LAS unsigned char* lds, const Gemm g, const Sched& S, const Epi& E) {
  const int tid = tid_(), wid = __builtin_amdgcn_readfirstlane(tid >> 6), lane = tid & 63, wr = wid >> 2, wc = wid & 3, fr = lane & 15, fq = lane >> 4;
  const int K = g.ldk, nt = g.K / BK;
  unsigned voffA[2], voffB[2];
#pragma unroll
  for (int i = 0; i < 2; ++i) { int R, C; stage_rc(tid * 16 + i * 8192, R, C); const int Rb = Epi::PERM ? ((R & ~31) + perm32(R & 31)) : R;
    voffA[i] = (unsigned)(R * K + C) * 2u; voffB[i] = (unsigned)(Rb * K + C) * 2u; }
  const size_t kstep = (size_t)(BK * 2);
  const size_t hstep = (size_t)HALF * K * 2;
  const size_t tstep = 2 * hstep;
  const unsigned ldsw = (unsigned)wid * 1024u;
  const int aoff = lds_byte(wr * 64 + fr, fq * 8), boff = lds_byte(wc * 32 + fr, fq * 8);
#define PG8_SA(b, h) (((b) * 2 + (h)) * HTB)
#define PG8_SB(b, h) ((4 + (b) * 2 + (h)) * HTB)
#define PG8_STAGE(bufoff, gbase, voff) do { _Pragma("unroll") for (int _i = 0; _i < 2; ++_i) \
    __builtin_amdgcn_global_load_lds((const unsigned*)((const char*)(gbase) + (voff)[_i]), (PG8_LAS unsigned*)(lds + (bufoff) + ldsw + _i * 8192), 16, 0, 0); } while (0)
#define PG8_LDA(dst, b, h) do { _Pragma("unroll") for (int m = 0; m < 4; ++m) _Pragma("unroll") for (int k = 0; k < 2; ++k) dst[m][k] = *(const PG8_LAS bf16x8*)(lds + PG8_SA(b, h) + aoff + m * 2048 + k * 1024); } while (0)
#define PG8_LDB(dst, b, h) do { _Pragma("unroll") for (int n = 0; n < 2; ++n) _Pragma("unroll") for (int k = 0; k < 2; ++k) dst[n][k] = *(const PG8_LAS bf16x8*)(lds + PG8_SB(b, h) + boff + n * 2048 + k * 1024); } while (0)
#define PG8_MMA(ai, bj, At, Bt) do { __builtin_amdgcn_s_setprio(1); _Pragma("unroll") for (int m = 0; m < 4; ++m) _Pragma("unroll") for (int n = 0; n < 2; ++n) _Pragma("unroll") for (int k = 0; k < 2; ++k) \
    acc[ai][bj][m][n] = __builtin_amdgcn_mfma_f32_16x16x32_bf16(Bt[n][k], At[m][k], acc[ai][bj][m][n], 0, 0, 0); __builtin_amdgcn_s_setprio(0); } while (0)
#define PG8_WAIT_V(n) asm volatile("s_waitcnt vmcnt(" #n ")" ::: "memory")
#define PG8_WAIT_L(n) asm volatile("s_waitcnt lgkmcnt(" #n ")" ::: "memory")
#define PG8_BAR __builtin_amdgcn_s_barrier()
#define PG8_SCHED __builtin_amdgcn_sched_barrier(0)
  Unit cur, nxt; int ui = 0;
  if (!S.next(0, cur)) return;
  f32x4 acc[2][2][4][2];
#pragma unroll
  for (int a = 0; a < 2; ++a)
#pragma unroll
    for (int b = 0; b < 2; ++b)
#pragma unroll
      for (int m = 0; m < 4; ++m)
#pragma unroll
        for (int n = 0; n < 2; ++n) acc[a][b][m][n] = (f32x4){0.f, 0.f, 0.f, 0.f};
  bf16x8 At[4][2], B0[2][2], B1[2][2];
  const char* cA = (const char*)g.A + (size_t)cur.pm * tstep + (size_t)cur.ko * 2; const char* cB = (const char*)g.Bt + (size_t)cur.pn * tstep + (size_t)cur.ko * 2;
#if GEMM_SP2
  PG8_STAGE(PG8_SB(0, 0), cB, voffB); PG8_STAGE(PG8_SB(0, 1), cB + hstep, voffB); PG8_STAGE(PG8_SA(0, 0), cA, voffA); PG8_STAGE(PG8_SA(0, 1), cA + hstep, voffA);
  if (wr == 1) PG8_BAR;
  PG8_WAIT_V(2); PG8_BAR;
  PG8_STAGE(PG8_SB(1, 0), cB + kstep, voffB); PG8_STAGE(PG8_SA(1, 0), cA + kstep, voffA); PG8_STAGE(PG8_SB(1, 1), cB + hstep + kstep, voffB);
  PG8_WAIT_V(6); PG8_BAR;
#else
  PG8_STAGE(PG8_SB(0, 0), cB, voffB); PG8_STAGE(PG8_SA(0, 0), cA, voffA); PG8_STAGE(PG8_SB(0, 1), cB + hstep, voffB); PG8_STAGE(PG8_SA(0, 1), cA + hstep, voffA);
  if (wr == 1) PG8_BAR;
  PG8_WAIT_V(4); PG8_BAR;
  PG8_STAGE(PG8_SB(1, 0), cB + kstep, voffB); PG8_STAGE(PG8_SA(1, 0), cA + kstep, voffA); PG8_STAGE(PG8_SB(1, 1), cB + hstep + kstep, voffB);
  PG8_WAIT_V(6); PG8_BAR;
#endif
  for (;;) {
    const bool has_next = S.next(ui + 1, nxt);
    const char* nA = has_next ? (const char*)g.A + (size_t)nxt.pm * tstep + (size_t)nxt.ko * 2 : cA; const char* nB = has_next ? (const char*)g.Bt + (size_t)nxt.pn * tstep + (size_t)nxt.ko * 2 : cB;
    for (int t = 0; t < nt; t += 2) {
      const bool last = (t == nt - 2);
      const char* a1 = cA + (size_t)(t + 1) * kstep;
      const char* a2 = last ? nA : cA + (size_t)(t + 2) * kstep; const char* b2 = last ? nB : cB + (size_t)(t + 2) * kstep;
      const char* a3 = a2 + kstep; const char* b3 = b2 + kstep;
#if GEMM_SP2
      PG8_LDB(B0, 0, 0); PG8_LDB(B1, 0, 1); PG8_SCHED; PG8_LDA(At, 0, 0); PG8_STAGE(PG8_SA(1, 1), a1 + hstep, voffA);
      PG8_WAIT_V(8); PG8_WAIT_L(0); PG8_BAR; PG8_MMA(0, 0, At, B0); PG8_MMA(0, 1, At, B1); PG8_BAR; PG8_SCHED;
      PG8_LDA(At, 0, 1); PG8_STAGE(PG8_SB(0, 0), b2, voffB); PG8_STAGE(PG8_SB(0, 1), b2 + hstep, voffB); PG8_STAGE(PG8_SA(0, 0), a2, voffA);
      PG8_WAIT_V(8); PG8_WAIT_L(0); PG8_BAR; PG8_MMA(1, 0, At, B0); PG8_MMA(1, 1, At, B1); PG8_BAR; PG8_SCHED;
      PG8_LDB(B0, 1, 0); PG8_LDB(B1, 1, 1); PG8_SCHED; PG8_LDA(At, 1, 0); PG8_STAGE(PG8_SA(0, 1), a2 + hstep, voffA);
      PG8_WAIT_V(8); PG8_WAIT_L(0); PG8_BAR; PG8_MMA(0, 0, At, B0); PG8_MMA(0, 1, At, B1); PG8_BAR; PG8_SCHED;
      PG8_LDA(At, 1, 1); PG8_STAGE(PG8_SB(1, 0), b3, voffB); PG8_STAGE(PG8_SB(1, 1), b3 + hstep, voffB); PG8_STAGE(PG8_SA(1, 0), a3, voffA);
      PG8_WAIT_V(8); PG8_WAIT_L(0); PG8_BAR; PG8_MMA(1, 0, At, B0); PG8_MMA(1, 1, At, B1); PG8_BAR; PG8_SCHED;
#else
      PG8_LDB(B0, 0, 0); PG8_SCHED; PG8_LDA(At, 0, 0); PG8_STAGE(PG8_SA(1, 1), a1 + hstep, voffA);
      PG8_WAIT_L(8); PG8_BAR; PG8_WAIT_L(0); PG8_MMA(0, 0, At, B0); PG8_BAR; PG8_SCHED;
      PG8_LDB(B1, 0, 1); PG8_STAGE(PG8_SB(0, 0), b2, voffB);
      PG8_BAR; PG8_WAIT_L(0); PG8_MMA(0, 1, At, B1); PG8_BAR;
      PG8_LDA(At, 0, 1); PG8_STAGE(PG8_SA(0, 0), a2, voffA);
      PG8_BAR; PG8_WAIT_L(0); PG8_MMA(1, 0, At, B0); PG8_BAR; PG8_SCHED;
      PG8_STAGE(PG8_SB(0, 1), b2 + hstep, voffB);
      PG8_WAIT_V(6); PG8_BAR; PG8_MMA(1, 1, At, B1); PG8_BAR;
      PG8_LDB(B0, 1, 0); PG8_SCHED; PG8_LDA(At, 1, 0); PG8_STAGE(PG8_SA(0, 1), a2 + hstep, voffA);
      PG8_WAIT_L(8); PG8_BAR; PG8_WAIT_L(0); PG8_MMA(0, 0, At, B0); PG8_BAR; PG8_SCHED;
      PG8_LDB(B1, 1, 1); PG8_STAGE(PG8_SB(1, 0), b3, voffB);
      PG8_BAR; PG8_WAIT_L(0); PG8_MMA(0, 1, At, B1); PG8_BAR;
      PG8_LDA(At, 1, 1); PG8_STAGE(PG8_SA(1, 0), a3, voffA);
      PG8_BAR; PG8_WAIT_L(0); PG8_MMA(1, 0, At, B0); PG8_BAR; PG8_SCHED;
      PG8_STAGE(PG8_SB(1, 1), b3 + hstep, voffB);
      PG8_WAIT_V(6); PG8_BAR; PG8_MMA(1, 1, At, B1); PG8_BAR;
#endif
    }
#if GEMM_ALIGN
    if (wr == 0) PG8_BAR;
#endif
    E(acc, cur, wr, wc, fr, fq);
    if (!has_next) break;
#pragma unroll
    for (int a = 0; a < 2; ++a)
#pragma unroll
      for (int b = 0; b < 2; ++b)
#pragma unroll
        for (int m = 0; m < 4; ++m)
#pragma unroll
          for (int n = 0; n < 2; ++n) acc[a][b][m][n] = (f32x4){0.f, 0.f, 0.f, 0.f};
    cur = nxt; cA = nA; cB = nB; ++ui;
#if GEMM_ALIGN
    if (wr == 1) PG8_BAR;
#endif
  }
  PG8_WAIT_V(0);
#if !GEMM_ALIGN
  if (wr == 0) PG8_BAR;
#endif
  PG8_BAR;
#undef PG8_SA
#undef PG8_SB
#undef PG8_STAGE
#undef PG8_LDA
#undef PG8_LDB
#undef PG8_MMA
#undef PG8_WAIT_V
#undef PG8_WAIT_L
#undef PG8_BAR
#undef PG8_SCHED
}
}

typedef const f32x4 (&AccRef)[2][2][4][2];
__device__ __forceinline__ u32x4 pack8(f32x4 v0, f32x4 v1) { u32x4 w; w.x = cvt_pk_bf16(v0[0], v0[1]); w.y = cvt_pk_bf16(v0[2], v0[3]); w.z = cvt_pk_bf16(v1[0], v1[1]); w.w = cvt_pk_bf16(v1[2], v1[3]); return w; }

struct EpiZ {
  static constexpr bool PERM = true;
  bf16_t* Z; bf16_t* ZTC;
  __device__ __forceinline__ void operator()(AccRef acc, const pg8::Unit& u, int wr, int wc, int fr, int fq) const {
#pragma unroll
    for (int ai = 0; ai < 2; ++ai)
#pragma unroll
      for (int m = 0; m < 4; ++m) {
        const int row = u.pm * 256 + ai * 128 + wr * 64 + m * 16 + fr;
        if (row < NLAT) {
          bf16_t* dst = Z + (size_t)row * 1024 + u.pn * 256 + wc * 32 + fq * 8;
#pragma unroll
          for (int bj = 0; bj < 2; ++bj) *(u32x4*)(dst + bj * 128) = pack8(acc[ai][bj][m][0], acc[ai][bj][m][1]);
        } else {
          const int rr = row - NLAT; bf16_t* base = ZTC + (size_t)(rr >> 8) * 512 * 512 + (rr & 255);
#pragma unroll
          for (int bj = 0; bj < 2; ++bj)
#pragma unroll
            for (int n = 0; n < 2; ++n)
#pragma unroll
              for (int j = 0; j < 4; ++j) { const int col = u.pn * 256 + bj * 128 + wc * 32 + fq * 8 + n * 4 + j;
                base[(size_t)(col & 511) * 512 + (col >> 9) * 256] = f2bf(acc[ai][bj][m][n][j]); }
        }
      }
  }
};
struct EpiHG {
  static constexpr bool PERM = true;
  bf16_t *Q, *V, *G; _Float16 *LF0, *LF1; const float* LB;
  __device__ __forceinline__ void operator()(AccRef acc, const pg8::Unit& u, int wr, int wc, int fr, int fq) const {
    const int region = u.pn >> 1;
#pragma unroll
    for (int bj = 0; bj < 2; ++bj) {
      const int cl = (u.pn & 1) * 256 + bj * 128 + wc * 32 + fq * 8;
      float lb[8];
      if (region == 1 || region == 2) {
        const f32x4 a = *(const f32x4*)(LB + (region - 1) * 512 + cl), b = *(const f32x4*)(LB + (region - 1) * 512 + cl + 4);
        lb[0] = a[0]; lb[1] = a[1]; lb[2] = a[2]; lb[3] = a[3]; lb[4] = b[0]; lb[5] = b[1]; lb[6] = b[2]; lb[7] = b[3];
      } else {
#pragma unroll
        for (int j = 0; j < 8; ++j) lb[j] = 0.f;
      }
#pragma unroll
      for (int ai = 0; ai < 2; ++ai)
#pragma unroll
        for (int m = 0; m < 4; ++m) {
          const size_t off = (size_t)(u.pm * 256 + ai * 128 + wr * 64 + m * 16 + fr) * 512 + cl;
          f32x4 v0 = acc[ai][bj][m][0], v1 = acc[ai][bj][m][1];
          if (region == 0) {
#pragma unroll
            for (int j = 0; j < 4; ++j) { v0[j] = silu_f(v0[j]); v1[j] = silu_f(v1[j]); }
            *(u32x4*)(Q + off) = pack8(v0, v1);
          } else if (region == 1 || region == 2) {
            h16x8 hv;
#pragma unroll
            for (int j = 0; j < 4; ++j) {
              const float f0 = lb[j] + (1.f - lb[j]) * __builtin_amdgcn_rcpf(1.f + __expf(-v0[j])), f1 = lb[4 + j] + (1.f - lb[4 + j]) * __builtin_amdgcn_rcpf(1.f + __expf(-v1[j]));
              hv[j] = (_Float16)__logf(fmaxf(f0, 1e-30f)); hv[4 + j] = (_Float16)__logf(fmaxf(f1, 1e-30f));
            }
            *(h16x8*)((region == 1 ? LF0 : LF1) + off) = hv;
          } else if (region == 3) { *(u32x4*)(V + off) = pack8(v0, v1); }
          else { *(u32x4*)(G + off) = pack8(v0, v1); }
        }
    }
  }
};
struct EpiAB {
  static constexpr bool PERM = true;
  EpiZ z; EpiHG hg;
  __device__ __forceinline__ void operator()(AccRef acc, const pg8::Unit& u, int wr, int wc, int fr, int fq) const {
    if (u.pn < 4) z(acc, u, wr, wc, fr, fq);
    else { pg8::Unit v = u; v.pn = u.pn - 4; hg(acc, v, wr, wc, fr, fq); }
  }
};
struct EpiQKV {
  static constexpr bool PERM = true;
  bf16_t *QB, *KB, *VB;
  __device__ __forceinline__ void operator()(AccRef acc, const pg8::Unit& u, int wr, int wc, int fr, int fq) const {
#pragma unroll
    for (int ai = 0; ai < 2; ++ai)
#pragma unroll
      for (int m = 0; m < 4; ++m) {
        const int row = u.pm * 256 + ai * 128 + wr * 64 + m * 16 + fr;
        bf16_t* dst;
        if (u.pn < 4) dst = QB + (size_t)row * 1024 + u.pn * 256;
        else dst = (u.pn == 4 ? KB : VB) + (size_t)kvrow(row) * 256;
#pragma unroll
        for (int bj = 0; bj < 2; ++bj) *(u32x4*)(dst + bj * 128 + wc * 32 + fq * 8) = pack8(acc[ai][bj][m][0], acc[ai][bj][m][1]);
      }
  }
};
struct EpiRes {
  static constexpr bool PERM = false;
  float* X; float* CX; const float* gate; const float* Xsrc;
  __device__ __forceinline__ void operator()(AccRef acc, const pg8::Unit& u, int wr, int wc, int fr, int fq) const {
    const int row0 = u.pm * 256;
    const int mr = row0 < NLAT ? (row0 >> 12) : 8;
    const int colb = u.pn * 256 + wc * 32 + fq * 4;
    f32x4 gv[2][2];
#pragma unroll
    for (int bj = 0; bj < 2; ++bj)
#pragma unroll
      for (int n = 0; n < 2; ++n) gv[bj][n] = *(const f32x4*)(gate + (size_t)mr * 6144 + colb + bj * 128 + n * 16);
#pragma unroll
    for (int ai = 0; ai < 2; ++ai)
#pragma unroll
      for (int m = 0; m < 4; ++m) {
        const int row = row0 + ai * 128 + wr * 64 + m * 16 + fr;
        float* dst = (row < NLAT ? X + (size_t)row * 1024 : CX + (size_t)(row - NLAT) * 1024) + colb;
        const float* srcp = (row < NLAT ? Xsrc + (size_t)row * 1024 : CX + (size_t)(row - NLAT) * 1024) + colb;
#pragma unroll
        for (int bj = 0; bj < 2; ++bj)
#pragma unroll
          for (int n = 0; n < 2; ++n) { f32x4 xv = *(const f32x4*)(srcp + bj * 128 + n * 16); xv += gv[bj][n] * acc[ai][bj][m][n]; *(f32x4*)(dst + bj * 128 + n * 16) = xv; }
      }
  }
};
struct EpiPart {
  static constexpr bool PERM = false;
  float* PART; int ksub;
  __device__ __forceinline__ void operator()(AccRef acc, const pg8::Unit& u, int wr, int wc, int fr, int fq) const {
    float* base = PART + (size_t)(u.ko / ksub) * NCTX * 1024 + u.pn * 256 + wc * 32 + fq * 4;
#pragma unroll
    for (int ai = 0; ai < 2; ++ai)
#pragma unroll
      for (int m = 0; m < 4; ++m) {
        float* dst = base + (size_t)(u.pm * 256 + ai * 128 + wr * 64 + m * 16 + fr) * 1024;
#pragma unroll
        for (int bj = 0; bj < 2; ++bj)
#pragma unroll
          for (int n = 0; n < 2; ++n) *(f32x4*)(dst + bj * 128 + n * 16) = acc[ai][bj][m][n];
      }
  }
};
struct EpiUp {
  static constexpr bool PERM = true;
  bf16_t *GATE, *VAL;
  __device__ __forceinline__ void operator()(AccRef acc, const pg8::Unit& u, int wr, int wc, int fr, int fq) const {
    bf16_t* base = (u.pn < 11 ? GATE + u.pn * 256 : VAL + (u.pn - 11) * 256) + wc * 32 + fq * 8;
#pragma unroll
    for (int ai = 0; ai < 2; ++ai)
#pragma unroll
      for (int m = 0; m < 4; ++m) {
        bf16_t* dst = base + (size_t)(u.pm * 256 + ai * 128 + wr * 64 + m * 16 + fr) * 2816;
#pragma unroll
        for (int bj = 0; bj < 2; ++bj) *(u32x4*)(dst + bj * 128) = pack8(acc[ai][bj][m][0], acc[ai][bj][m][1]);
      }
  }
};
struct EpiDFT {
  static constexpr bool PERM = true;
  bf16_t* MIX; int ctxmode;
  __device__ __forceinline__ void operator()(AccRef acc, const pg8::Unit& u, int wr, int wc, int fr, int fq) const {
    const int b = u.pn >> 1;
    const int tok0 = ctxmode ? NLAT + b * 256 : b * 4096 + u.pm * 256;
    bf16_t* base = MIX + (u.pn & 1) * 256 + wc * 32 + fq * 8;
#pragma unroll
    for (int ai = 0; ai < 2; ++ai)
#pragma unroll
      for (int m = 0; m < 4; ++m) {
        bf16_t* dst = base + (size_t)(tok0 + ai * 128 + wr * 64 + m * 16 + fr) * 1024;
#pragma unroll
        for (int bj = 0; bj < 2; ++bj) *(u32x4*)(dst + bj * 128) = pack8(acc[ai][bj][m][0], acc[ai][bj][m][1]);
      }
  }
};
template <class Epi> __device__ __forceinline__ void run_gemm(unsigned char* lds, const bf16_t* A, const bf16_t* Bt, int M, int N, int K, const Epi& E) {
  pg8::Gemm g{A, Bt, M, N, K, K}; pg8::StaticOrder S; S.init(M, N, (int)gridDim.x, bid_());
  pg8::gemm_phase<Epi, pg8::StaticOrder>((PG8_LAS unsigned char*)lds, g, S, E);
}
template <class Epi> __device__ __forceinline__ void run_gemm_splitk(unsigned char* lds, const bf16_t* A, const bf16_t* Bt, int M, int N, int K, int ns, const Epi& E) {
  pg8::Gemm g{A, Bt, M, N, K / ns, K}; pg8::SplitKOrder S; S.init(M, N, ns, K / ns, (int)gridDim.x, bid_());
  pg8::gemm_phase<Epi, pg8::SplitKOrder>((PG8_LAS unsigned char*)lds, g, S, E);
}

namespace att {
constexpr int D = 128, NW = 8, QBLK = 32, KVBLK = 64;
constexpr float SCALE = 0.088388347648318440f;
constexpr float THR = 8.f;
constexpr int LDQ = 1024, LDK = 256, LDO = 1024;
constexpr size_t SHM_V = KVBLK * D * 2, SHM_K = KVBLK * D * 2;
#define KSWZ(row, colB) ((row) * 256 + ((colB) ^ (((row) & 7) << 4)))
#define SBAR() __builtin_amdgcn_sched_barrier(0)
__device__ __forceinline__ int crow(int r, int hi) { return (r & 3) + 8 * (r >> 2) + 4 * hi; }
__device__ __forceinline__ unsigned cvtpk(float lo, float hi) { return cvt_pk_bf16(lo, hi); }
__device__ __forceinline__ void partialSM(f32x16& p0, f32x16& p1, float& m_reg, float& mn, float& alpha) {
  constexpr float C = SCALE * 1.4426950408889634f;
  float pmax = p0[0]; _Pragma("unroll") for (int r = 1; r < 16; ++r) pmax = fmaxf(pmax, p0[r]); _Pragma("unroll") for (int r = 0; r < 16; ++r) pmax = fmaxf(pmax, p1[r]);
  { auto rr = __builtin_amdgcn_permlane32_swap(__float_as_uint(pmax), __float_as_uint(pmax), false, false);
    pmax = fmaxf(__uint_as_float(rr[0]), __uint_as_float(rr[1])); }
  if (__builtin_expect(__all(pmax - m_reg <= THR / SCALE), 1)) { mn = m_reg; alpha = 1.f; }
  else { mn = fmaxf(m_reg, pmax); alpha = __builtin_amdgcn_exp2f((m_reg - mn) * C); m_reg = mn; }
  float mnC = -mn * C;
  _Pragma("unroll") for (int r = 0; r < 16; ++r) p0[r] = fmaf(p0[r], C, mnC); _Pragma("unroll") for (int r = 0; r < 16; ++r) p1[r] = fmaf(p1[r], C, mnC);
  _Pragma("unroll") for (int r = 0; r < 16; ++r) p0[r] = __builtin_amdgcn_exp2f(p0[r]);
}
__device__ __forceinline__ void finishSM(f32x16& p0, f32x16& p1, float alpha, float& l_reg, bf16x8& pa0, bf16x8& pa1, bf16x8& pa2, bf16x8& pa3) {
  _Pragma("unroll") for (int r = 0; r < 16; ++r) p1[r] = __builtin_amdgcn_exp2f(p1[r]);
  float ps = 0; _Pragma("unroll") for (int r = 0; r < 16; ++r) ps += p0[r]; _Pragma("unroll") for (int r = 0; r < 16; ++r) ps += p1[r];
  { auto rr = __builtin_amdgcn_permlane32_swap(__float_as_uint(ps), __float_as_uint(ps), false, false);
    ps = __uint_as_float(rr[0]) + __uint_as_float(rr[1]); }
  l_reg = l_reg * alpha + ps;
#define PK4(Pv, BASE, OUT) do { unsigned a0 = cvtpk(Pv[BASE + 0], Pv[BASE + 1]), a1 = cvtpk(Pv[BASE + 2], Pv[BASE + 3]);   \
    unsigned b0 = cvtpk(Pv[BASE + 4], Pv[BASE + 5]), b1 = cvtpk(Pv[BASE + 6], Pv[BASE + 7]);                              \
    auto r0 = __builtin_amdgcn_permlane32_swap(a0, b0, false, false); auto r1 = __builtin_amdgcn_permlane32_swap(a1, b1, false, false); \
    u32x4 w = {r0[0], r1[0], r0[1], r1[1]}; OUT = *reinterpret_cast<bf16x8*>(&w); } while (0)
  PK4(p0, 0, pa0); PK4(p0, 8, pa1); PK4(p1, 0, pa2); PK4(p1, 8, pa3);
#undef PK4
}
__device__ __forceinline__ void qkt(f32x16& p0, f32x16& p1, const bf16_t* Ks, const bf16x8* qr, int r32, int hi) {
  p0 = f32x16{}; p1 = f32x16{};
  _Pragma("unroll") for (int d0 = 0; d0 < 8; ++d0) { int cb = (d0 * 16 + hi * 8) * 2;
    bf16x8 b0 = *reinterpret_cast<const bf16x8*>((const char*)Ks + KSWZ(r32, cb));
    bf16x8 b1 = *reinterpret_cast<const bf16x8*>((const char*)Ks + KSWZ(32 + r32, cb));
    p0 = __builtin_amdgcn_mfma_f32_32x32x16_bf16(b0, qr[d0], p0, 0, 0, 0);
    p1 = __builtin_amdgcn_mfma_f32_32x32x16_bf16(b1, qr[d0], p1, 0, 0, 0); }
}
__device__ __forceinline__ int v_st(int k, int c) { const int kk = (k & ~0xC) | ((k & 4) << 1) | ((k & 8) >> 1); return ((kk >> 3) * 4 + (c >> 5)) * 512 + ((kk & 7) * 32 + (c & 31)) * 2; }
__device__ __forceinline__ int v_rd_base(int lane) { return ((lane & 3) << 3) | (((lane >> 2) & 3) << 6) | (((lane >> 4) & 1) << 5) | (((lane >> 5) & 1) << 8); }
constexpr int v_rd_off(int d0, int ks, int half) { return d0 * 512 + ks * 4096 + half * 2048; }
template <int OFF> __device__ __forceinline__ s16x4 tr_read(int vb) {
  s16x4 r; asm volatile("ds_read_b64_tr_b16 %0, %1 offset:%2" : "=&v"(r) : "v"(vb), "i"(OFF) : "memory"); return r;
}
template <int D0> __device__ __forceinline__ void pv_one(f32x16& od, int vb, bf16x8 pa0, bf16x8 pa1, bf16x8 pa2, bf16x8 pa3) {
  const s16x4 l0 = tr_read<v_rd_off(D0, 0, 0)>(vb), h0 = tr_read<v_rd_off(D0, 0, 1)>(vb), l1 = tr_read<v_rd_off(D0, 1, 0)>(vb), h1 = tr_read<v_rd_off(D0, 1, 1)>(vb);
  const s16x4 l2 = tr_read<v_rd_off(D0, 2, 0)>(vb), h2 = tr_read<v_rd_off(D0, 2, 1)>(vb), l3 = tr_read<v_rd_off(D0, 3, 0)>(vb), h3 = tr_read<v_rd_off(D0, 3, 1)>(vb);
  asm volatile("s_waitcnt lgkmcnt(0)" ::: "memory"); SBAR();
#define PK(L, H) (bf16x8){L[0], L[1], L[2], L[3], H[0], H[1], H[2], H[3]}
  od = __builtin_amdgcn_mfma_f32_32x32x16_bf16(pa0, PK(l0, h0), od, 0, 0, 0);
  od = __builtin_amdgcn_mfma_f32_32x32x16_bf16(pa1, PK(l1, h1), od, 0, 0, 0);
  od = __builtin_amdgcn_mfma_f32_32x32x16_bf16(pa2, PK(l2, h2), od, 0, 0, 0);
  od = __builtin_amdgcn_mfma_f32_32x32x16_bf16(pa3, PK(l3, h3), od, 0, 0, 0);
#undef PK
}
__device__ __forceinline__ void pv_d0(f32x16* o, int vb, bf16x8 pa0, bf16x8 pa1, bf16x8 pa2, bf16x8 pa3) {
  pv_one<0>(o[0], vb, pa0, pa1, pa2, pa3); pv_one<1>(o[1], vb, pa0, pa1, pa2, pa3); pv_one<2>(o[2], vb, pa0, pa1, pa2, pa3); pv_one<3>(o[3], vb, pa0, pa1, pa2, pa3);
}
__device__ __forceinline__ void attn_dense_body(const bf16_t* __restrict__ Qb, const bf16_t* __restrict__ Kh, const bf16_t* __restrict__ Vh,
                                                bf16_t* __restrict__ Ob, int seq, char* lds) {
  const int tid = tid_(), wid = tid >> 6, lane = tid & 63, r32 = lane & 31, hi = lane >> 5;
  bf16_t* V_lds = (bf16_t*)lds; bf16_t* K_lds = (bf16_t*)(lds + 2 * SHM_V);
  float* ws = (float*)(lds + 2 * SHM_V + 2 * SHM_K) + wid * 64; float* li_l = ws; float* al_l = ws + 32;
  float m_reg = -1e30f, l_reg = 0; f32x16 o[4] = {}; bf16x8 qr[8];
  const bf16_t* Qw = Qb + (long)(wid * QBLK + r32) * LDQ + hi * 8;
_Pragma("unroll") for (int d0 = 0; d0 < 8; ++d0) qr[d0] = *reinterpret_cast<const bf16x8*>(Qw + d0 * 16);
  const int sr = tid >> 4, sc = (tid & 15) * 8, vst0 = v_st(sr, sc), vst1 = v_st(32 + sr, sc);
  const int vb0 = (int)(uintptr_t)V_lds + v_rd_base(lane);
  struct { bf16x8 vs0, vs1, ks0, ks1; } sr_[2];
#define SLOAD(i, k0) do { sr_[i].vs0 = *(const bf16x8*)(&Vh[(long)((k0) + sr) * LDK + sc]); sr_[i].vs1 = *(const bf16x8*)(&Vh[(long)((k0) + 32 + sr) * LDK + sc]); \
    sr_[i].ks0 = *(const bf16x8*)(&Kh[(long)((k0) + sr) * LDK + sc]); sr_[i].ks1 = *(const bf16x8*)(&Kh[(long)((k0) + 32 + sr) * LDK + sc]); } while (0)
#define SWRITE(b, i) do { *(bf16x8*)((char*)V_lds + (b) * SHM_V + vst0) = sr_[i].vs0;          \
    *(bf16x8*)((char*)V_lds + (b) * SHM_V + vst1) = sr_[i].vs1; int kc = sc * 2;               \
    *(bf16x8*)((char*)K_lds + (b) * SHM_K + KSWZ(sr, kc)) = sr_[i].ks0;                       \
    *(bf16x8*)((char*)K_lds + (b) * SHM_K + KSWZ(32 + sr, kc)) = sr_[i].ks1; } while (0)
#define SWAIT() asm volatile("s_waitcnt vmcnt(4)" ::: "memory")
#define RESC(a) do { if (__any((a) < 1.f)) { if (hi == 0) al_l[r32] = (a); asm volatile("s_waitcnt lgkmcnt(0)" ::: "memory"); \
    _Pragma("unroll") for (int d = 0; d < 4; ++d) _Pragma("unroll") for (int r = 0; r < 16; ++r) o[d][r] *= al_l[crow(r, hi)]; } } while (0)
  f32x16 pA0, pA1, pB0, pB1; float mnA, mnB, alA, alB; bf16x8 pa0, pa1, pa2, pa3; const int NT = seq / KVBLK;
  constexpr int SE = 0, SO = 1;
  SLOAD(SE, 0); asm volatile("s_waitcnt vmcnt(0)" ::: "memory"); SWRITE(0, SE); __syncthreads();
  qkt(pA0, pA1, K_lds, qr, r32, hi); partialSM(pA0, pA1, m_reg, mnA, alA);
  SLOAD(SO, KVBLK); if (2 < NT) SLOAD(SE, 2 * KVBLK);
  SWAIT(); SWRITE(1, SO); __syncthreads();
  for (int j = 1; j + 1 < NT; j += 2) {
    SBAR(); qkt(pB0, pB1, (bf16_t*)((char*)K_lds + SHM_K), qr, r32, hi);
    finishSM(pA0, pA1, alA, l_reg, pa0, pa1, pa2, pa3); SBAR();
    SLOAD(SO, (j + 2) * KVBLK); SBAR();
    pv_d0(o, vb0, pa0, pa1, pa2, pa3); partialSM(pB0, pB1, m_reg, mnB, alB);
    __syncthreads(); SWAIT(); SWRITE(0, SE);
    RESC(alB); __syncthreads();
    SBAR(); qkt(pA0, pA1, K_lds, qr, r32, hi);
    finishSM(pB0, pB1, alB, l_reg, pa0, pa1, pa2, pa3); SBAR();
    if (j + 3 < NT) SLOAD(SE, (j + 3) * KVBLK); SBAR();
    pv_d0(o, vb0 + (int)SHM_V, pa0, pa1, pa2, pa3); partialSM(pA0, pA1, m_reg, mnA, alA);
    __syncthreads(); SWAIT(); SWRITE(1, SO);
    RESC(alA); __syncthreads();
  }
  SBAR(); qkt(pB0, pB1, (bf16_t*)((char*)K_lds + SHM_K), qr, r32, hi);
  finishSM(pA0, pA1, alA, l_reg, pa0, pa1, pa2, pa3); SBAR();
  pv_d0(o, vb0, pa0, pa1, pa2, pa3); partialSM(pB0, pB1, m_reg, mnB, alB);
  __syncthreads(); RESC(alB);
  finishSM(pB0, pB1, alB, l_reg, pa0, pa1, pa2, pa3); SBAR();
  pv_d0(o, vb0 + (int)SHM_V, pa0, pa1, pa2, pa3);
  if (hi == 0) li_l[r32] = l_reg; asm volatile("s_waitcnt lgkmcnt(0)" ::: "memory");
  float rli[16];
_Pragma("unroll") for (int r = 0; r < 16; ++r) rli[r] = __builtin_amdgcn_rcpf(li_l[crow(r, hi)]);
  bf16_t* Ow = Ob + (long)(wid * QBLK) * LDO;
_Pragma("unroll") for (int r = 0; r < 16; ++r) { int orow = crow(r, hi);
    _Pragma("unroll") for (int d0 = 0; d0 < 4; ++d0) Ow[(long)orow * LDO + d0 * 32 + r32] = f2bf(o[d0][r] * rli[r]); }
#undef SLOAD
#undef SWRITE
#undef SWAIT
#undef RESC
}
}

__device__ __forceinline__ void ph0(const P& p, unsigned char* lds) {
  const int tid = tid_();
  float* MOD = (float*)(p.ws + OFF_MOD);
  float* sc = (float*)lds;
  float* red = sc + 9 * 1024;
  for (int i = tid; i < 9 * 1024; i += 512) { const int r = i >> 10, k = i & 1023; const float v = r < 8 ? p.c[r * 1024 + k] : p.c_ctx[k]; sc[i] = v / (1.f + expf(-v)); }
  __syncthreads();
  const int ng = tid & 31, kg = tid >> 5;
  for (int it = bid_(); it < 4 * 48; it += gridDim.x) {
    const int l = it / 48, nb = (it % 48) * 128;
    const float* w = p.w_mod + ((size_t)l * 1024 + kg * 64) * 6144 + nb + ng * 4;
    float acc[9][4];
#pragma unroll
    for (int r = 0; r < 9; ++r) { acc[r][0] = 0.f; acc[r][1] = 0.f; acc[r][2] = 0.f; acc[r][3] = 0.f; }
#pragma unroll 4
    for (int k = 0; k < 64; ++k) {
      const f32x4 wv = *(const f32x4*)(w + (size_t)k * 6144);
#pragma unroll
      for (int r = 0; r < 9; ++r) { const float s = sc[r * 1024 + kg * 64 + k]; acc[r][0] += s * wv[0]; acc[r][1] += s * wv[1]; acc[r][2] += s * wv[2]; acc[r][3] += s * wv[3]; }
    }
#pragma unroll
    for (int r = 0; r < 9; ++r) { float* d = red + (kg * 9 + r) * 128 + ng * 4; d[0] = acc[r][0]; d[1] = acc[r][1]; d[2] = acc[r][2]; d[3] = acc[r][3]; }
    __syncthreads();
    for (int o = tid; o < 9 * 128; o += 512) { const int r = o >> 7, n = o & 127; float s = 0.f;
      for (int g = 0; g < 16; ++g) s += red[(g * 9 + r) * 128 + n];
      MOD[(size_t)(l * 9 + r) * 6144 + nb + n] = s + p.b_mod[l * 6144 + nb + n]; }
    __syncthreads();
  }
  const int gtid = bid_() * 512 + tid, gsz = gridDim.x * 512;
  float* LB = (float*)(p.ws + OFF_LB);
  for (int i = gtid; i < 1024; i += gsz) { const float a0 = p.hg_lb[i], a1 = p.hg_lb[1024 + i]; LB[i] = 0.f; LB[1024 + i] = 1.f / (1.f + expf(a0 - a1)); }
  { float* ROPE = (float*)(p.ws + OFF_ROPE);
    for (int i = gtid; i < 64 * 32; i += gsz) { const int pos = i >> 5, j = i & 31; const float fr = exp2f(-(float)j * (13.287712379549449f / 32.f)); float sn, cs; sincosf((float)pos * fr, &sn, &cs); ROPE[2 * i] = cs; ROPE[2 * i + 1] = sn; } }
  bf16_t* CM256 = (bf16_t*)(p.ws + OFF_CM256);
  for (int i = gtid; i < 256 * 256; i += gsz) { const int k = i >> 8, j = i & 255; float s, c; sincospif((float)((k * j) & 255) * (1.f / 128.f), &s, &c);
    CM256[k * 512 + j] = f2bf(c * 0.0625f); CM256[k * 512 + 256 + j] = f2bf(-s * 0.0625f); }
}

__device__ __forceinline__ void modulate_rows(const P& p, int l, int which, int nrows, bool first, const float* fixP, const float* fixG) {
  const int tid = tid_(), wave = tid >> 6, lane = tid & 63;
  const GA float* MOD = (const GA float*)(p.ws + OFF_MOD);
  GA float* CX = (GA float*)(p.ws + OFF_CTXR);
  GA bf16_t* HB = (GA bf16_t*)(p.ws + OFF_HB);
  for (int row0 = bid_() * 16 + wave; row0 < nrows; row0 += gridDim.x * 16) {
    const bool lat = row0 < NLAT;
    const GA float* src = (const GA float*)(first ? (lat ? p.x + (size_t)row0 * 1024 : p.ctx + (size_t)(row0 - NLAT) * 1024) : (lat ? p.out + (size_t)row0 * 1024 : (float*)CX + (size_t)(row0 - NLAT) * 1024));
    f32x4 v[2][4]; float ss0 = 0.f, ss1 = 0.f;
#pragma unroll
    for (int j = 0; j < 4; ++j) { v[0][j] = *(const GA f32x4*)(src + j * 256 + lane * 4); v[1][j] = *(const GA f32x4*)(src + 8 * 1024 + j * 256 + lane * 4); }
    if (!lat && fixP) {
      const GA float* P0 = (const GA float*)fixP + (size_t)(row0 - NLAT) * 1024; const GA float* G0 = (const GA float*)fixG; GA float* xw = CX + (size_t)(row0 - NLAT) * 1024;
#pragma unroll
      for (int j = 0; j < 4; ++j) { const int col = j * 256 + lane * 4; const f32x4 g4 = *(const GA f32x4*)(G0 + col);
        v[0][j] += g4 * (*(const GA f32x4*)(P0 + col) + *(const GA f32x4*)(P0 + (size_t)NCTX * 1024 + col));
        v[1][j] += g4 * (*(const GA f32x4*)(P0 + 8 * 1024 + col) + *(const GA f32x4*)(P0 + (size_t)NCTX * 1024 + 8 * 1024 + col));
        *(GA f32x4*)(xw + col) = v[0][j]; *(GA f32x4*)(xw + 8 * 1024 + col) = v[1][j]; }
    }
    const GA float* sh = MOD + (size_t)(l * 9 + (lat ? (row0 >> 12) : 8)) * 6144 + (which ? 3072 : 0);
    f32x4 s4[4], c4[4];
#pragma unroll
    for (int j = 0; j < 4; ++j) { s4[j] = *(const GA f32x4*)(sh + j * 256 + lane * 4); c4[j] = *(const GA f32x4*)(sh + 1024 + j * 256 + lane * 4); }
#pragma unroll
    for (int j = 0; j < 4; ++j) { ss0 += v[0][j][0] * v[0][j][0] + v[0][j][1] * v[0][j][1] + v[0][j][2] * v[0][j][2] + v[0][j][3] * v[0][j][3];
      ss1 += v[1][j][0] * v[1][j][0] + v[1][j][1] * v[1][j][1] + v[1][j][2] * v[1][j][2] + v[1][j][3] * v[1][j][3]; }
    ss0 = wave_sum(ss0); ss1 = wave_sum(ss1);
    const float rs0 = rsqrtf(ss0 * (1.f / 1024.f) + EPS), rs1 = rsqrtf(ss1 * (1.f / 1024.f) + EPS);
    if (first && !lat) { GA float* dst = (GA float*)((float*)CX + (size_t)(row0 - NLAT) * 1024);
#pragma unroll
      for (int j = 0; j < 4; ++j) { *(GA f32x4*)(dst + j * 256 + lane * 4) = v[0][j]; *(GA f32x4*)(dst + 8 * 1024 + j * 256 + lane * 4) = v[1][j]; } }
#pragma unroll
    for (int j = 0; j < 4; ++j) { const int col = j * 256 + lane * 4;
      f32x4 h0, h1; for (int q = 0; q < 4; ++q) { h0[q] = v[0][j][q] * rs0 * (1.f + c4[j][q]) + s4[j][q]; h1[q] = v[1][j][q] * rs1 * (1.f + c4[j][q]) + s4[j][q]; }
      u32x2 w0, w1; w0.x = cvt_pk_bf16(h0[0], h0[1]); w0.y = cvt_pk_bf16(h0[2], h0[3]); w1.x = cvt_pk_bf16(h1[0], h1[1]); w1.y = cvt_pk_bf16(h1[2], h1[3]);
      *(GA u32x2*)(HB + (size_t)row0 * 1024 + col) = w0; *(GA u32x2*)(HB + (size_t)(row0 + 8) * 1024 + col) = w1; }
  }
}

__device__ __forceinline__ void convert_weights(const P& p, int l, unsigned char* lds, int wg, int nwg, int jlo = 0, int jhi = 4) {
  float* tile = (float*)lds;
  const int tid = tid_(), e = l >> 1; const bool even = !(l & 1);
  bf16_t* W1 = (bf16_t*)(p.ws + OFF_W1); bf16_t* W2 = (bf16_t*)(p.ws + OFF_W2); bf16_t* W3 = (bf16_t*)(p.ws + OFF_W3); bf16_t* W4 = (bf16_t*)(p.ws + ((l & 1) ? OFF_W4B : OFF_W4));
  if (wg < 0) return;
  int base = 0;
#pragma unroll 1
  for (int j = jlo; j < jhi; ++j) {
    const float* W; int K, N, ldw; bf16_t* Wt;
    if (j == 0) { if (even) { W = p.w_in_ab + (size_t)e * 1024 * 3072 + 512; K = 1024; N = 2560; ldw = 3072; Wt = W1 + 1024 * 1024; } else { W = p.w_qkv + (size_t)e * 1024 * 1536; K = 1024; N = 1536; ldw = 1536; Wt = W1; } }
    else if (j == 1) { W = (even ? p.w_out_ab : p.w_out_att) + (size_t)e * 1024 * 1024; K = 1024; N = 1024; ldw = 1024; Wt = W2; }
    else if (j == 2) { W = p.w_up + (size_t)l * 1024 * 5632; K = 1024; N = 5632; ldw = 5632; Wt = W3; }
    else { W = p.w_down + (size_t)l * 2816 * 1024; K = 2816; N = 1024; ldw = 1024; Wt = W4; }
    const int tn = N / 64, nt = (K / 64) * tn;
    int t0 = (wg - base) % nwg; if (t0 < 0) t0 += nwg;
    for (int t = t0; t < nt; t += nwg) {
      const int k0 = (t / tn) * 64, n0 = (t % tn) * 64;
#pragma unroll
      for (int i = 0; i < 2; ++i) { const int idx = tid + i * 512, kr = idx >> 4, nc = (idx & 15) * 4;
        const f32x4 v = *(const f32x4*)(W + (size_t)(k0 + kr) * ldw + n0 + nc);
        tile[kr * 65 + nc] = v[0]; tile[kr * 65 + nc + 1] = v[1]; tile[kr * 65 + nc + 2] = v[2]; tile[kr * 65 + nc + 3] = v[3]; }
      __syncthreads();
      { const int n = tid >> 3, kg = (tid & 7) * 8; u32x4 w;
        w.x = cvt_pk_bf16(tile[(kg + 0) * 65 + n], tile[(kg + 1) * 65 + n]); w.y = cvt_pk_bf16(tile[(kg + 2) * 65 + n], tile[(kg + 3) * 65 + n]);
        w.z = cvt_pk_bf16(tile[(kg + 4) * 65 + n], tile[(kg + 5) * 65 + n]); w.w = cvt_pk_bf16(tile[(kg + 6) * 65 + n], tile[(kg + 7) * 65 + n]);
        *(u32x4*)(Wt + (size_t)(n0 + n) * K + k0 + kg) = w; }
      __syncthreads();
    }
    base = (base + nt) % nwg;
  }
}

__device__ __forceinline__ void fold_dft(const P& p, int e, unsigned char* lds, int wg, int nwg) {
  LAS3 float* wt = (LAS3 float*)lds;
  LAS3 float* tc = wt + 16 * 129; LAS3 float* ts = tc + 128;
  const int tid = tid_();
  GA bf16_t* W1 = (GA bf16_t*)(p.ws + OFF_W1);
  const GA float* Wa = (const GA float*)(p.w_in_ab + (size_t)e * 1024 * 3072);
  __syncthreads();
  if (tid < 128) { float s, c; sincospif((float)tid * (1.f / 64.f), &s, &c); tc[tid] = c * 0.08838834764831845f; ts[tid] = s * 0.08838834764831845f; }
  for (int t = wg < 0 ? 256 : wg; t < 256; t += nwg) {
    const int kk0 = (t >> 2) * 16, g = t & 3;
    __syncthreads();
    for (int i = tid; i < 16 * 128; i += 512) { const int r = i >> 7, c = i & 127; wt[r * 129 + c] = Wa[(size_t)(kk0 + r) * 3072 + g * 128 + c]; }
    __syncthreads();
    const int kk = tid & 15, mw = tid >> 4;
    float ac[4], as[4];
#pragma unroll
    for (int i = 0; i < 4; ++i) { ac[i] = 0.f; as[i] = 0.f; }
    for (int c = 0; c < 128; ++c) { const float w = wt[kk * 129 + c];
#pragma unroll
      for (int i = 0; i < 4; ++i) { const int idx = (c * (mw + 32 * i)) & 127; ac[i] += w * tc[idx]; as[i] += w * ts[idx]; } }
#pragma unroll
    for (int i = 0; i < 4; ++i) { const int m = mw + 32 * i;
      W1[(size_t)(g * 128 + m) * 1024 + kk0 + kk] = f2bf(ac[i]); W1[(size_t)(512 + g * 128 + m) * 1024 + kk0 + kk] = f2bf(as[i]); }
  }
  __syncthreads();
}
__device__ __forceinline__ void gen_cm(const P& p, unsigned char* lds) {
  LAS3 bf16_t* tcos = (LAS3 bf16_t*)lds; LAS3 bf16_t* tsin = tcos + 4096;
  const int tid = tid_();
  __syncthreads();
  for (int j = tid; j < 4096; j += 512) { float s, c; sincospif((float)j * (1.f / 2048.f), &s, &c); tcos[j] = f2bf(c * 0.015625f); tsin[j] = f2bf(-s * 0.015625f); }
  __syncthreads();
  GA bf16_t* CM2 = (GA bf16_t*)(p.ws + OFF_CM2);
  const int gsz = gridDim.x * 512;
  for (int it = bid_() * 512 + tid; it < 4096 * 512; it += gsz) {
    const int k = it >> 9, j0 = (it & 511) * 8; unsigned w[4];
    const bool sinp = j0 >= 2048; const int jb = sinp ? j0 - 2048 : j0;
#pragma unroll
    for (int j = 0; j < 4; ++j) { const int i0 = (k * (jb + 2 * j)) & 4095, i1 = (i0 + k) & 4095;
      unsigned lo = sinp ? (unsigned)tsin[i0] : (unsigned)tcos[i0]; const unsigned hi = sinp ? (unsigned)tsin[i1] : (unsigned)tcos[i1];
      if (j == 0 && j0 == 2048) lo = (unsigned)tcos[(k * 2048) & 4095];
      w[j] = lo | (hi << 16); }
    u32x4 wv = {w[0], w[1], w[2], w[3]};
    *(GA u32x4*)(CM2 + (size_t)k * 4096 + j0) = wv;
  }
  __syncthreads();
}
__device__ __forceinline__ void ph_fold(const P& p, unsigned char* lds) {
  LAS3 bf16_t* T = (LAS3 bf16_t*)lds;
  const int tid = tid_();
  const GA bf16_t* Z = (const GA bf16_t*)(p.ws + OFF_ZT); GA bf16_t* ZF = (GA bf16_t*)(p.ws + OFF_ZF);
  const int tl = tid >> 3, mg = (tid & 7) * 8;
  const int mo = tid >> 3, tg = (tid & 7) * 8;
  for (int it = bid_(); it < 4096; it += gridDim.x) {
    const int part = it & 1, mt = (it >> 1) & 7, tt = (it >> 4) & 31, b = it >> 9;
    const int t = tt * 64 + tl, m0 = mt * 64;
    const GA bf16_t* zb = Z + (size_t)b * 4096 * 1024 + part * 512 + m0 + mg;
    u32x4 A = *(const GA u32x4*)(zb + (size_t)t * 1024);
    const u32x4 Bm = *(const GA u32x4*)(zb + (size_t)((4096 - t) & 4095) * 1024);
    if (part == 1 && t == 0) A = *(const GA u32x4*)(Z + ((size_t)b * 4096 + 2048) * 1024 + m0 + mg);
    unsigned o[4];
#pragma unroll
    for (int q = 0; q < 4; ++q) {
      float lo = bflo(A[q]), hi = bfhi(A[q]);
      if (t != 0) { if (part == 0) { lo += bflo(Bm[q]); hi += bfhi(Bm[q]); } else { lo -= bflo(Bm[q]); hi -= bfhi(Bm[q]); } }
      o[q] = cvt_pk_bf16(lo, hi);
    }
    __syncthreads();
#pragma unroll
    for (int q = 0; q < 4; ++q) *(LAS3 unsigned*)(T + tl * 66 + mg + 2 * q) = o[q];
    __syncthreads();
    unsigned w[4];
#pragma unroll
    for (int q = 0; q < 4; ++q) w[q] = (unsigned)T[(tg + 2 * q) * 66 + mo] | ((unsigned)T[(tg + 2 * q + 1) * 66 + mo] << 16);
    u32x4 wv = {w[0], w[1], w[2], w[3]};
    *(GA u32x4*)(ZF + ((size_t)b * 512 + m0 + mo) * 4096 + part * 2048 + tt * 64 + tg) = wv;
  }
  __syncthreads();
}

__device__ __forceinline__ int tcidx(int tb, int dir) { return dir ? (tb < 4 ? 3 - tb : 71 - tb) : tb; }
__device__ __forceinline__ int rowbase_of(int b, int tb) { return tb < 4 ? NLAT + b * 256 + tb * 64 : b * 4096 + (tb - 4) * 64; }
__device__ __forceinline__ void chunk_cumsum(const GA _Float16* LFc, int rowbase, int dir, int tq, int kch, LAS3 float* totl, float (&lf)[16], float (&bc)[16], float& T0, float& T1, float& T2, float& T3) {
#pragma unroll
  for (int i = 0; i < 16; ++i) { const int tau = 16 * tq + i, pp = dir ? 63 - tau : tau; lf[i] = (float)LFc[(size_t)(rowbase + pp) * 512]; }
  float run = 0.f;
#pragma unroll
  for (int i = 0; i < 16; ++i) { run += lf[i]; bc[i] = run; }
  totl[tq * 128 + kch] = run;
  __syncthreads();
  T0 = totl[kch]; T1 = totl[128 + kch]; T2 = totl[256 + kch]; T3 = totl[384 + kch];
  const float off = tq == 0 ? 0.f : (tq == 1 ? T0 : (tq == 2 ? T0 + T1 : T0 + T1 + T2));
#pragma unroll
  for (int i = 0; i < 16; ++i) bc[i] += off;
}
typedef unsigned short us2_t __attribute__((ext_vector_type(2)));
#define US2U(v) __builtin_bit_cast(unsigned, v)
__device__ __forceinline__ void ld16(unsigned& r, const bf16_t* sbase, unsigned voff) { asm volatile("global_load_ushort %0, %1, %2" : "=v"(r) : "v"(voff), "s"(sbase)); }
#define RAW_WAIT16(a) asm volatile("s_waitcnt vmcnt(0)" : "+v"(a[0]), "+v"(a[1]), "+v"(a[2]), "+v"(a[3]), "+v"(a[4]), "+v"(a[5]), "+v"(a[6]), "+v"(a[7]), \
    "+v"(a[8]), "+v"(a[9]), "+v"(a[10]), "+v"(a[11]), "+v"(a[12]), "+v"(a[13]), "+v"(a[14]), "+v"(a[15]) :: "memory")
__device__ __forceinline__ void pack2(const unsigned (&r)[16], us2_t (&pk)[8]) {
#pragma unroll
  for (int i = 0; i < 8; ++i) { pk[i].x = (unsigned short)r[2 * i]; pk[i].y = (unsigned short)r[2 * i + 1]; }
}
__device__ __forceinline__ void h1_load_raw(const P& p, int rowbase, int h, int dir, int tq, int kch, unsigned (&lfr)[16], unsigned (&vr)[16]) {
  const bf16_t* LFb = (const bf16_t*)(p.ws + (dir ? OFF_LF1 : OFF_LF0)) + (size_t)rowbase * 512 + h * 128;
  const bf16_t* Vb = (const bf16_t*)(p.ws + OFF_V) + (size_t)rowbase * 512 + h * 128;
#pragma unroll
  for (int i = 0; i < 16; ++i) { const int tau = 16 * tq + i, pp = dir ? 63 - tau : tau; const unsigned o0 = (unsigned)(pp * 1024 + kch * 2); ld16(lfr[i], LFb, o0); ld16(vr[i], Vb, o0); }
}
__device__ __forceinline__ void h3_load_raw(const P& p, int rowbase, int h, int dir, int tq, int kch, unsigned (&lfr)[16], unsigned (&qr)[16]) {
  const bf16_t* LFb = (const bf16_t*)(p.ws + (dir ? OFF_LF1 : OFF_LF0)) + (size_t)rowbase * 512 + h * 128;
  const bf16_t* Qb = (const bf16_t*)(p.ws + OFF_Q) + (size_t)rowbase * 512 + h * 128;
#pragma unroll
  for (int i = 0; i < 16; ++i) { const int tau = 16 * tq + i, pp = dir ? 63 - tau : tau; const unsigned o0 = (unsigned)(pp * 1024 + kch * 2); ld16(lfr[i], LFb, o0); ld16(qr[i], Qb, o0); }
}
__device__ __forceinline__ void h_load_raw(const P& p, int rowbase, int h, int dir, int tq, int kch, bool needq, us2_t (&lfr)[8], us2_t (&vr)[8], us2_t (&qr)[8]) {
  const GA bf16_t* LFc = (const GA bf16_t*)(p.ws + (dir ? OFF_LF1 : OFF_LF0)) + h * 128 + kch;
  const GA bf16_t* V = (const GA bf16_t*)(p.ws + OFF_V) + h * 128 + kch; const GA bf16_t* Q = (const GA bf16_t*)(p.ws + OFF_Q) + h * 128 + kch;
#pragma unroll
  for (int i = 0; i < 8; ++i) { const int tau = 16 * tq + 2 * i, p0 = dir ? 63 - tau : tau, p1 = dir ? p0 - 1 : p0 + 1; const size_t g0 = (size_t)(rowbase + p0) * 512, g1 = (size_t)(rowbase + p1) * 512;
    lfr[i].x = LFc[g0]; lfr[i].y = LFc[g1]; vr[i].x = V[g0]; vr[i].y = V[g1]; if (needq) { qr[i].x = Q[g0]; qr[i].y = Q[g1]; } }
}
__device__ __forceinline__ float h16bits(unsigned short w) { return (float)__builtin_bit_cast(_Float16, w); }
__device__ __forceinline__ void chunk_cumsum_raw(const us2_t (&lfr)[8], int tq, int kch, LAS3 float* totl, float (&lf)[16], float (&bc)[16], float& T0, float& T1, float& T2, float& T3) {
  float run = 0.f;
#pragma unroll
  for (int i = 0; i < 16; ++i) { lf[i] = h16bits((i & 1) ? lfr[i >> 1].y : lfr[i >> 1].x); run += lf[i]; bc[i] = run; }
  totl[tq * 128 + kch] = run;
  __syncthreads();
  T0 = totl[kch]; T1 = totl[128 + kch]; T2 = totl[256 + kch]; T3 = totl[384 + kch];
  const float off = tq == 0 ? 0.f : (tq == 1 ? T0 : (tq == 2 ? T0 + T1 : T0 + T1 + T2));
#pragma unroll
  for (int i = 0; i < 16; ++i) bc[i] += off;
}
__device__ __forceinline__ void ph_h1(const P& p, unsigned char* lds) {
  const int tid = tid_(), wid = tid >> 6, lane = tid & 63, r32 = lane & 31, hi = lane >> 5, kch = tid & 127, tq = tid >> 7;
  LAS3 bf16_t* KD = (LAS3 bf16_t*)lds;
  LAS3 bf16_t* VT = KD + 128 * 72;
  LAS3 float* totl = (LAS3 float*)(VT + 128 * 72);
  const GA bf16_t* V = (const GA bf16_t*)(p.ws + OFF_V);
  GA bf16_t* ST = (GA bf16_t*)(p.ws + OFF_ST); GA float* DEC = (GA float*)(p.ws + OFF_DEC);
  const int ti = wid >> 1;
  const int GS = gridDim.x;
  us2_t lfA[8], vv[8]; unsigned lfN[16], vN[16];
  { const int it0 = bid_(); if (it0 < 4352) { const int rest = it0 >> 3; h1_load_raw(p, rowbase_of(rest / 68, rest % 68), (it0 >> 1) & 3, it0 & 1, tq, kch, lfN, vN); RAW_WAIT16(lfN); RAW_WAIT16(vN); pack2(lfN, lfA); pack2(vN, vv); } }
  for (int it = bid_(); it < 4352; it += GS) {
    const int dir = it & 1, h = (it >> 1) & 3, rest = it >> 3, tb = rest % 68, b = rest / 68;
    const int tc = tcidx(tb, dir), stream = (b * 4 + h) * 2 + dir;
    { const int itn = it + GS; if (itn < 4352) { const int restn = itn >> 3; h1_load_raw(p, rowbase_of(restn / 68, restn % 68), (itn >> 1) & 3, itn & 1, tq, kch, lfN, vN); } }
    float lf[16], bc[16], T0, T1, T2, T3;
    chunk_cumsum_raw(lfA, tq, kch, totl, lf, bc, T0, T1, T2, T3);
    const float blast = T0 + T1 + T2 + T3;
    float kd[16];
#pragma unroll
    for (int i = 0; i < 16; ++i) kd[i] = (1.f - __expf(lf[i])) * __expf(blast - bc[i]);
    u32x4 w0, w1;
    w0.x = cvt_pk_bf16(kd[0], kd[1]); w0.y = cvt_pk_bf16(kd[2], kd[3]); w0.z = cvt_pk_bf16(kd[4], kd[5]); w0.w = cvt_pk_bf16(kd[6], kd[7]);
    w1.x = cvt_pk_bf16(kd[8], kd[9]); w1.y = cvt_pk_bf16(kd[10], kd[11]); w1.z = cvt_pk_bf16(kd[12], kd[13]); w1.w = cvt_pk_bf16(kd[14], kd[15]);
    *(LAS3 u32x4*)(KD + kch * 72 + 16 * tq) = w0; *(LAS3 u32x4*)(KD + kch * 72 + 16 * tq + 8) = w1;
    w0.x = US2U(vv[0]); w0.y = US2U(vv[1]); w0.z = US2U(vv[2]); w0.w = US2U(vv[3]); w1.x = US2U(vv[4]); w1.y = US2U(vv[5]); w1.z = US2U(vv[6]); w1.w = US2U(vv[7]);
    *(LAS3 u32x4*)(VT + kch * 72 + 16 * tq) = w0; *(LAS3 u32x4*)(VT + kch * 72 + 16 * tq + 8) = w1;
    if (tq == 0) DEC[(size_t)(stream * 68 + tc) * 128 + kch] = __expf(blast);
    __syncthreads();
    GA bf16_t* UT = ST + (size_t)(stream * 68 + tc) * 16384;
#pragma unroll
    for (int jj = 0; jj < 2; ++jj) {
      const int tj = (wid & 1) * 2 + jj;
      f32x16 acc = {};
#pragma unroll
      for (int ks = 0; ks < 4; ++ks) {
        const bf16x8 a = *(const LAS3 bf16x8*)(KD + (32 * ti + r32) * 72 + ks * 16 + hi * 8);
        const bf16x8 bq = *(const LAS3 bf16x8*)(VT + (32 * tj + r32) * 72 + ks * 16 + hi * 8);
        acc = __builtin_amdgcn_mfma_f32_32x32x16_bf16(a, bq, acc, 0, 0, 0);
      }
#pragma unroll
      for (int rg = 0; rg < 4; ++rg) { u32x2 w; w.x = cvt_pk_bf16(acc[4 * rg], acc[4 * rg + 1]); w.y = cvt_pk_bf16(acc[4 * rg + 2], acc[4 * rg + 3]);
        *(GA u32x2*)(UT + (size_t)(32 * tj + r32) * 128 + 32 * ti + 8 * rg + 4 * hi) = w; }
    }
    __syncthreads();
    if (it + GS < 4352) { RAW_WAIT16(lfN); RAW_WAIT16(vN); pack2(lfN, lfA); pack2(vN, vv); }
  }
}
__device__ __forceinline__ void ph_h2(const P& p) {
  GA bf16_t* ST = (GA bf16_t*)(p.ws + OFF_ST); const GA float* DEC = (const GA float*)(p.ws + OFF_DEC);
  for (int idx = bid_() * 512 + tid_(); idx < 64 * 2048; idx += gridDim.x * 512) {
    const int stream = idx >> 11, e8 = idx & 2047, k0 = (e8 & 15) * 8;
    GA bf16_t* base = ST + (size_t)stream * 68 * 16384 + e8 * 8; const GA float* dec = DEC + (size_t)stream * 68 * 128 + k0;
    float S[8];
#pragma unroll
    for (int j = 0; j < 8; ++j) S[j] = 0.f;
#pragma unroll 1
    for (int t0 = 0; t0 < 68; t0 += 4) {
      u32x4 u[4]; f32x4 d0[4], d1[4];
#pragma unroll
      for (int q = 0; q < 4; ++q) { u[q] = *(const GA u32x4*)(base + (size_t)(t0 + q) * 16384); d0[q] = *(const GA f32x4*)(dec + (t0 + q) * 128); d1[q] = *(const GA f32x4*)(dec + (t0 + q) * 128 + 4); }
#pragma unroll
      for (int q = 0; q < 4; ++q) {
        u32x4 w; w.x = cvt_pk_bf16(S[0], S[1]); w.y = cvt_pk_bf16(S[2], S[3]); w.z = cvt_pk_bf16(S[4], S[5]); w.w = cvt_pk_bf16(S[6], S[7]);
        *(GA u32x4*)(base + (size_t)(t0 + q) * 16384) = w;
        S[0] = d0[q][0] * S[0] + bflo(u[q].x); S[1] = d0[q][1] * S[1] + bfhi(u[q].x); S[2] = d0[q][2] * S[2] + bflo(u[q].y); S[3] = d0[q][3] * S[3] + bfhi(u[q].y);
        S[4] = d1[q][0] * S[4] + bflo(u[q].z); S[5] = d1[q][1] * S[5] + bfhi(u[q].z); S[6] = d1[q][2] * S[6] + bflo(u[q].w); S[7] = d1[q][3] * S[7] + bfhi(u[q].w);
      }
    }
  }
}
__device__ __forceinline__ void ph_h3(const P& p, int e, unsigned char* lds) {
  const int tid = tid_(), wid = tid >> 6, lane = tid & 63, r32 = lane & 31, hi = lane >> 5, kch = tid & 127, tq = tid >> 7;
  LAS3 bf16_t* QBt = (LAS3 bf16_t*)lds;
  LAS3 bf16_t* QXt = QBt + 64 * 136;
  LAS3 bf16_t* KXt = QXt + 64 * 136;
  LAS3 bf16_t* YTt = KXt + 64 * 136;
  LAS3 bf16_t* VTt = YTt + 64 * 136;
  LAS3 bf16_t* ATt = VTt + 128 * 72;
  LAS3 float* totl = (LAS3 float*)(ATt + 64 * 72);
  LAS3 float* OT = (LAS3 float*)lds;
  const GA bf16_t* Q = (const GA bf16_t*)(p.ws + OFF_Q); const GA bf16_t* V = (const GA bf16_t*)(p.ws + OFF_V); const GA bf16_t* G = (const GA bf16_t*)(p.ws + OFF_G);
  const GA bf16_t* ST = (const GA bf16_t*)(p.ws + OFF_ST); GA bf16_t* MIX = (GA bf16_t*)(p.ws + OFF_MIX);
  const GA float* gn = (const GA float*)(p.hg_ng + e * 512);
  const int ti = wid >> 2, tj = wid & 3;
  const int GS = gridDim.x;
  us2_t lfA[8], qraw[8]; unsigned lfN[16], qN[16];
  { const int it0 = bid_(); if (it0 < 2176) { const int rest = it0 >> 2; h3_load_raw(p, rowbase_of(rest / 68, rest % 68), it0 & 3, 0, tq, kch, lfN, qN); RAW_WAIT16(lfN); RAW_WAIT16(qN); pack2(lfN, lfA); pack2(qN, qraw); } }
  const int ppv = tid >> 3, cgv = tid & 7;
  for (int it = bid_(); it < 2176; it += GS) {
    const int h = it & 3, rest = it >> 2, tb = rest % 68, b = rest / 68;
    const int rowbase = rowbase_of(b, tb);
    f32x16 o = {};
#pragma unroll 1
    for (int dir = 0; dir < 2; ++dir) {
      const int tc = tcidx(tb, dir), stream = (b * 4 + h) * 2 + dir;
      const GA bf16_t* Sg = ST + (size_t)(stream * 68 + tc) * 16384;
      bf16x8 sfr[8];
#pragma unroll
      for (int ks = 0; ks < 8; ++ks) sfr[ks] = *(const GA bf16x8*)(Sg + (size_t)(32 * tj + r32) * 128 + ks * 16 + hi * 8);
      u32x4 vw0, vw1;
      if (dir == 0) { const GA bf16_t* vp = V + (size_t)(rowbase + ppv) * 512 + h * 128 + cgv * 16; vw0 = *(const GA u32x4*)vp; vw1 = *(const GA u32x4*)(vp + 8); }
      if (dir == 0) h3_load_raw(p, rowbase, h, 1, tq, kch, lfN, qN);
      else { const int itn = it + GS; if (itn < 2176) { const int restn = itn >> 2; h3_load_raw(p, rowbase_of(restn / 68, restn % 68), itn & 3, 0, tq, kch, lfN, qN); } }
      float lf[16], bc[16], T0, T1, T2, T3;
      chunk_cumsum_raw(lfA, tq, kch, totl, lf, bc, T0, T1, T2, T3);
      const float R31 = T0 + T1, refx = tq < 2 ? T0 : R31 + T2;
#pragma unroll 1
      for (int rep_ = 0; rep_ < REP_FILL; ++rep_)
#pragma unroll
      for (int i = 0; i < 16; ++i) {
        const int tau = 16 * tq + i, pp = dir ? 63 - tau : tau;
        const float qv = bf2f((i & 1) ? qraw[i >> 1].y : qraw[i >> 1].x), kkv = 1.f - __expf(lf[i]), bi = bc[i];
        QBt[pp * 136 + kch] = f2bf(qv * __expf(bi));
        QXt[pp * 136 + kch] = f2bf(qv * __expf(fminf(bi - refx, 80.f)));
        KXt[pp * 136 + kch] = f2bf(kkv * __expf(fminf(refx - bi, 80.f)));
        YTt[pp * 136 + kch] = tq < 2 ? f2bf(kkv * __expf(R31 - bi)) : f2bf(qv * __expf(bi - R31));
      }
      if (dir == 0) {
#pragma unroll
        for (int j = 0; j < 8; ++j) { VTt[(cgv * 16 + j) * 72 + ppv] = (bf16_t)((j & 1) ? (vw0[j >> 1] >> 16) : (vw0[j >> 1] & 0xffffu)); VTt[(cgv * 16 + 8 + j) * 72 + ppv] = (bf16_t)((j & 1) ? (vw1[j >> 1] >> 16) : (vw1[j >> 1] & 0xffffu)); }
      }
      __syncthreads();
#pragma unroll
      for (int ks = 0; ks < 8; ++ks) {
        const bf16x8 a = *(const LAS3 bf16x8*)(QBt + (32 * ti + r32) * 136 + ks * 16 + hi * 8);
        o = __builtin_amdgcn_mfma_f32_32x32x16_bf16(a, sfr[ks], o, 0, 0, 0);
      }
      if (wid < 4) {
        const int I = wid >> 1, J = wid & 1;
        const bool diag = (I == J), offd = dir ? (I == 0 && J == 1) : (I == 1 && J == 0);
        f32x16 acc = {};
        if (diag || offd) {
          const LAS3 bf16_t* Ap = diag ? QXt : YTt; const LAS3 bf16_t* Bp = diag ? KXt : YTt;
#pragma unroll
          for (int ks = 0; ks < 8; ++ks) {
            const bf16x8 a = *(const LAS3 bf16x8*)(Ap + (32 * I + r32) * 136 + ks * 16 + hi * 8);
            const bf16x8 bq = *(const LAS3 bf16x8*)(Bp + (32 * J + r32) * 136 + ks * 16 + hi * 8);
            acc = __builtin_amdgcn_mfma_f32_32x32x16_bf16(a, bq, acc, 0, 0, 0);
          }
        }
#pragma unroll
        for (int r = 0; r < 16; ++r) { const int t = (r & 3) + 8 * (r >> 2) + 4 * hi;
          const bool keep = !diag || (dir ? (r32 >= t) : (r32 <= t));
          ATt[(32 * I + t) * 72 + 32 * J + r32] = f2bf(keep ? acc[r] : 0.f); }
      }
      __syncthreads();
#pragma unroll
      for (int ks = 0; ks < 4; ++ks) {
        const bf16x8 a = *(const LAS3 bf16x8*)(ATt + (32 * ti + r32) * 72 + ks * 16 + hi * 8);
        const bf16x8 bq = *(const LAS3 bf16x8*)(VTt + (32 * tj + r32) * 72 + ks * 16 + hi * 8);
        o = __builtin_amdgcn_mfma_f32_32x32x16_bf16(a, bq, o, 0, 0, 0);
      }
      __syncthreads();
      if (dir == 0 || it + GS < 2176) { RAW_WAIT16(lfN); RAW_WAIT16(qN); pack2(lfN, lfA); pack2(qN, qraw); }
    }
#pragma unroll
    for (int r = 0; r < 16; ++r) OT[(32 * ti + (r & 3) + 8 * (r >> 2) + 4 * hi) * 132 + 32 * tj + r32] = o[r];
    __syncthreads();
    {
      const int pp = tid >> 3, seg = tid & 7, row = rowbase + pp;
      float ov[16]; float ss = 0.f;
#pragma unroll
      for (int q = 0; q < 4; ++q) { const f32x4 v4 = *(const LAS3 f32x4*)(OT + pp * 132 + seg * 16 + q * 4); ov[q * 4] = v4[0]; ov[q * 4 + 1] = v4[1]; ov[q * 4 + 2] = v4[2]; ov[q * 4 + 3] = v4[3];
        ss += v4[0] * v4[0] + v4[1] * v4[1] + v4[2] * v4[2] + v4[3] * v4[3]; }
      ss += __shfl_xor(ss, 1); ss += __shfl_xor(ss, 2); ss += __shfl_xor(ss, 4);
      const float rs = rsqrtf(ss * (1.f / 128.f) + EPS);
      const u32x4 g0 = *(const GA u32x4*)(G + (size_t)row * 512 + h * 128 + seg * 16), g1 = *(const GA u32x4*)(G + (size_t)row * 512 + h * 128 + seg * 16 + 8);
      float y[16];
#pragma unroll
      for (int j = 0; j < 8; ++j) { y[j] = ov[j] * rs * gn[h * 128 + seg * 16 + j] * silu_f(UNPK(g0, j)); y[8 + j] = ov[8 + j] * rs * gn[h * 128 + seg * 16 + 8 + j] * silu_f(UNPK(g1, j)); }
      u32x4 w0, w1;
      w0.x = cvt_pk_bf16(y[0], y[1]); w0.y = cvt_pk_bf16(y[2], y[3]); w0.z = cvt_pk_bf16(y[4], y[5]); w0.w = cvt_pk_bf16(y[6], y[7]);
      w1.x = cvt_pk_bf16(y[8], y[9]); w1.y = cvt_pk_bf16(y[10], y[11]); w1.z = cvt_pk_bf16(y[12], y[13]); w1.w = cvt_pk_bf16(y[14], y[15]);
      GA bf16_t* dst = MIX + (size_t)row * 1024 + 512 + h * 128 + seg * 16;
      *(GA u32x4*)dst = w0; *(GA u32x4*)(dst + 8) = w1;
    }
    __syncthreads();
  }
}

__device__ __forceinline__ void ph_normrope(const P& p, int o) {
  const int tid = tid_(), wave = tid >> 6, lane = tid & 63;
  GA bf16_t* QB = (GA bf16_t*)(p.ws + OFF_QB); GA bf16_t* KB = (GA bf16_t*)(p.ws + OFF_KB);
  const GA float* ROPE = (const GA float*)(p.ws + OFF_ROPE);
  const float gq0 = p.qn_g[o * 128 + lane * 2], gq1 = p.qn_g[o * 128 + lane * 2 + 1], gk0 = p.kn_g[o * 128 + lane * 2], gk1 = p.kn_g[o * 128 + lane * 2 + 1];
  for (int row = bid_() * 8 + wave; row < NTOK; row += gridDim.x * 8) {
    GA bf16_t* qp = QB + (size_t)row * 1024 + lane * 2; GA bf16_t* kp = KB + (size_t)kvrow(row) * 256 + lane * 2;
    unsigned w[10];
#pragma unroll
    for (int s_ = 0; s_ < 8; ++s_) w[s_] = *(const GA unsigned*)(qp + s_ * 128);
    w[8] = *(const GA unsigned*)kp; w[9] = *(const GA unsigned*)(kp + 128);
    float cs = 1.f, sn = 0.f;
    if (row < NLAT) { const int t = row & 4095; const int pos = lane < 32 ? (t >> 6) : (t & 63); const GA float* cs2 = ROPE + 2 * (pos * 32 + (lane & 31)); cs = cs2[0]; sn = cs2[1]; }
#pragma unroll
    for (int s_ = 0; s_ < 10; ++s_) {
      const float x0 = bflo(w[s_]), x1 = bfhi(w[s_]);
      const float ss = wave_sum(x0 * x0 + x1 * x1);
      const float rs = rsqrtf(ss * (1.f / 128.f) + EPS);
      const float y0 = x0 * rs * (s_ < 8 ? gq0 : gk0), y1 = x1 * rs * (s_ < 8 ? gq1 : gk1);
      const unsigned ow = cvt_pk_bf16(y0 * cs - y1 * sn, y0 * sn + y1 * cs);
      if (s_ < 8) *(GA unsigned*)(qp + s_ * 128) = ow; else *(GA unsigned*)(kp + (s_ - 8) * 128) = ow;
    }
  }
}

__device__ __forceinline__ void ph_attn(const P& p, bool last, unsigned char* lds) {
  const bf16_t* QB = (const bf16_t*)(p.ws + OFF_QB); const bf16_t* KB = (const bf16_t*)(p.ws + OFF_KB); const bf16_t* VB = (const bf16_t*)(p.ws + OFF_VB);
  bf16_t* MIX = (bf16_t*)(p.ws + OFF_MIX);
#pragma unroll 1
  for (int r = 0; r < (last ? 4 : 5); ++r) {
    const int w = bid_(), bb = w & 7, jj = w >> 3;
    size_t qoff, koff; int seq;
    if (r < 4) { const int idx = r * 32 + jj, h = idx >> 4, qb = idx & 15; qoff = (size_t)(bb * 4096 + qb * 256) * 1024 + h * 128; koff = (size_t)bb * 4352 * 256 + (h >> 2) * 128; seq = 4352; }
    else { if (jj >= 8) break; const int h = jj; qoff = (size_t)(NLAT + bb * 256) * 1024 + h * 128; koff = ((size_t)bb * 4352 + 4096) * 256 + (h >> 2) * 128; seq = 256; }
    att::attn_dense_body(QB + qoff, KB + koff, VB + koff, MIX + qoff, seq, (char*)lds);
    __syncthreads();
  }
}

__device__ __forceinline__ void ph_conv(const P& p, int l, bool last) {
  const bf16_t* GATE = (const bf16_t*)(p.ws + OFF_GATE); bf16_t* VAL = (bf16_t*)(p.ws + OFF_VAL);
  const float* cw = p.conv_w + (size_t)l * 9 * 2816; const float* cb = p.conv_b + (size_t)l * 2816;
  const int gsz = gridDim.x * 512, gtid = bid_() * 512 + tid_();
  const u32x4 Z4 = {0u, 0u, 0u, 0u};
  for (int it = gtid; it < 2 * 8 * 64 * 352; it += gsz) {
    const int cg8 = it % 352; int rest = it / 352; const int col = rest & 63; rest >>= 6; const int b = rest & 7, seg = rest >> 3;
    const int c0 = cg8 * 8;
    float w[9][8], bias[8];
#pragma unroll
    for (int k = 0; k < 9; ++k) { const f32x4 a = *(const f32x4*)(cw + k * 2816 + c0), bq = *(const f32x4*)(cw + k * 2816 + c0 + 4);
      w[k][0] = a[0]; w[k][1] = a[1]; w[k][2] = a[2]; w[k][3] = a[3]; w[k][4] = bq[0]; w[k][5] = bq[1]; w[k][6] = bq[2]; w[k][7] = bq[3]; }
    { const f32x4 a = *(const f32x4*)(cb + c0), bq = *(const f32x4*)(cb + c0 + 4); bias[0] = a[0]; bias[1] = a[1]; bias[2] = a[2]; bias[3] = a[3]; bias[4] = bq[0]; bias[5] = bq[1]; bias[6] = bq[2]; bias[7] = bq[3]; }
    const size_t tb = (size_t)b * 4096;
#define LD3(r, A, Mi, C) do { if ((r) < 0 || (r) > 63) { A = Z4; Mi = Z4; C = Z4; } else { const bf16_t* q_ = GATE + (tb + (r) * 64 + col) * 2816 + c0; \
      Mi = *(const u32x4*)q_; A = col > 0 ? *(const u32x4*)(q_ - 2816) : Z4; C = col < 63 ? *(const u32x4*)(q_ + 2816) : Z4; } } while (0)
    u32x4 p0, p1, p2, q0, q1, q2, n0, n1, n2;
    const int r0 = seg * 32;
    LD3(r0 - 1, p0, p1, p2); LD3(r0, q0, q1, q2);
    for (int r = r0; r < r0 + 32; ++r) {
      LD3(r + 1, n0, n1, n2);
      bf16_t* vp = VAL + (tb + r * 64 + col) * 2816 + c0;
      const u32x4 vv = *(const u32x4*)vp;
      float a[8];
#pragma unroll
      for (int j = 0; j < 8; ++j) {
        float s = bias[j];
        s += w[0][j] * UNPK(p0, j) + w[1][j] * UNPK(p1, j) + w[2][j] * UNPK(p2, j);
        s += w[3][j] * UNPK(q0, j) + w[4][j] * UNPK(q1, j) + w[5][j] * UNPK(q2, j);
        s += w[6][j] * UNPK(n0, j) + w[7][j] * UNPK(n1, j) + w[8][j] * UNPK(n2, j);
        a[j] = silu_f(s) * UNPK(vv, j);
      }
      u32x4 ow; ow.x = cvt_pk_bf16(a[0], a[1]); ow.y = cvt_pk_bf16(a[2], a[3]); ow.z = cvt_pk_bf16(a[4], a[5]); ow.w = cvt_pk_bf16(a[6], a[7]);
      *(u32x4*)vp = ow;
      p0 = q0; p1 = q1; p2 = q2; q0 = n0; q1 = n1; q2 = n2;
    }
#undef LD3
  }
  if (!last) {
    for (int it = gtid; it < 8 * 32 * 352; it += gsz) {
      const int cg8 = it % 352, rest = it / 352, seg = rest & 31, b = rest >> 5, c0 = cg8 * 8, j0 = seg * 8;
      float w3[3][8], bias[8];
#pragma unroll
      for (int k = 0; k < 3; ++k) { const f32x4 wa = *(const f32x4*)(cw + (3 + k) * 2816 + c0), wb = *(const f32x4*)(cw + (3 + k) * 2816 + c0 + 4);
        w3[k][0] = wa[0]; w3[k][1] = wa[1]; w3[k][2] = wa[2]; w3[k][3] = wa[3]; w3[k][4] = wb[0]; w3[k][5] = wb[1]; w3[k][6] = wb[2]; w3[k][7] = wb[3]; }
      { const f32x4 wa = *(const f32x4*)(cb + c0), wb = *(const f32x4*)(cb + c0 + 4); bias[0] = wa[0]; bias[1] = wa[1]; bias[2] = wa[2]; bias[3] = wa[3]; bias[4] = wb[0]; bias[5] = wb[1]; bias[6] = wb[2]; bias[7] = wb[3]; }
      const size_t row0 = (size_t)NLAT + b * 256 + j0;
      const bf16_t* gq = GATE + row0 * 2816 + c0; bf16_t* vq = VAL + row0 * 2816 + c0;
      u32x4 g[10], vv[8];
#pragma unroll
      for (int i = 0; i < 10; ++i) { const int j = j0 - 1 + i; g[i] = (j >= 0 && j <= 255) ? *(const u32x4*)(gq + (ptrdiff_t)(i - 1) * 2816) : Z4; }
#pragma unroll
      for (int i = 0; i < 8; ++i) vv[i] = *(const u32x4*)(vq + (size_t)i * 2816);
#pragma unroll
      for (int i = 0; i < 8; ++i) {
        float a[8];
#pragma unroll
        for (int j = 0; j < 8; ++j) {
          const float sacc = bias[j] + w3[0][j] * UNPK(g[i], j) + w3[1][j] * UNPK(g[i + 1], j) + w3[2][j] * UNPK(g[i + 2], j);
          a[j] = silu_f(sacc) * UNPK(vv[i], j);
        }
        u32x4 ow; ow.x = cvt_pk_bf16(a[0], a[1]); ow.y = cvt_pk_bf16(a[2], a[3]); ow.z = cvt_pk_bf16(a[4], a[5]); ow.w = cvt_pk_bf16(a[6], a[7]);
        *(u32x4*)(vq + (size_t)i * 2816) = ow;
      }
    }
  }
}

__device__ __forceinline__ void ph_final(const P& p) {
  const int tid = tid_(), wave = tid >> 6, lane = tid & 63;
  f32x4 g4[4];
#pragma unroll
  for (int j = 0; j < 4; ++j) g4[j] = *(const GA f32x4*)((const GA float*)p.fn_g + j * 256 + lane * 4);
  for (int row = bid_() * 16 + wave; row < NLAT; row += gridDim.x * 16) {
    GA float* src = (GA float*)(p.out + (size_t)row * 1024);
    f32x4 v[2][4]; float ss0 = 0.f, ss1 = 0.f;
#pragma unroll
    for (int j = 0; j < 4; ++j) { v[0][j] = *(const GA f32x4*)(src + j * 256 + lane * 4); v[1][j] = *(const GA f32x4*)(src + 8 * 1024 + j * 256 + lane * 4); }
#pragma unroll
    for (int j = 0; j < 4; ++j) { ss0 += v[0][j][0] * v[0][j][0] + v[0][j][1] * v[0][j][1] + v[0][j][2] * v[0][j][2] + v[0][j][3] * v[0][j][3];
      ss1 += v[1][j][0] * v[1][j][0] + v[1][j][1] * v[1][j][1] + v[1][j][2] * v[1][j][2] + v[1][j][3] * v[1][j][3]; }
    ss0 = wave_sum(ss0); ss1 = wave_sum(ss1);
    const float rs0 = rsqrtf(ss0 * (1.f / 1024.f) + EPS), rs1 = rsqrtf(ss1 * (1.f / 1024.f) + EPS);
#pragma unroll
    for (int j = 0; j < 4; ++j) { f32x4 o0, o1; for (int q = 0; q < 4; ++q) { o0[q] = v[0][j][q] * rs0 * g4[j][q]; o1[q] = v[1][j][q] * rs1 * g4[j][q]; }
      *(GA f32x4*)(src + j * 256 + lane * 4) = o0; *(GA f32x4*)(src + 8 * 1024 + j * 256 + lane * 4) = o1; }
  }
}

__device__ __forceinline__ void run_phase(const P& p_in, int l, int ph, unsigned char* lds) {
  const bool even = !(l & 1), last = (l == 3); const int e = l >> 1;
  P p = p_in; asm volatile("" : "+s"(p.ws), "+s"(p.out));
  unsigned char* ws = p.ws;
  const float* MOD = (const float*)(ws + OFF_MOD);
  bf16_t* HB = (bf16_t*)(ws + OFF_HB); bf16_t* MIX = (bf16_t*)(ws + OFF_MIX);
  bf16_t* W1 = (bf16_t*)(ws + OFF_W1); bf16_t* W2 = (bf16_t*)(ws + OFF_W2); bf16_t* W3 = (bf16_t*)(ws + OFF_W3); bf16_t* W4 = (bf16_t*)(ws + OFF_W4);
  const int Mres = last ? NLAT : NTOK;
  if (ph == 0) {
    modulate_rows(p, l, 0, NTOK, l == 0, l > 0 ? (const float*)(ws + OFF_GATE) : nullptr, MOD + (size_t)((l > 0 ? l - 1 : 0) * 9 + 8) * 6144 + 5120);
    if (l == 0) { convert_weights(p, 0, lds, bid_(), (int)gridDim.x); fold_dft(p, 0, lds, bid_(), (int)gridDim.x); }
    if (even) gen_cm(p, lds);
  } else if (ph == 7) {
    EpiRes E{p.out, (float*)(ws + OFF_CTXR), MOD + (size_t)l * 9 * 6144 + 2048, l == 0 ? p.x : (const float*)p.out};
    run_gemm(lds, MIX, W2, NLAT, 1024, 1024, E);
    if (!last) { EpiPart Ep{(float*)(ws + OFF_MX), 512}; run_gemm_splitk(lds, MIX + (size_t)NLAT * 1024, W2, NCTX, 1024, 1024, 2, Ep); }
  } else if (ph == 8) {
    modulate_rows(p, l, 1, Mres, false, (const float*)(ws + OFF_MX), MOD + (size_t)(l * 9 + 8) * 6144 + 2048);
  } else if (ph == 9) {
    EpiUp E{(bf16_t*)(ws + OFF_GATE), (bf16_t*)(ws + OFF_VAL)};
    run_gemm(lds, HB, W3, Mres, 5632, 1024, E);
    if (!last) {
      __syncthreads();
      convert_weights(p, l + 1, lds, (int)bid_() - 176, (int)gridDim.x - 176, 0, 2);
    }
  } else if (ph == 10) {
    ph_conv(p, l, last);
  } else if (ph == 11) {
    EpiRes E{p.out, (float*)(ws + OFF_CTXR), MOD + (size_t)l * 9 * 6144 + 5120, (const float*)p.out};
    run_gemm(lds, (const bf16_t*)(ws + OFF_VAL), (const bf16_t*)(ws + ((l & 1) ? OFF_W4B : OFF_W4)), NLAT, 1024, 2816, E);
    if (!last) { EpiPart Ep{(float*)(ws + OFF_GATE), 1408}; run_gemm_splitk(lds, (const bf16_t*)(ws + OFF_VAL) + (size_t)NLAT * 2816, (const bf16_t*)(ws + ((l & 1) ? OFF_W4B : OFF_W4)), NCTX, 1024, 2816, 2, Ep); }
    if (!last) {
      const int wg = (int)bid_() - 64, nwg = (int)gridDim.x - 64;
      __syncthreads();
      convert_weights(p, l + 1, lds, wg, nwg, 2, 4);
      if (l & 1) fold_dft(p, (l + 1) >> 1, lds, wg, nwg);
    }
  } else if (even) {
    if (ph == 1) { EpiAB E{EpiZ{(bf16_t*)(ws + OFF_ZT), (bf16_t*)(ws + OFF_ZTC)},
                           EpiHG{(bf16_t*)(ws + OFF_Q), (bf16_t*)(ws + OFF_V), (bf16_t*)(ws + OFF_G), (_Float16*)(ws + OFF_LF0), (_Float16*)(ws + OFF_LF1), (const float*)(ws + OFF_LB) + e * 1024}};
      run_gemm(lds, HB, W1, NTOK, 3584, 1024, E); }
    else if (ph == 12) ph_fold(p, lds);
    else if (ph == 2) {
      { EpiDFT E{MIX, 0}; run_gemm(lds, (const bf16_t*)(ws + OFF_CM2), (const bf16_t*)(ws + OFF_ZF), 4096, 4096, 4096, E); }
      { EpiDFT E{MIX, 1}; run_gemm(lds, (const bf16_t*)(ws + OFF_CM256), (const bf16_t*)(ws + OFF_ZTC), 256, 4096, 512, E); }
    }
    else if (ph == 4) ph_h1(p, lds);
    else if (ph == 5) ph_h2(p);
    else if (ph == 6) ph_h3(p, e, lds);
  } else {
    if (ph == 1) { EpiQKV E{(bf16_t*)(ws + OFF_QB), (bf16_t*)(ws + OFF_KB), (bf16_t*)(ws + OFF_VB)}; run_gemm(lds, HB, W1, NTOK, 1536, 1024, E); }
    else if (ph == 2) ph_normrope(p, e);
    else if (ph == 3) ph_attn(p, last, lds);
  }
}

#if MULTI
__global__ void __launch_bounds__(512, 2) k_phase(P p, int l, int ph) {
  extern __shared__ __attribute__((aligned(16))) unsigned char lds[];
  if (l < 0) ph0(p, lds); else if (l >= 4) ph_final(p); else run_phase(p, l, ph, lds);
}
#else
__global__ void __launch_bounds__(512, 2) k_mega(P p) {
  extern __shared__ __attribute__((aligned(16))) unsigned char lds[];
  cg::grid_group grid = cg::this_grid();
  volatile LAS3 unsigned* st = (volatile LAS3 unsigned*)((LAS3 unsigned char*)lds + 131072);
  if (threadIdx.x == 0) { st[0] = 0u; st[1] = 0u; st[2] = 0u; st[3] = 0u; }
  __syncthreads();
  XcdBarrier bar = xcd_barrier_post((unsigned*)(p.ws + OFF_BAR), st);
  grid.sync();
  ph0(p, lds); xcd_barrier(bar);
#pragma unroll 1
  for (int l = 0; l < 4; ++l) {
#pragma unroll 1
    for (int sq = 0; sq <= 12; ++sq) {
      const int ph = sq < 2 ? sq : (sq == 2 ? 12 : sq - 1);
      if ((l & 1) ? ((ph >= 4 && ph <= 6) || ph == 12) : (ph == 3)) continue;
      run_phase(p, l, ph, lds);
      xcd_barrier(bar);
#if REP_MASK != 0
      if (((REP_MASK >> ph) & 1) && !(ph == 2 && (l & 1))) { run_phase(p, l, ph, lds); xcd_barrier(bar); }
#endif
    }
  }
  ph_final(p);
}
#endif

constexpr int LDS_BYTES = 131072 + 16;
extern "C" void kernel_launch(void* const* d_in, const int* in_sizes, int n_in, void* d_out, int out_size, void* d_ws, size_t ws_size, hipStream_t stream) {
  static int ok = 0;
  if (!ok) {
    if (n_in != 19 || ws_size < WS_END) { fprintf(stderr, "kernel_launch: unexpected n_in %d / ws %zu (need %zu)\n", n_in, ws_size, (size_t)WS_END); return; }
#if MULTI
    if (hipFuncSetAttribute((const void*)k_phase, hipFuncAttributeMaxDynamicSharedMemorySize, LDS_BYTES) != hipSuccess) { fprintf(stderr, "hipFuncSetAttribute failed\n"); return; }
#else
    if (hipFuncSetAttribute((const void*)k_mega, hipFuncAttributeMaxDynamicSharedMemorySize, LDS_BYTES) != hipSuccess) { fprintf(stderr, "hipFuncSetAttribute failed\n"); return; }
#endif
    ok = 1;
  }
  P p{};
  p.x = (const float*)d_in[0]; p.c = (const float*)d_in[1]; p.ctx = (const float*)d_in[2]; p.c_ctx = (const float*)d_in[3]; p.w_mod = (const float*)d_in[4]; p.b_mod = (const float*)d_in[5];
  p.w_in_ab = (const float*)d_in[6]; p.w_out_ab = (const float*)d_in[7]; p.hg_lb = (const float*)d_in[8]; p.hg_ng = (const float*)d_in[9]; p.w_qkv = (const float*)d_in[10];
  p.qn_g = (const float*)d_in[11]; p.kn_g = (const float*)d_in[12]; p.w_out_att = (const float*)d_in[13]; p.w_up = (const float*)d_in[14]; p.conv_w = (const float*)d_in[15];
  p.conv_b = (const float*)d_in[16]; p.w_down = (const float*)d_in[17]; p.fn_g = (const float*)d_in[18];
  p.out = (float*)d_out; p.ws = (unsigned char*)d_ws;
#if MULTI
  hipLaunchKernelGGL(k_phase, dim3(256), dim3(512), LDS_BYTES, stream, p, -1, 0);
  for (int l = 0; l < 4; ++l) for (int ph = 0; ph <= 11; ++ph) { if ((l & 1) && (ph >= 4 && ph <= 6)) continue; hipLaunchKernelGGL(k_phase, dim3(256), dim3(512), LDS_BYTES, stream, p, l, ph); }
  hipLaunchKernelGGL(k_phase, dim3(256), dim3(512), LDS_BYTES, stream, p, 4, 0);
#else
  if (hipMemsetAsync((char*)d_ws + OFF_BAR, 0, 16384, stream) != hipSuccess) { fprintf(stderr, "memset failed\n"); return; }
  void* args[] = {&p};
  hipError_t e = hipLaunchCooperativeKernel((const void*)k_mega, dim3(256), dim3(512), args, LDS_BYTES, stream);
  if (e != hipSuccess) fprintf(stderr, "cooperative launch failed: %s\n", hipGetErrorString(e));
#endif
}
```

```cpp
#include <hip/hip_runtime.h>
#include <hip/hip_bf16.h>
#include <hip/hip_cooperative_groups.h>
#include <cstdio>
namespace cg = cooperative_groups;

#ifndef REP_FILL
#define REP_FILL 1
#endif
#ifndef REP_MASK
#define REP_MASK 0
#endif
#ifndef MULTI
#define MULTI 0
#endif

typedef unsigned short bf16_t;
typedef short bf16x8 __attribute__((ext_vector_type(8)));
typedef short s16x4 __attribute__((ext_vector_type(4)));
typedef float f32x4 __attribute__((ext_vector_type(4)));
typedef float f32x16 __attribute__((ext_vector_type(16)));
typedef unsigned u32x4 __attribute__((ext_vector_type(4)));
typedef unsigned u32x2 __attribute__((ext_vector_type(2)));
typedef _Float16 h16x8 __attribute__((ext_vector_type(8)));

constexpr int NLAT = 32768, NCTX = 2048, NTOK = 34816;
constexpr float EPS = 1e-6f;

constexpr size_t OFF_CTXR = 0;
constexpr size_t OFF_MOD = OFF_CTXR + 8388608;
constexpr size_t OFF_LB = OFF_MOD + 1048576;
constexpr size_t OFF_CM256 = OFF_LB + 8192;
constexpr size_t OFF_HB = OFF_CM256 + 262144;
constexpr size_t OFF_W1 = OFF_HB + 71303168;
constexpr size_t OFF_W2 = OFF_W1 + 7340032;
constexpr size_t OFF_W3 = OFF_W2 + 2097152;
constexpr size_t OFF_W4 = OFF_W3 + 11534336;
constexpr size_t OFF_AL = OFF_W4 + 5767168;
constexpr size_t OFF_GATE = OFF_AL;
constexpr size_t OFF_VAL = OFF_GATE + 196083712;
constexpr size_t OFF_MIX = OFF_AL;
constexpr size_t OFF_MX = OFF_MIX + 71303168;
constexpr size_t OFF_Q = OFF_MX;
constexpr size_t OFF_V = OFF_Q + 35651584;
constexpr size_t OFF_G = OFF_V + 35651584;
constexpr size_t OFF_LF0 = OFF_G + 35651584;
constexpr size_t OFF_LF1 = OFF_LF0 + 35651584;
constexpr size_t OFF_O0 = OFF_LF1 + 35651584;
constexpr size_t OFF_O1 = OFF_O0 + 71303168;
constexpr size_t OFF_ZT = OFF_O0;
constexpr size_t OFF_ZTC = OFF_ZT + 67108864;
constexpr size_t OFF_ZF = OFF_ZTC + 4194304;
constexpr size_t OFF_CM2 = OFF_ZF + 33554432;
constexpr size_t OFF_CM = OFF_CM2;
constexpr size_t OFF_QB = OFF_MX;
constexpr size_t OFF_KB = OFF_QB + 71303168;
constexpr size_t OFF_VB = OFF_KB + 17825792;
constexpr size_t OFF_ST = OFF_O0;
constexpr size_t OFF_DEC = OFF_VAL + 196083712;
constexpr size_t OFF_W4B = OFF_DEC + 2228224;
constexpr size_t OFF_BAR = OFF_W4B + 5767168;
constexpr size_t OFF_ROPE = OFF_BAR + 16384;
constexpr size_t WS_END = OFF_ROPE + 16384;
static_assert(OFF_O1 + 71303168 <= OFF_DEC && OFF_CM2 + 33554432 <= OFF_DEC && OFF_VB + 17825792 <= WS_END, "alias region");

struct P {
  const float *x, *c, *ctx, *c_ctx, *w_mod, *b_mod, *w_in_ab, *w_out_ab, *hg_lb, *hg_ng, *w_qkv, *qn_g, *kn_g, *w_out_att, *w_up, *conv_w, *conv_b, *w_down, *fn_g;
  float* out; unsigned char* ws;
};

typedef __bf16 bf16v2_t __attribute__((ext_vector_type(2)));
typedef float f32v2_t __attribute__((ext_vector_type(2)));
__device__ __forceinline__ unsigned cvt_pk_bf16(float lo, float hi) { const f32v2_t v = {lo, hi}; const bf16v2_t r = __builtin_convertvector(v, bf16v2_t); return __builtin_bit_cast(unsigned, r); }
__device__ __forceinline__ bf16_t f2bf(float f) { return (bf16_t)(cvt_pk_bf16(f, 0.f) & 0xffffu); }
__device__ __forceinline__ float bflo(unsigned w) { return __uint_as_float(w << 16); }
__device__ __forceinline__ float bfhi(unsigned w) { return __uint_as_float(w & 0xffff0000u); }
__device__ __forceinline__ float bf2f(bf16_t v) { return __uint_as_float(((unsigned)v) << 16); }
#define GA __attribute__((address_space(1)))
#define LAS3 __attribute__((address_space(3)))
#define UNPK(w, j) (((j) & 1) ? bfhi((w)[(j) >> 1]) : bflo((w)[(j) >> 1]))
__device__ __forceinline__ float silu_f(float v) { return v * __builtin_amdgcn_rcpf(1.f + __expf(-v)); }
__device__ __forceinline__ float wave_sum(float v) {
#pragma unroll
  for (int o = 32; o > 0; o >>= 1) v += __shfl_xor(v, o);
  return v;
}
__device__ __forceinline__ int tid_() { int t = threadIdx.x; asm volatile("" : "+v"(t)); return t; }
__device__ __forceinline__ int bid_() { int b = blockIdx.x; asm volatile("" : "+s"(b)); return b; }
__device__ __forceinline__ int kvrow(int row) { return row < NLAT ? (row >> 12) * 4352 + (row & 4095) : ((row - NLAT) >> 8) * 4352 + 4096 + ((row - NLAT) & 255); }

#define XB_TMO      128
#define XB_XCNT(j)  (256  + 64 * (j))
#define XB_XSUB(j)  (1280 + 64 * (j))
#define XB_XGEN(j)  (2304 + 64 * (j))
#define XB_TOP      3328
#define XB_TOPGEN   3392
#define XCD_BAR_WORDS 3456
#define XB_SPIN_CAP (1u << 22)
__device__ __forceinline__ unsigned xb_ld(unsigned* p)              { return __hip_atomic_load(p, __ATOMIC_RELAXED, __HIP_MEMORY_SCOPE_AGENT); }
__device__ __forceinline__ unsigned xb_add(unsigned* p, unsigned v) { return __hip_atomic_fetch_add(p, v, __ATOMIC_RELAXED, __HIP_MEMORY_SCOPE_AGENT); }
__device__ __forceinline__ unsigned xb_xcc_id() { return (unsigned)__builtin_amdgcn_s_getreg((3 << 11) | 20) & 0xFu; }
#define XB_SPIN(cond, bar) do { unsigned _sp = 0; while (cond) { __builtin_amdgcn_s_sleep(1); \
    if ((++_sp & 255u) == 0u) { if (xb_ld(&(bar)[XB_TMO])) break; if (_sp > XB_SPIN_CAP) { atomicAdd(&(bar)[XB_TMO], 1u); break; } } } } while (0)
struct XcdBarrier { unsigned* bar; unsigned x; volatile LAS3 unsigned* st; };
__device__ __forceinline__ XcdBarrier xcd_barrier_post(unsigned* bar, volatile LAS3 unsigned* st) {
  XcdBarrier b; b.bar = bar; b.x = xb_xcc_id(); b.st = st;
  if (threadIdx.x == 0) (void)xb_add(&bar[XB_XCNT(b.x)], 1u);
  return b;
}
__device__ __forceinline__ void xcd_barrier_complete(unsigned* bar, unsigned x, unsigned& nloc, unsigned& nx) {
  const unsigned G = gridDim.x * gridDim.y * gridDim.z;
  unsigned sum, cnt, mine, sp = 0u;
  for (;;) {
    sum = 0u; cnt = 0u; mine = 0u;
#pragma unroll
    for (unsigned j = 0; j < 16; ++j) { const unsigned c = xb_ld(&bar[XB_XCNT(j)]); sum += c; cnt += (c > 0u) ? 1u : 0u; mine = (j == x) ? c : mine; }
    if (sum == G) break;
    __builtin_amdgcn_s_sleep(1);
    if ((++sp & 255u) == 0u) { if (xb_ld(&bar[XB_TMO])) break; if (sp > XB_SPIN_CAP) { atomicAdd(&bar[XB_TMO], 1u); break; } }
  }
  nloc = mine > 0u ? mine : 1u; nx = cnt > 0u ? cnt : 1u;
}
__device__ __forceinline__ void xcd_barrier(const XcdBarrier& b) {
  asm volatile("s_waitcnt vmcnt(0)" ::: "memory");
  __syncthreads();
  if (threadIdx.x == 0) {
    unsigned* bar = b.bar; unsigned bx = __builtin_amdgcn_readfirstlane(b.x);
    asm volatile("" : "+s"(bar), "+s"(bx));
    __builtin_amdgcn_s_waitcnt(0);
    unsigned nloc = b.st[0], nx = b.st[1];
    if (nloc == 0u) { xcd_barrier_complete(bar, bx, nloc, nx); b.st[0] = nloc; b.st[1] = nx; }
    const unsigned old = xb_add(&bar[XB_XSUB(bx)], 1u);
    const unsigned gen = old / nloc;
    if (old + 1u == (gen + 1u) * nloc) {
      __builtin_amdgcn_fence(__ATOMIC_RELEASE, "agent");
      asm volatile("s_waitcnt vmcnt(0)" ::: "memory");
      const unsigned og = xb_add(&bar[XB_TOP], 1u);
      const unsigned tg = og / nx;
      if (og + 1u == (tg + 1u) * nx) xb_add(&bar[XB_TOPGEN], 1u);
      else XB_SPIN(xb_ld(&bar[XB_TOPGEN]) == tg, bar);
      __builtin_amdgcn_fence(__ATOMIC_ACQUIRE, "agent");
      xb_add(&bar[XB_XGEN(bx)], 1u);
      asm volatile("s_waitcnt vmcnt(0)" ::: "memory");
    } else {
      XB_SPIN(xb_ld(&bar[XB_XGEN(bx)]) == gen, bar);
      __builtin_amdgcn_fence(__ATOMIC_ACQUIRE, "agent");
      asm volatile("s_waitcnt vmcnt(0)" ::: "memory");
    }
  }
  __syncthreads();
}

namespace pg8 {
#define PG8_LAS __attribute__((address_space(3)))
constexpr int BM = 256, BK = 64, HALF = 128, HTB = HALF * BK * 2, STAGE_BYTES = 8 * HTB, NXCD = 8, WGM = 8;
__device__ __forceinline__ int lds_byte(int r, int c) { const int st = (r >> 4) * 2 + (c >> 5), rr = r & 15, cc = c & 31, ob = rr * 64 + cc * 2; return st * 1024 + (ob ^ (((ob >> 9) & 1) << 5)); }
__device__ __forceinline__ void stage_rc(int b, int& R, int& C) { const int st = b / 1024, sb = b % 1024, swz = sb ^ (((sb >> 9) & 1) << 5); R = (st >> 1) * 16 + swz / 64; C = (st & 1) * 32 + (swz % 64) / 2; }
__device__ __forceinline__ int perm32(int rho) { const int n = rho >> 4, i = rho & 15; return 8 * (i >> 2) + 4 * n + (i & 3); }
struct Unit { int pm, pn, ko; };
struct Gemm { const bf16_t* A; const bf16_t* Bt; int M, N, K, ldk; };
struct StaticOrder {
  int nM, nN, nwg, G, c;
  __device__ void init(int M, int N, int G_, int c_) { nM = M / BM; nN = N / BM; nwg = nM * nN; G = G_; c = c_; }
  __device__ bool next(int i, Unit& u) const {
    const long L = (long)i * G + c; if (L >= nwg) return false;
    int wgid = (int)L; { const int q = nwg / NXCD, r = nwg % NXCD, xcd = wgid % NXCD, off = wgid / NXCD; wgid = (xcd < r ? xcd * (q + 1) : r * (q + 1) + (xcd - r) * q) + off; }
    const int nig = WGM * nN, gid = wgid / nig, fm = gid * WGM, gsz = (nM - fm) < WGM ? (nM - fm) : WGM;
    u.pm = fm + ((wgid % nig) % gsz); u.pn = (wgid % nig) / gsz; u.ko = 0; return true;
  }
};
struct SplitKOrder {
  int nN, ns, nwg, G, c, ksub;
  __device__ void init(int M, int N, int ns_, int ksub_, int G_, int c_) { nN = N / BM; ns = ns_; ksub = ksub_; nwg = (M / BM) * nN * ns; G = G_; c = c_; }
  __device__ bool next(int i, Unit& u) const {
    const int L = i * G + c; if (L >= nwg) return false;
    u.ko = (L % ns) * ksub; u.pn = (L / ns) % nN; u.pm = L / (ns * nN); return true;
  }
};

#ifndef GEMM_SP2
#define GEMM_SP2 1
#endif
#ifndef GEMM_ALIGN
#define GEMM_ALIGN 1
#endif
template <class Epi, class Sched>
__device__ __forceinline__ void gemm_phase(PG8_LAS unsigned char* lds, const Gemm g, const Sched& S, const Epi& E) {
  const int tid = tid_(), wid = __builtin_amdgcn_readfirstlane(tid >> 6), lane = tid & 63, wr = wid >> 2, wc = wid & 3, fr = lane & 15, fq = lane >> 4;
  const int K = g.ldk, nt = g.K / BK;
  unsigned voffA[2], voffB[2];
#pragma unroll
  for (int i = 0; i < 2; ++i) { int R, C; stage_rc(tid * 16 + i * 8192, R, C); const int Rb = Epi::PERM ? ((R & ~31) + perm32(R & 31)) : R;
    voffA[i] = (unsigned)(R * K + C) * 2u; voffB[i] = (unsigned)(Rb * K + C) * 2u; }
  const size_t kstep = (size_t)(BK * 2);
  const size_t hstep = (size_t)HALF * K * 2;
  const size_t tstep = 2 * hstep;
  const unsigned ldsw = (unsigned)wid * 1024u;
  const int aoff = lds_byte(wr * 64 + fr, fq * 8), boff = lds_byte(wc * 32 + fr, fq * 8);
#define PG8_SA(b, h) (((b) * 2 + (h)) * HTB)
#define PG8_SB(b, h) ((4 + (b) * 2 + (h)) * HTB)
#define PG8_STAGE(bufoff, gbase, voff) do { _Pragma("unroll") for (int _i = 0; _i < 2; ++_i) \
    __builtin_amdgcn_global_load_lds((const unsigned*)((const char*)(gbase) + (voff)[_i]), (PG8_LAS unsigned*)(lds + (bufoff) + ldsw + _i * 8192), 16, 0, 0); } while (0)
#define PG8_LDA(dst, b, h) do { _Pragma("unroll") for (int m = 0; m < 4; ++m) _Pragma("unroll") for (int k = 0; k < 2; ++k) dst[m][k] = *(const PG8_LAS bf16x8*)(lds + PG8_SA(b, h) + aoff + m * 2048 + k * 1024); } while (0)
#define PG8_LDB(dst, b, h) do { _Pragma("unroll") for (int n = 0; n < 2; ++n) _Pragma("unroll") for (int k = 0; k < 2; ++k) dst[n][k] = *(const PG8_LAS bf16x8*)(lds + PG8_SB(b, h) + boff + n * 2048 + k * 1024); } while (0)
#define PG8_MMA(ai, bj, At, Bt) do { __builtin_amdgcn_s_setprio(1); _Pragma("unroll") for (int m = 0; m < 4; ++m) _Pragma("unroll") for (int n = 0; n < 2; ++n) _Pragma("unroll") for (int k = 0; k < 2; ++k) \
    acc[ai][bj][m][n] = __builtin_amdgcn_mfma_f32_16x16x32_bf16(Bt[n][k], At[m][k], acc[ai][bj][m][n], 0, 0, 0); __builtin_amdgcn_s_setprio(0); } while (0)
#define PG8_WAIT_V(n) asm volatile("s_waitcnt vmcnt(" #n ")" ::: "memory")
#define PG8_WAIT_L(n) asm volatile("s_waitcnt lgkmcnt(" #n ")" ::: "memory")
#define PG8_BAR __builtin_amdgcn_s_barrier()
#define PG8_SCHED __builtin_amdgcn_sched_barrier(0)
  Unit cur, nxt; int ui = 0;
  if (!S.next(0, cur)) return;
  f32x4 acc[2][2][4][2];
#pragma unroll
  for (int a = 0; a < 2; ++a)
#pragma unroll
    for (int b = 0; b < 2; ++b)
#pragma unroll
      for (int m = 0; m < 4; ++m)
#pragma unroll
        for (int n = 0; n < 2; ++n) acc[a][b][m][n] = (f32x4){0.f, 0.f, 0.f, 0.f};
  bf16x8 At[4][2], B0[2][2], B1[2][2];
  const char* cA = (const char*)g.A + (size_t)cur.pm * tstep + (size_t)cur.ko * 2; const char* cB = (const char*)g.Bt + (size_t)cur.pn * tstep + (size_t)cur.ko * 2;
#if GEMM_SP2
  PG8_STAGE(PG8_SB(0, 0), cB, voffB); PG8_STAGE(PG8_SB(0, 1), cB + hstep, voffB); PG8_STAGE(PG8_SA(0, 0), cA, voffA); PG8_STAGE(PG8_SA(0, 1), cA + hstep, voffA);
  if (wr == 1) PG8_BAR;
  PG8_WAIT_V(2); PG8_BAR;
  PG8_STAGE(PG8_SB(1, 0), cB + kstep, voffB); PG8_STAGE(PG8_SA(1, 0), cA + kstep, voffA); PG8_STAGE(PG8_SB(1, 1), cB + hstep + kstep, voffB);
  PG8_WAIT_V(6); PG8_BAR;
#else
  PG8_STAGE(PG8_SB(0, 0), cB, voffB); PG8_STAGE(PG8_SA(0, 0), cA, voffA); PG8_STAGE(PG8_SB(0, 1), cB + hstep, voffB); PG8_STAGE(PG8_SA(0, 1), cA + hstep, voffA);
  if (wr == 1) PG8_BAR;
  PG8_WAIT_V(4); PG8_BAR;
  PG8_STAGE(PG8_SB(1, 0), cB + kstep, voffB); PG8_STAGE(PG8_SA(1, 0), cA + kstep, voffA); PG8_STAGE(PG8_SB(1, 1), cB + hstep + kstep, voffB);
  PG8_WAIT_V(6); PG8_BAR;
#endif
  for (;;) {
    const bool has_next = S.next(ui + 1, nxt);
    const char* nA = has_next ? (const char*)g.A + (size_t)nxt.pm * tstep + (size_t)nxt.ko * 2 : cA; const char* nB = has_next ? (const char*)g.Bt + (size_t)nxt.pn * tstep + (size_t)nxt.ko * 2 : cB;
    for (int t = 0; t < nt; t += 2) {
      const bool last = (t == nt - 2);
      const char* a1 = cA + (size_t)(t + 1) * kstep;
      const char* a2 = last ? nA : cA + (size_t)(t + 2) * kstep; const char* b2 = last ? nB : cB + (size_t)(t + 2) * kstep;
      const char* a3 = a2 + kstep; const char* b3 = b2 + kstep;
#if GEMM_SP2
      PG8_LDB(B0, 0, 0); PG8_LDB(B1, 0, 1); PG8_SCHED; PG8_LDA(At, 0, 0); PG8_STAGE(PG8_SA(1, 1), a1 + hstep, voffA);
      PG8_WAIT_V(8); PG8_WAIT_L(0); PG8_BAR; PG8_MMA(0, 0, At, B0); PG8_MMA(0, 1, At, B1); PG8_BAR; PG8_SCHED;
      PG8_LDA(At, 0, 1); PG8_STAGE(PG8_SB(0, 0), b2, voffB); PG8_STAGE(PG8_SB(0, 1), b2 + hstep, voffB); PG8_STAGE(PG8_SA(0, 0), a2, voffA);
      PG8_WAIT_V(8); PG8_WAIT_L(0); PG8_BAR; PG8_MMA(1, 0, At, B0); PG8_MMA(1, 1, At, B1); PG8_BAR; PG8_SCHED;
      PG8_LDB(B0, 1, 0); PG8_LDB(B1, 1, 1); PG8_SCHED; PG8_LDA(At, 1, 0); PG8_STAGE(PG8_SA(0, 1), a2 + hstep, voffA);
      PG8_WAIT_V(8); PG8_WAIT_L(0); PG8_BAR; PG8_MMA(0, 0, At, B0); PG8_MMA(0, 1, At, B1); PG8_BAR; PG8_SCHED;
      PG8_LDA(At, 1, 1); PG8_STAGE(PG8_SB(1, 0), b3, voffB); PG8_STAGE(PG8_SB(1, 1), b3 + hstep, voffB); PG8_STAGE(PG8_SA(1, 0), a3, voffA);
      PG8_WAIT_V(8); PG8_WAIT_L(0); PG8_BAR; PG8_MMA(1, 0, At, B0); PG8_MMA(1, 1, At, B1); PG8_BAR; PG8_SCHED;
#else
      PG8_LDB(B0, 0, 0); PG8_SCHED; PG8_LDA(At, 0, 0); PG8_STAGE(PG8_SA(1, 1), a1 + hstep, voffA);
      PG8_WAIT_L(8); PG8_BAR; PG8_WAIT_L(0); PG8_MMA(0, 0, At, B0); PG8_BAR; PG8_SCHED;
      PG8_LDB(B1, 0, 1); PG8_STAGE(PG8_SB(0, 0), b2, voffB);
      PG8_BAR; PG8_WAIT_L(0); PG8_MMA(0, 1, At, B1); PG8_BAR;
      PG8_LDA(At, 0, 1); PG8_STAGE(PG8_SA(0, 0), a2, voffA);
      PG8_BAR; PG8_WAIT_L(0); PG8_MMA(1, 0, At, B0); PG8_BAR; PG8_SCHED;
      PG8_STAGE(PG8_SB(0, 1), b2 + hstep, voffB);
      PG8_WAIT_V(6); PG8_BAR; PG8_MMA(1, 1, At, B1); PG8_BAR;
      PG8_LDB(B0, 1, 0); PG8_SCHED; PG8_LDA(At, 1, 0); PG8_STAGE(PG8_SA(0, 1), a2 + hstep, voffA);
      PG8_WAIT_L(8); PG8_BAR; PG8_WAIT_L(0); PG8_MMA(0, 0, At, B0); PG8_BAR; PG8_SCHED;
      PG8_LDB(B1, 1, 1); PG8_STAGE(PG8_SB(1, 0), b3, voffB);
      PG8_BAR; PG8_WAIT_L(0); PG8_MMA(0, 1, At, B1); PG8_BAR;
      PG8_LDA(At, 1, 1); PG8_STAGE(PG8_SA(1, 0), a3, voffA);
      PG8_BAR; PG8_WAIT_L(0); PG8_MMA(1, 0, At, B0); PG8_BAR; PG8_SCHED;
      PG8_STAGE(PG8_SB(1, 1), b3 + hstep, voffB);
      PG8_WAIT_V(6); PG8_BAR; PG8_MMA(1, 1, At, B1); PG8_BAR;
#endif
    }
#if GEMM_ALIGN
    if (wr == 0) PG8_BAR;
#endif
    E(acc, cur, wr, wc, fr, fq);
    if (!has_next) break;
#pragma unroll
    for (int a = 0; a < 2; ++a)
#pragma unroll
      for (int b = 0; b < 2; ++b)
#pragma unroll
        for (int m = 0; m < 4; ++m)
#pragma unroll
          for (int n = 0; n < 2; ++n) acc[a][b][m][n] = (f32x4){0.f, 0.f, 0.f, 0.f};
    cur = nxt; cA = nA; cB = nB; ++ui;
#if GEMM_ALIGN
    if (wr == 1) PG8_BAR;
#endif
  }
  PG8_WAIT_V(0);
#if !GEMM_ALIGN
  if (wr == 0) PG8_BAR;
#endif
  PG8_BAR;
#undef PG8_SA
#undef PG8_SB
#undef PG8_STAGE
#undef PG8_LDA
#undef PG8_LDB
#undef PG8_MMA
#undef PG8_WAIT_V
#undef PG8_WAIT_L
#undef PG8_BAR
#undef PG8_SCHED
}
}

typedef const f32x4 (&AccRef)[2][2][4][2];
__device__ __forceinline__ u32x4 pack8(f32x4 v0, f32x4 v1) { u32x4 w; w.x = cvt_pk_bf16(v0[0], v0[1]); w.y = cvt_pk_bf16(v0[2], v0[3]); w.z = cvt_pk_bf16(v1[0], v1[1]); w.w = cvt_pk_bf16(v1[2], v1[3]); return w; }

struct EpiZ {
  static constexpr bool PERM = true;
  bf16_t* Z; bf16_t* ZTC;
  __device__ __forceinline__ void operator()(AccRef acc, const pg8::Unit& u, int wr, int wc, int fr, int fq) const {
#pragma unroll
    for (int ai = 0; ai < 2; ++ai)
#pragma unroll
      for (int m = 0; m < 4; ++m) {
        const int row = u.pm * 256 + ai * 128 + wr * 64 + m * 16 + fr;
        if (row < NLAT) {
          bf16_t* dst = Z + (size_t)row * 1024 + u.pn * 256 + wc * 32 + fq * 8;
#pragma unroll
          for (int bj = 0; bj < 2; ++bj) *(u32x4*)(dst + bj * 128) = pack8(acc[ai][bj][m][0], acc[ai][bj][m][1]);
        } else {
          const int rr = row - NLAT; bf16_t* base = ZTC + (size_t)(rr >> 8) * 512 * 512 + (rr & 255);
#pragma unroll
          for (int bj = 0; bj < 2; ++bj)
#pragma unroll
            for (int n = 0; n < 2; ++n)
#pragma unroll
              for (int j = 0; j < 4; ++j) { const int col = u.pn * 256 + bj * 128 + wc * 32 + fq * 8 + n * 4 + j;
                base[(size_t)(col & 511) * 512 + (col >> 9) * 256] = f2bf(acc[ai][bj][m][n][j]); }
        }
      }
  }
};
struct EpiHG {
  static constexpr bool PERM = true;
  bf16_t *Q, *V, *G; _Float16 *LF0, *LF1; const float* LB;
  __device__ __forceinline__ void operator()(AccRef acc, const pg8::Unit& u, int wr, int wc, int fr, int fq) const {
    const int region = u.pn >> 1;
#pragma unroll
    for (int bj = 0; bj < 2; ++bj) {
      const int cl = (u.pn & 1) * 256 + bj * 128 + wc * 32 + fq * 8;
      float lb[8];
      if (region == 1 || region == 2) {
        const f32x4 a = *(const f32x4*)(LB + (region - 1) * 512 + cl), b = *(const f32x4*)(LB + (region - 1) * 512 + cl + 4);
        lb[0] = a[0]; lb[1] = a[1]; lb[2] = a[2]; lb[3] = a[3]; lb[4] = b[0]; lb[5] = b[1]; lb[6] = b[2]; lb[7] = b[3];
      } else {
#pragma unroll
        for (int j = 0; j < 8; ++j) lb[j] = 0.f;
      }
#pragma unroll
      for (int ai = 0; ai < 2; ++ai)
#pragma unroll
        for (int m = 0; m < 4; ++m) {
          const size_t off = (size_t)(u.pm * 256 + ai * 128 + wr * 64 + m * 16 + fr) * 512 + cl;
          f32x4 v0 = acc[ai][bj][m][0], v1 = acc[ai][bj][m][1];
          if (region == 0) {
#pragma unroll
            for (int j = 0; j < 4; ++j) { v0[j] = silu_f(v0[j]); v1[j] = silu_f(v1[j]); }
            *(u32x4*)(Q + off) = pack8(v0, v1);
          } else if (region == 1 || region == 2) {
            h16x8 hv;
#pragma unroll
            for (int j = 0; j < 4; ++j) {
              const float f0 = lb[j] + (1.f - lb[j]) * __builtin_amdgcn_rcpf(1.f + __expf(-v0[j])), f1 = lb[4 + j] + (1.f - lb[4 + j]) * __builtin_amdgcn_rcpf(1.f + __expf(-v1[j]));
              hv[j] = (_Float16)__logf(fmaxf(f0, 1e-30f)); hv[4 + j] = (_Float16)__logf(fmaxf(f1, 1e-30f));
            }
            *(h16x8*)((region == 1 ? LF0 : LF1) + off) = hv;
          } else if (region == 3) { *(u32x4*)(V + off) = pack8(v0, v1); }
          else { *(u32x4*)(G + off) = pack8(v0, v1); }
        }
    }
  }
};
struct EpiAB {
  static constexpr bool PERM = true;
  EpiZ z; EpiHG hg;
  __device__ __forceinline__ void operator()(AccRef acc, const pg8::Unit& u, int wr, int wc, int fr, int fq) const {
    if (u.pn < 4) z(acc, u, wr, wc, fr, fq);
    else { pg8::Unit v = u; v.pn = u.pn - 4; hg(acc, v, wr, wc, fr, fq); }
  }
};
struct EpiQKV {
  static constexpr bool PERM = true;
  bf16_t *QB, *KB, *VB;
  __device__ __forceinline__ void operator()(AccRef acc, const pg8::Unit& u, int wr, int wc, int fr, int fq) const {
#pragma unroll
    for (int ai = 0; ai < 2; ++ai)
#pragma unroll
      for (int m = 0; m < 4; ++m) {
        const int row = u.pm * 256 + ai * 128 + wr * 64 + m * 16 + fr;
        bf16_t* dst;
        if (u.pn < 4) dst = QB + (size_t)row * 1024 + u.pn * 256;
        else dst = (u.pn == 4 ? KB : VB) + (size_t)kvrow(row) * 256;
#pragma unroll
        for (int bj = 0; bj < 2; ++bj) *(u32x4*)(dst + bj * 128 + wc * 32 + fq * 8) = pack8(acc[ai][bj][m][0], acc[ai][bj][m][1]);
      }
  }
};
struct EpiRes {
  static constexpr bool PERM = false;
  float* X; float* CX; const float* gate; const float* Xsrc;
  __device__ __forceinline__ void operator()(AccRef acc, const pg8::Unit& u, int wr, int wc, int fr, int fq) const {
    const int row0 = u.pm * 256;
    const int mr = row0 < NLAT ? (row0 >> 12) : 8;
    const int colb = u.pn * 256 + wc * 32 + fq * 4;
    f32x4 gv[2][2];
#pragma unroll
    for (int bj = 0; bj < 2; ++bj)
#pragma unroll
      for (int n = 0; n < 2; ++n) gv[bj][n] = *(const f32x4*)(gate + (size_t)mr * 6144 + colb + bj * 128 + n * 16);
#pragma unroll
    for (int ai = 0; ai < 2; ++ai)
#pragma unroll
      for (int m = 0; m < 4; ++m) {
        const int row = row0 + ai * 128 + wr * 64 + m * 16 + fr;
        float* dst = (row < NLAT ? X + (size_t)row * 1024 : CX + (size_t)(row - NLAT) * 1024) + colb;
        const float* srcp = (row < NLAT ? Xsrc + (size_t)row * 1024 : CX + (size_t)(row - NLAT) * 1024) + colb;
#pragma unroll
        for (int bj = 0; bj < 2; ++bj)
#pragma unroll
          for (int n = 0; n < 2; ++n) { f32x4 xv = *(const f32x4*)(srcp + bj * 128 + n * 16); xv += gv[bj][n] * acc[ai][bj][m][n]; *(f32x4*)(dst + bj * 128 + n * 16) = xv; }
      }
  }
};
struct EpiPart {
  static constexpr bool PERM = false;
  float* PART; int ksub;
  __device__ __forceinline__ void operator()(AccRef acc, const pg8::Unit& u, int wr, int wc, int fr, int fq) const {
    float* base = PART + (size_t)(u.ko / ksub) * NCTX * 1024 + u.pn * 256 + wc * 32 + fq * 4;
#pragma unroll
    for (int ai = 0; ai < 2; ++ai)
#pragma unroll
      for (int m = 0; m < 4; ++m) {
        float* dst = base + (size_t)(u.pm * 256 + ai * 128 + wr * 64 + m * 16 + fr) * 1024;
#pragma unroll
        for (int bj = 0; bj < 2; ++bj)
#pragma unroll
          for (int n = 0; n < 2; ++n) *(f32x4*)(dst + bj * 128 + n * 16) = acc[ai][bj][m][n];
      }
  }
};
struct EpiUp {
  static constexpr bool PERM = true;
  bf16_t *GATE, *VAL;
  __device__ __forceinline__ void operator()(AccRef acc, const pg8::Unit& u, int wr, int wc, int fr, int fq) const {
    bf16_t* base = (u.pn < 11 ? GATE + u.pn * 256 : VAL + (u.pn - 11) * 256) + wc * 32 + fq * 8;
#pragma unroll
    for (int ai = 0; ai < 2; ++ai)
#pragma unroll
      for (int m = 0; m < 4; ++m) {
        bf16_t* dst = base + (size_t)(u.pm * 256 + ai * 128 + wr * 64 + m * 16 + fr) * 2816;
#pragma unroll
        for (int bj = 0; bj < 2; ++bj) *(u32x4*)(dst + bj * 128) = pack8(acc[ai][bj][m][0], acc[ai][bj][m][1]);
      }
  }
};
struct EpiDFT {
  static constexpr bool PERM = true;
  bf16_t* MIX; int ctxmode;
  __device__ __forceinline__ void operator()(AccRef acc, const pg8::Unit& u, int wr, int wc, int fr, int fq) const {
    const int b = u.pn >> 1;
    const int tok0 = ctxmode ? NLAT + b * 256 : b * 4096 + u.pm * 256;
    bf16_t* base = MIX + (u.pn & 1) * 256 + wc * 32 + fq * 8;
#pragma unroll
    for (int ai = 0; ai < 2; ++ai)
#pragma unroll
      for (int m = 0; m < 4; ++m) {
        bf16_t* dst = base + (size_t)(tok0 + ai * 128 + wr * 64 + m * 16 + fr) * 1024;
#pragma unroll
        for (int bj = 0; bj < 2; ++bj) *(u32x4*)(dst + bj * 128) = pack8(acc[ai][bj][m][0], acc[ai][bj][m][1]);
      }
  }
};
template <class Epi> __device__ __forceinline__ void run_gemm(unsigned char* lds, const bf16_t* A, const bf16_t* Bt, int M, int N, int K, const Epi& E) {
  pg8::Gemm g{A, Bt, M, N, K, K}; pg8::StaticOrder S; S.init(M, N, (int)gridDim.x, bid_());
  pg8::gemm_phase<Epi, pg8::StaticOrder>((PG8_LAS unsigned char*)lds, g, S, E);
}
template <class Epi> __device__ __forceinline__ void run_gemm_splitk(unsigned char* lds, const bf16_t* A, const bf16_t* Bt, int M, int N, int K, int ns, const Epi& E) {
  pg8::Gemm g{A, Bt, M, N, K / ns, K}; pg8::SplitKOrder S; S.init(M, N, ns, K / ns, (int)gridDim.x, bid_());
  pg8::gemm_phase<Epi, pg8::SplitKOrder>((PG8_LAS unsigned char*)lds, g, S, E);
}

namespace att {
constexpr int D = 128, NW = 8, QBLK = 32, KVBLK = 64;
constexpr float SCALE = 0.088388347648318440f;
constexpr float THR = 8.f;
constexpr int LDQ = 1024, LDK = 256, LDO = 1024;
constexpr size_t SHM_V = KVBLK * D * 2, SHM_K = KVBLK * D * 2;
#define KSWZ(row, colB) ((row) * 256 + ((colB) ^ (((row) & 7) << 4)))
#define SBAR() __builtin_amdgcn_sched_barrier(0)
__device__ __forceinline__ int crow(int r, int hi) { return (r & 3) + 8 * (r >> 2) + 4 * hi; }
__device__ __forceinline__ unsigned cvtpk(float lo, float hi) { return cvt_pk_bf16(lo, hi); }
__device__ __forceinline__ void partialSM(f32x16& p0, f32x16& p1, float& m_reg, float& mn, float& alpha) {
  constexpr float C = SCALE * 1.4426950408889634f;
  float pmax = p0[0]; _Pragma("unroll") for (int r = 1; r < 16; ++r) pmax = fmaxf(pmax, p0[r]); _Pragma("unroll") for (int r = 0; r < 16; ++r) pmax = fmaxf(pmax, p1[r]);
  { auto rr = __builtin_amdgcn_permlane32_swap(__float_as_uint(pmax), __float_as_uint(pmax), false, false);
    pmax = fmaxf(__uint_as_float(rr[0]), __uint_as_float(rr[1])); }
  if (__builtin_expect(__all(pmax - m_reg <= THR / SCALE), 1)) { mn = m_reg; alpha = 1.f; }
  else { mn = fmaxf(m_reg, pmax); alpha = __builtin_amdgcn_exp2f((m_reg - mn) * C); m_reg = mn; }
  float mnC = -mn * C;
  _Pragma("unroll") for (int r = 0; r < 16; ++r) p0[r] = fmaf(p0[r], C, mnC); _Pragma("unroll") for (int r = 0; r < 16; ++r) p1[r] = fmaf(p1[r], C, mnC);
  _Pragma("unroll") for (int r = 0; r < 16; ++r) p0[r] = __builtin_amdgcn_exp2f(p0[r]);
}
__device__ __forceinline__ void finishSM(f32x16& p0, f32x16& p1, float alpha, float& l_reg, bf16x8& pa0, bf16x8& pa1, bf16x8& pa2, bf16x8& pa3) {
  _Pragma("unroll") for (int r = 0; r < 16; ++r) p1[r] = __builtin_amdgcn_exp2f(p1[r]);
  float ps = 0; _Pragma("unroll") for (int r = 0; r < 16; ++r) ps += p0[r]; _Pragma("unroll") for (int r = 0; r < 16; ++r) ps += p1[r];
  { auto rr = __builtin_amdgcn_permlane32_swap(__float_as_uint(ps), __float_as_uint(ps), false, false);
    ps = __uint_as_float(rr[0]) + __uint_as_float(rr[1]); }
  l_reg = l_reg * alpha + ps;
#define PK4(Pv, BASE, OUT) do { unsigned a0 = cvtpk(Pv[BASE + 0], Pv[BASE + 1]), a1 = cvtpk(Pv[BASE + 2], Pv[BASE + 3]);   \
    unsigned b0 = cvtpk(Pv[BASE + 4], Pv[BASE + 5]), b1 = cvtpk(Pv[BASE + 6], Pv[BASE + 7]);                              \
    auto r0 = __builtin_amdgcn_permlane32_swap(a0, b0, false, false); auto r1 = __builtin_amdgcn_permlane32_swap(a1, b1, false, false); \
    u32x4 w = {r0[0], r1[0], r0[1], r1[1]}; OUT = *reinterpret_cast<bf16x8*>(&w); } while (0)
  PK4(p0, 0, pa0); PK4(p0, 8, pa1); PK4(p1, 0, pa2); PK4(p1, 8, pa3);
#undef PK4
}
__device__ __forceinline__ void qkt(f32x16& p0, f32x16& p1, const bf16_t* Ks, const bf16x8* qr, int r32, int hi) {
  p0 = f32x16{}; p1 = f32x16{};
  _Pragma("unroll") for (int d0 = 0; d0 < 8; ++d0) { int cb = (d0 * 16 + hi * 8) * 2;
    bf16x8 b0 = *reinterpret_cast<const bf16x8*>((const char*)Ks + KSWZ(r32, cb));
    bf16x8 b1 = *reinterpret_cast<const bf16x8*>((const char*)Ks + KSWZ(32 + r32, cb));
    p0 = __builtin_amdgcn_mfma_f32_32x32x16_bf16(b0, qr[d0], p0, 0, 0, 0);
    p1 = __builtin_amdgcn_mfma_f32_32x32x16_bf16(b1, qr[d0], p1, 0, 0, 0); }
}
__device__ __forceinline__ int v_st(int k, int c) { const int kk = (k & ~0xC) | ((k & 4) << 1) | ((k & 8) >> 1); return ((kk >> 3) * 4 + (c >> 5)) * 512 + ((kk & 7) * 32 + (c & 31)) * 2; }
__device__ __forceinline__ int v_rd_base(int lane) { return ((lane & 3) << 3) | (((lane >> 2) & 3) << 6) | (((lane >> 4) & 1) << 5) | (((lane >> 5) & 1) << 8); }
constexpr int v_rd_off(int d0, int ks, int half) { return d0 * 512 + ks * 4096 + half * 2048; }
template <int OFF> __device__ __forceinline__ s16x4 tr_read(int vb) {
  s16x4 r; asm volatile("ds_read_b64_tr_b16 %0, %1 offset:%2" : "=&v"(r) : "v"(vb), "i"(OFF) : "memory"); return r;
}
template <int D0> __device__ __forceinline__ void pv_one(f32x16& od, int vb, bf16x8 pa0, bf16x8 pa1, bf16x8 pa2, bf16x8 pa3) {
  const s16x4 l0 = tr_read<v_rd_off(D0, 0, 0)>(vb), h0 = tr_read<v_rd_off(D0, 0, 1)>(vb), l1 = tr_read<v_rd_off(D0, 1, 0)>(vb), h1 = tr_read<v_rd_off(D0, 1, 1)>(vb);
  const s16x4 l2 = tr_read<v_rd_off(D0, 2, 0)>(vb), h2 = tr_read<v_rd_off(D0, 2, 1)>(vb), l3 = tr_read<v_rd_off(D0, 3, 0)>(vb), h3 = tr_read<v_rd_off(D0, 3, 1)>(vb);
  asm volatile("s_waitcnt lgkmcnt(0)" ::: "memory"); SBAR();
#define PK(L, H) (bf16x8){L[0], L[1], L[2], L[3], H[0], H[1], H[2], H[3]}
  od = __builtin_amdgcn_mfma_f32_32x32x16_bf16(pa0, PK(l0, h0), od, 0, 0, 0);
  od = __builtin_amdgcn_mfma_f32_32x32x16_bf16(pa1, PK(l1, h1), od, 0, 0, 0);
  od = __builtin_amdgcn_mfma_f32_32x32x16_bf16(pa2, PK(l2, h2), od, 0, 0, 0);
  od = __builtin_amdgcn_mfma_f32_32x32x16_bf16(pa3, PK(l3, h3), od, 0, 0, 0);
#undef PK
}
__device__ __forceinline__ void pv_d0(f32x16* o, int vb, bf16x8 pa0, bf16x8 pa1, bf16x8 pa2, bf16x8 pa3) {
  pv_one<0>(o[0], vb, pa0, pa1, pa2, pa3); pv_one<1>(o[1], vb, pa0, pa1, pa2, pa3); pv_one<2>(o[2], vb, pa0, pa1, pa2, pa3); pv_one<3>(o[3], vb, pa0, pa1, pa2, pa3);
}
__device__ __forceinline__ void attn_dense_body(const bf16_t* __restrict__ Qb, const bf16_t* __restrict__ Kh, const bf16_t* __restrict__ Vh,
                                                bf16_t* __restrict__ Ob, int seq, char* lds) {
  const int tid = tid_(), wid = tid >> 6, lane = tid & 63, r32 = lane & 31, hi = lane >> 5;
  bf16_t* V_lds = (bf16_t*)lds; bf16_t* K_lds = (bf16_t*)(lds + 2 * SHM_V);
  float* ws = (float*)(lds + 2 * SHM_V + 2 * SHM_K) + wid * 64; float* li_l = ws; float* al_l = ws + 32;
  float m_reg = -1e30f, l_reg = 0; f32x16 o[4] = {}; bf16x8 qr[8];
  const bf16_t* Qw = Qb + (long)(wid * QBLK + r32) * LDQ + hi * 8;
_Pragma("unroll") for (int d0 = 0; d0 < 8; ++d0) qr[d0] = *reinterpret_cast<const bf16x8*>(Qw + d0 * 16);
  const int sr = tid >> 4, sc = (tid & 15) * 8, vst0 = v_st(sr, sc), vst1 = v_st(32 + sr, sc);
  const int vb0 = (int)(uintptr_t)V_lds + v_rd_base(lane);
  struct { bf16x8 vs0, vs1, ks0, ks1; } sr_[2];
#define SLOAD(i, k0) do { sr_[i].vs0 = *(const bf16x8*)(&Vh[(long)((k0) + sr) * LDK + sc]); sr_[i].vs1 = *(const bf16x8*)(&Vh[(long)((k0) + 32 + sr) * LDK + sc]); \
    sr_[i].ks0 = *(const bf16x8*)(&Kh[(long)((k0) + sr) * LDK + sc]); sr_[i].ks1 = *(const bf16x8*)(&Kh[(long)((k0) + 32 + sr) * LDK + sc]); } while (0)
#define SWRITE(b, i) do { *(bf16x8*)((char*)V_lds + (b) * SHM_V + vst0) = sr_[i].vs0;          \
    *(bf16x8*)((char*)V_lds + (b) * SHM_V + vst1) = sr_[i].vs1; int kc = sc * 2;               \
    *(bf16x8*)((char*)K_lds + (b) * SHM_K + KSWZ(sr, kc)) = sr_[i].ks0;                       \
    *(bf16x8*)((char*)K_lds + (b) * SHM_K + KSWZ(32 + sr, kc)) = sr_[i].ks1; } while (0)
#define SWAIT() asm volatile("s_waitcnt vmcnt(4)" ::: "memory")
#define RESC(a) do { if (__any((a) < 1.f)) { if (hi == 0) al_l[r32] = (a); asm volatile("s_waitcnt lgkmcnt(0)" ::: "memory"); \
    _Pragma("unroll") for (int d = 0; d < 4; ++d) _Pragma("unroll") for (int r = 0; r < 16; ++r) o[d][r] *= al_l[crow(r, hi)]; } } while (0)
  f32x16 pA0, pA1, pB0, pB1; float mnA, mnB, alA, alB; bf16x8 pa0, pa1, pa2, pa3; const int NT = seq / KVBLK;
  constexpr int SE = 0, SO = 1;
  SLOAD(SE, 0); asm volatile("s_waitcnt vmcnt(0)" ::: "memory"); SWRITE(0, SE); __syncthreads();
  qkt(pA0, pA1, K_lds, qr, r32, hi); partialSM(pA0, pA1, m_reg, mnA, alA);
  SLOAD(SO, KVBLK); if (2 < NT) SLOAD(SE, 2 * KVBLK);
  SWAIT(); SWRITE(1, SO); __syncthreads();
  for (int j = 1; j + 1 < NT; j += 2) {
    SBAR(); qkt(pB0, pB1, (bf16_t*)((char*)K_lds + SHM_K), qr, r32, hi);
    finishSM(pA0, pA1, alA, l_reg, pa0, pa1, pa2, pa3); SBAR();
    SLOAD(SO, (j + 2) * KVBLK); SBAR();
    pv_d0(o, vb0, pa0, pa1, pa2, pa3); partialSM(pB0, pB1, m_reg, mnB, alB);
    __syncthreads(); SWAIT(); SWRITE(0, SE);
    RESC(alB); __syncthreads();
    SBAR(); qkt(pA0, pA1, K_lds, qr, r32, hi);
    finishSM(pB0, pB1, alB, l_reg, pa0, pa1, pa2, pa3); SBAR();
    if (j + 3 < NT) SLOAD(SE, (j + 3) * KVBLK); SBAR();
    pv_d0(o, vb0 + (int)SHM_V, pa0, pa1, pa2, pa3); partialSM(pA0, pA1, m_reg, mnA, alA);
    __syncthreads(); SWAIT(); SWRITE(1, SO);
    RESC(alA); __syncthreads();
  }
  SBAR(); qkt(pB0, pB1, (bf16_t*)((char*)K_lds + SHM_K), qr, r32, hi);
  finishSM(pA0, pA1, alA, l_reg, pa0, pa1, pa2, pa3); SBAR();
  pv_d0(o, vb0, pa0, pa1, pa2, pa3); partialSM(pB0, pB1, m_reg, mnB, alB);
  __syncthreads(); RESC(alB);
  finishSM(pB0, pB1, alB, l_reg, pa0, pa1, pa2, pa3); SBAR();
  pv_d0(o, vb0 + (int)SHM_V, pa0, pa1, pa2, pa3);
  if (hi == 0) li_l[r32] = l_reg; asm volatile("s_waitcnt lgkmcnt(0)" ::: "memory");
  float rli[16];
_Pragma("unroll") for (int r = 0; r < 16; ++r) rli[r] = __builtin_amdgcn_rcpf(li_l[crow(r, hi)]);
  bf16_t* Ow = Ob + (long)(wid * QBLK) * LDO;
_Pragma("unroll") for (int r = 0; r < 16; ++r) { int orow = crow(r, hi);
    _Pragma("unroll") for (int d0 = 0; d0 < 4; ++d0) Ow[(long)orow * LDO + d0 * 32 + r32] = f2bf(o[d0][r] * rli[r]); }
#undef SLOAD
#undef SWRITE
#undef SWAIT
#undef RESC
}
}

__device__ __forceinline__ void mod_gemv(const P& p, unsigned char* lds, int l_lo, int l_hi, int wg, int nwg) {
  const int tid = tid_();
  float* MOD = (float*)(p.ws + OFF_MOD);
  float* sc = (float*)lds;
  float* red = sc + 9 * 1024;
  for (int i = tid; i < 9 * 1024; i += 512) { const int r = i >> 10, k = i & 1023; const float v = r < 8 ? p.c[r * 1024 + k] : p.c_ctx[k]; sc[i] = v / (1.f + expf(-v)); }
  __syncthreads();
  const int ng = tid & 31, kg = tid >> 5;
  for (int it = wg < 0 ? l_hi * 48 : l_lo * 48 + wg; it < l_hi * 48; it += nwg) {
    const int l = it / 48, nb = (it % 48) * 128;
    const float* w = p.w_mod + ((size_t)l * 1024 + kg * 64) * 6144 + nb + ng * 4;
    float acc[9][4];
#pragma unroll
    for (int r = 0; r < 9; ++r) { acc[r][0] = 0.f; acc[r][1] = 0.f; acc[r][2] = 0.f; acc[r][3] = 0.f; }
#pragma unroll 4
    for (int k = 0; k < 64; ++k) {
      const f32x4 wv = *(const f32x4*)(w + (size_t)k * 6144);
#pragma unroll
      for (int r = 0; r < 9; ++r) { const float s = sc[r * 1024 + kg * 64 + k]; acc[r][0] += s * wv[0]; acc[r][1] += s * wv[1]; acc[r][2] += s * wv[2]; acc[r][3] += s * wv[3]; }
    }
#pragma unroll
    for (int r = 0; r < 9; ++r) { float* d = red + (kg * 9 + r) * 128 + ng * 4; d[0] = acc[r][0]; d[1] = acc[r][1]; d[2] = acc[r][2]; d[3] = acc[r][3]; }
    __syncthreads();
    for (int o = tid; o < 9 * 128; o += 512) { const int r = o >> 7, n = o & 127; float s = 0.f;
      for (int g = 0; g < 16; ++g) s += red[(g * 9 + r) * 128 + n];
      MOD[(size_t)(l * 9 + r) * 6144 + nb + n] = s + p.b_mod[l * 6144 + nb + n]; }
    __syncthreads();
  }
}
__device__ __forceinline__ void ph0(const P& p, unsigned char* lds) {
  mod_gemv(p, lds, 0, 1, bid_(), (int)gridDim.x);
  const int tid = tid_();
  const int gtid = bid_() * 512 + tid, gsz = gridDim.x * 512;
  float* LB = (float*)(p.ws + OFF_LB);
  for (int i = gtid; i < 1024; i += gsz) { const float a0 = p.hg_lb[i], a1 = p.hg_lb[1024 + i]; LB[i] = 0.f; LB[1024 + i] = 1.f / (1.f + expf(a0 - a1)); }
  { float* ROPE = (float*)(p.ws + OFF_ROPE);
    for (int i = gtid; i < 64 * 32; i += gsz) { const int pos = i >> 5, j = i & 31; const float fr = exp2f(-(float)j * (13.287712379549449f / 32.f)); float sn, cs; sincosf((float)pos * fr, &sn, &cs); ROPE[2 * i] = cs; ROPE[2 * i + 1] = sn; } }
  bf16_t* CM256 = (bf16_t*)(p.ws + OFF_CM256);
  for (int i = gtid; i < 256 * 256; i += gsz) { const int k = i >> 8, j = i & 255; float s, c; sincospif((float)((k * j) & 255) * (1.f / 128.f), &s, &c);
    CM256[k * 512 + j] = f2bf(c * 0.0625f); CM256[k * 512 + 256 + j] = f2bf(-s * 0.0625f); }
}

__device__ __forceinline__ void modulate_rows(const P& p, int l, int which, int nrows, bool first, const float* fixP, const float* fixG) {
  const int tid = tid_(), wave = tid >> 6, lane = tid & 63;
  const GA float* MOD = (const GA float*)(p.ws + OFF_MOD);
  GA float* CX = (GA float*)(p.ws + OFF_CTXR);
  GA bf16_t* HB = (GA bf16_t*)(p.ws + OFF_HB);
  for (int row0 = bid_() * 16 + wave; row0 < nrows; row0 += gridDim.x * 16) {
    const bool lat = row0 < NLAT;
    const GA float* src = (const GA float*)(first ? (lat ? p.x + (size_t)row0 * 1024 : p.ctx + (size_t)(row0 - NLAT) * 1024) : (lat ? p.out + (size_t)row0 * 1024 : (float*)CX + (size_t)(row0 - NLAT) * 1024));
    f32x4 v[2][4]; float ss0 = 0.f, ss1 = 0.f;
#pragma unroll
    for (int j = 0; j < 4; ++j) { v[0][j] = *(const GA f32x4*)(src + j * 256 + lane * 4); v[1][j] = *(const GA f32x4*)(src + 8 * 1024 + j * 256 + lane * 4); }
    if (!lat && fixP) {
      const GA float* P0 = (const GA float*)fixP + (size_t)(row0 - NLAT) * 1024; const GA float* G0 = (const GA float*)fixG; GA float* xw = CX + (size_t)(row0 - NLAT) * 1024;
#pragma unroll
      for (int j = 0; j < 4; ++j) { const int col = j * 256 + lane * 4; const f32x4 g4 = *(const GA f32x4*)(G0 + col);
        v[0][j] += g4 * (*(const GA f32x4*)(P0 + col) + *(const GA f32x4*)(P0 + (size_t)NCTX * 1024 + col));
        v[1][j] += g4 * (*(const GA f32x4*)(P0 + 8 * 1024 + col) + *(const GA f32x4*)(P0 + (size_t)NCTX * 1024 + 8 * 1024 + col));
        *(GA f32x4*)(xw + col) = v[0][j]; *(GA f32x4*)(xw + 8 * 1024 + col) = v[1][j]; }
    }
    const GA float* sh = MOD + (size_t)(l * 9 + (lat ? (row0 >> 12) : 8)) * 6144 + (which ? 3072 : 0);
    f32x4 s4[4], c4[4];
#pragma unroll
    for (int j = 0; j < 4; ++j) { s4[j] = *(const GA f32x4*)(sh + j * 256 + lane * 4); c4[j] = *(const GA f32x4*)(sh + 1024 + j * 256 + lane * 4); }
#pragma unroll
    for (int j = 0; j < 4; ++j) { ss0 += v[0][j][0] * v[0][j][0] + v[0][j][1] * v[0][j][1] + v[0][j][2] * v[0][j][2] + v[0][j][3] * v[0][j][3];
      ss1 += v[1][j][0] * v[1][j][0] + v[1][j][1] * v[1][j][1] + v[1][j][2] * v[1][j][2] + v[1][j][3] * v[1][j][3]; }
    ss0 = wave_sum(ss0); ss1 = wave_sum(ss1);
    const float rs0 = rsqrtf(ss0 * (1.f / 1024.f) + EPS), rs1 = rsqrtf(ss1 * (1.f / 1024.f) + EPS);
    if (first && !lat) { GA float* dst = (GA float*)((float*)CX + (size_t)(row0 - NLAT) * 1024);
#pragma unroll
      for (int j = 0; j < 4; ++j) { *(GA f32x4*)(dst + j * 256 + lane * 4) = v[0][j]; *(GA f32x4*)(dst + 8 * 1024 + j * 256 + lane * 4) = v[1][j]; } }
#pragma unroll
    for (int j = 0; j < 4; ++j) { const int col = j * 256 + lane * 4;
      f32x4 h0, h1; for (int q = 0; q < 4; ++q) { h0[q] = v[0][j][q] * rs0 * (1.f + c4[j][q]) + s4[j][q]; h1[q] = v[1][j][q] * rs1 * (1.f + c4[j][q]) + s4[j][q]; }
      u32x2 w0, w1; w0.x = cvt_pk_bf16(h0[0], h0[1]); w0.y = cvt_pk_bf16(h0[2], h0[3]); w1.x = cvt_pk_bf16(h1[0], h1[1]); w1.y = cvt_pk_bf16(h1[2], h1[3]);
      *(GA u32x2*)(HB + (size_t)row0 * 1024 + col) = w0; *(GA u32x2*)(HB + (size_t)(row0 + 8) * 1024 + col) = w1; }
  }
}

__device__ __forceinline__ void convert_weights(const P& p, int l, unsigned char* lds, int wg, int nwg, int jlo = 0, int jhi = 4) {
  float* tile = (float*)lds;
  const int tid = tid_(), e = l >> 1; const bool even = !(l & 1);
  bf16_t* W1 = (bf16_t*)(p.ws + OFF_W1); bf16_t* W2 = (bf16_t*)(p.ws + OFF_W2); bf16_t* W3 = (bf16_t*)(p.ws + OFF_W3); bf16_t* W4 = (bf16_t*)(p.ws + ((l & 1) ? OFF_W4B : OFF_W4));
  if (wg < 0) return;
  int base = 0;
#pragma unroll 1
  for (int j = jlo; j < jhi; ++j) {
    const float* W; int K, N, ldw; bf16_t* Wt;
    if (j == 0) { if (even) { W = p.w_in_ab + (size_t)e * 1024 * 3072 + 512; K = 1024; N = 2560; ldw = 3072; Wt = W1 + 1024 * 1024; } else { W = p.w_qkv + (size_t)e * 1024 * 1536; K = 1024; N = 1536; ldw = 1536; Wt = W1; } }
    else if (j == 1) { W = (even ? p.w_out_ab : p.w_out_att) + (size_t)e * 1024 * 1024; K = 1024; N = 1024; ldw = 1024; Wt = W2; }
    else if (j == 2) { W = p.w_up + (size_t)l * 1024 * 5632; K = 1024; N = 5632; ldw = 5632; Wt = W3; }
    else { W = p.w_down + (size_t)l * 2816 * 1024; K = 2816; N = 1024; ldw = 1024; Wt = W4; }
    const int tn = N / 64, nt = (K / 64) * tn;
    int t0 = (wg - base) % nwg; if (t0 < 0) t0 += nwg;
    for (int t = t0; t < nt; t += nwg) {
      const int k0 = (t / tn) * 64, n0 = (t % tn) * 64;
#pragma unroll
      for (int i = 0; i < 2; ++i) { const int idx = tid + i * 512, kr = idx >> 4, nc = (idx & 15) * 4;
        const f32x4 v = *(const f32x4*)(W + (size_t)(k0 + kr) * ldw + n0 + nc);
        tile[kr * 65 + nc] = v[0]; tile[kr * 65 + nc + 1] = v[1]; tile[kr * 65 + nc + 2] = v[2]; tile[kr * 65 + nc + 3] = v[3]; }
      __syncthreads();
      { const int n = tid >> 3, kg = (tid & 7) * 8; u32x4 w;
        w.x = cvt_pk_bf16(tile[(kg + 0) * 65 + n], tile[(kg + 1) * 65 + n]); w.y = cvt_pk_bf16(tile[(kg + 2) * 65 + n], tile[(kg + 3) * 65 + n]);
        w.z = cvt_pk_bf16(tile[(kg + 4) * 65 + n], tile[(kg + 5) * 65 + n]); w.w = cvt_pk_bf16(tile[(kg + 6) * 65 + n], tile[(kg + 7) * 65 + n]);
        *(u32x4*)(Wt + (size_t)(n0 + n) * K + k0 + kg) = w; }
      __syncthreads();
    }
    base = (base + nt) % nwg;
  }
}

__device__ __forceinline__ void fold_dft(const P& p, int e, unsigned char* lds, int wg, int nwg) {
  LAS3 float* wt = (LAS3 float*)lds;
  LAS3 float* tc = wt + 16 * 129; LAS3 float* ts = tc + 128;
  const int tid = tid_();
  GA bf16_t* W1 = (GA bf16_t*)(p.ws + OFF_W1);
  const GA float* Wa = (const GA float*)(p.w_in_ab + (size_t)e * 1024 * 3072);
  __syncthreads();
  if (tid < 128) { float s, c; sincospif((float)tid * (1.f / 64.f), &s, &c); tc[tid] = c * 0.08838834764831845f; ts[tid] = s * 0.08838834764831845f; }
  for (int t = wg < 0 ? 256 : wg; t < 256; t += nwg) {
    const int kk0 = (t >> 2) * 16, g = t & 3;
    __syncthreads();
    for (int i = tid; i < 16 * 128; i += 512) { const int r = i >> 7, c = i & 127; wt[r * 129 + c] = Wa[(size_t)(kk0 + r) * 3072 + g * 128 + c]; }
    __syncthreads();
    const int kk = tid & 15, mw = tid >> 4;
    float ac[4], as[4];
#pragma unroll
    for (int i = 0; i < 4; ++i) { ac[i] = 0.f; as[i] = 0.f; }
    for (int c = 0; c < 128; ++c) { const float w = wt[kk * 129 + c];
#pragma unroll
      for (int i = 0; i < 4; ++i) { const int idx = (c * (mw + 32 * i)) & 127; ac[i] += w * tc[idx]; as[i] += w * ts[idx]; } }
#pragma unroll
    for (int i = 0; i < 4; ++i) { const int m = mw + 32 * i;
      W1[(size_t)(g * 128 + m) * 1024 + kk0 + kk] = f2bf(ac[i]); W1[(size_t)(512 + g * 128 + m) * 1024 + kk0 + kk] = f2bf(as[i]); }
  }
  __syncthreads();
}
__device__ __forceinline__ void gen_cm(const P& p, unsigned char* lds) {
  LAS3 bf16_t* tcos = (LAS3 bf16_t*)lds; LAS3 bf16_t* tsin = tcos + 4096;
  const int tid = tid_();
  __syncthreads();
  for (int j = tid; j < 4096; j += 512) { float s, c; sincospif((float)j * (1.f / 2048.f), &s, &c); tcos[j] = f2bf(c * 0.015625f); tsin[j] = f2bf(-s * 0.015625f); }
  __syncthreads();
  GA bf16_t* CM2 = (GA bf16_t*)(p.ws + OFF_CM2);
  const int gsz = gridDim.x * 512;
  for (int it = bid_() * 512 + tid; it < 4096 * 512; it += gsz) {
    const int k = it >> 9, j0 = (it & 511) * 8; unsigned w[4];
    const bool sinp = j0 >= 2048; const int jb = sinp ? j0 - 2048 : j0;
#pragma unroll
    for (int j = 0; j < 4; ++j) { const int i0 = (k * (jb + 2 * j)) & 4095, i1 = (i0 + k) & 4095;
      unsigned lo = sinp ? (unsigned)tsin[i0] : (unsigned)tcos[i0]; const unsigned hi = sinp ? (unsigned)tsin[i1] : (unsigned)tcos[i1];
      if (j == 0 && j0 == 2048) lo = (unsigned)tcos[(k * 2048) & 4095];
      w[j] = lo | (hi << 16); }
    u32x4 wv = {w[0], w[1], w[2], w[3]};
    *(GA u32x4*)(CM2 + (size_t)k * 4096 + j0) = wv;
  }
  __syncthreads();
}
__device__ __forceinline__ void ph_fold(const P& p, unsigned char* lds) {
  LAS3 bf16_t* T = (LAS3 bf16_t*)lds;
  const int tid = tid_();
  const GA bf16_t* Z = (const GA bf16_t*)(p.ws + OFF_ZT); GA bf16_t* ZF = (GA bf16_t*)(p.ws + OFF_ZF);
  const int tl = tid >> 3, mg = (tid & 7) * 8;
  const int mo = tid >> 3, tg = (tid & 7) * 8;
  for (int it = bid_(); it < 4096; it += gridDim.x) {
    const int part = it & 1, mt = (it >> 1) & 7, tt = (it >> 4) & 31, b = it >> 9;
    const int t = tt * 64 + tl, m0 = mt * 64;
    const GA bf16_t* zb = Z + (size_t)b * 4096 * 1024 + part * 512 + m0 + mg;
    u32x4 A = *(const GA u32x4*)(zb + (size_t)t * 1024);
    const u32x4 Bm = *(const GA u32x4*)(zb + (size_t)((4096 - t) & 4095) * 1024);
    if (part == 1 && t == 0) A = *(const GA u32x4*)(Z + ((size_t)b * 4096 + 2048) * 1024 + m0 + mg);
    unsigned o[4];
#pragma unroll
    for (int q = 0; q < 4; ++q) {
      float lo = bflo(A[q]), hi = bfhi(A[q]);
      if (t != 0) { if (part == 0) { lo += bflo(Bm[q]); hi += bfhi(Bm[q]); } else { lo -= bflo(Bm[q]); hi -= bfhi(Bm[q]); } }
      o[q] = cvt_pk_bf16(lo, hi);
    }
    __syncthreads();
#pragma unroll
    for (int q = 0; q < 4; ++q) *(LAS3 unsigned*)(T + tl * 66 + mg + 2 * q) = o[q];
    __syncthreads();
    unsigned w[4];
#pragma unroll
    for (int q = 0; q < 4; ++q) w[q] = (unsigned)T[(tg + 2 * q) * 66 + mo] | ((unsigned)T[(tg + 2 * q + 1) * 66 + mo] << 16);
    u32x4 wv = {w[0], w[1], w[2], w[3]};
    *(GA u32x4*)(ZF + ((size_t)b * 512 + m0 + mo) * 4096 + part * 2048 + tt * 64 + tg) = wv;
  }
  __syncthreads();
}

__device__ __forceinline__ int tcidx(int tb, int dir) { return dir ? (tb < 4 ? 3 - tb : 71 - tb) : tb; }
__device__ __forceinline__ int rowbase_of(int b, int tb) { return tb < 4 ? NLAT + b * 256 + tb * 64 : b * 4096 + (tb - 4) * 64; }
__device__ __forceinline__ void chunk_cumsum(const GA _Float16* LFc, int rowbase, int dir, int tq, int kch, LAS3 float* totl, float (&lf)[16], float (&bc)[16], float& T0, float& T1, float& T2, float& T3) {
#pragma unroll
  for (int i = 0; i < 16; ++i) { const int tau = 16 * tq + i, pp = dir ? 63 - tau : tau; lf[i] = (float)LFc[(size_t)(rowbase + pp) * 512]; }
  float run = 0.f;
#pragma unroll
  for (int i = 0; i < 16; ++i) { run += lf[i]; bc[i] = run; }
  totl[tq * 128 + kch] = run;
  __syncthreads();
  T0 = totl[kch]; T1 = totl[128 + kch]; T2 = totl[256 + kch]; T3 = totl[384 + kch];
  const float off = tq == 0 ? 0.f : (tq == 1 ? T0 : (tq == 2 ? T0 + T1 : T0 + T1 + T2));
#pragma unroll
  for (int i = 0; i < 16; ++i) bc[i] += off;
}
typedef unsigned short us2_t __attribute__((ext_vector_type(2)));
#define US2U(v) __builtin_bit_cast(unsigned, v)
__device__ __forceinline__ void ld16(unsigned& r, const bf16_t* sbase, unsigned voff) { asm volatile("global_load_ushort %0, %1, %2" : "=v"(r) : "v"(voff), "s"(sbase)); }
#define RAW_WAIT16(a) asm volatile("s_waitcnt vmcnt(0)" : "+v"(a[0]), "+v"(a[1]), "+v"(a[2]), "+v"(a[3]), "+v"(a[4]), "+v"(a[5]), "+v"(a[6]), "+v"(a[7]), \
    "+v"(a[8]), "+v"(a[9]), "+v"(a[10]), "+v"(a[11]), "+v"(a[12]), "+v"(a[13]), "+v"(a[14]), "+v"(a[15]) :: "memory")
__device__ __forceinline__ void pack2(const unsigned (&r)[16], us2_t (&pk)[8]) {
#pragma unroll
  for (int i = 0; i < 8; ++i) { pk[i].x = (unsigned short)r[2 * i]; pk[i].y = (unsigned short)r[2 * i + 1]; }
}
__device__ __forceinline__ void h1_load_raw(const P& p, int rowbase, int h, int dir, int tq, int kch, unsigned (&lfr)[16], unsigned (&vr)[16]) {
  const bf16_t* LFb = (const bf16_t*)(p.ws + (dir ? OFF_LF1 : OFF_LF0)) + (size_t)rowbase * 512 + h * 128;
  const bf16_t* Vb = (const bf16_t*)(p.ws + OFF_V) + (size_t)rowbase * 512 + h * 128;
#pragma unroll
  for (int i = 0; i < 16; ++i) { const int tau = 16 * tq + i, pp = dir ? 63 - tau : tau; const unsigned o0 = (unsigned)(pp * 1024 + kch * 2); ld16(lfr[i], LFb, o0); ld16(vr[i], Vb, o0); }
}
__device__ __forceinline__ void h3_load_raw(const P& p, int rowbase, int h, int dir, int tq, int kch, unsigned (&lfr)[16], unsigned (&qr)[16]) {
  const bf16_t* LFb = (const bf16_t*)(p.ws + (dir ? OFF_LF1 : OFF_LF0)) + (size_t)rowbase * 512 + h * 128;
  const bf16_t* Qb = (const bf16_t*)(p.ws + OFF_Q) + (size_t)rowbase * 512 + h * 128;
#pragma unroll
  for (int i = 0; i < 16; ++i) { const int tau = 16 * tq + i, pp = dir ? 63 - tau : tau; const unsigned o0 = (unsigned)(pp * 1024 + kch * 2); ld16(lfr[i], LFb, o0); ld16(qr[i], Qb, o0); }
}
__device__ __forceinline__ void h_load_raw(const P& p, int rowbase, int h, int dir, int tq, int kch, bool needq, us2_t (&lfr)[8], us2_t (&vr)[8], us2_t (&qr)[8]) {
  const GA bf16_t* LFc = (const GA bf16_t*)(p.ws + (dir ? OFF_LF1 : OFF_LF0)) + h * 128 + kch;
  const GA bf16_t* V = (const GA bf16_t*)(p.ws + OFF_V) + h * 128 + kch; const GA bf16_t* Q = (const GA bf16_t*)(p.ws + OFF_Q) + h * 128 + kch;
#pragma unroll
  for (int i = 0; i < 8; ++i) { const int tau = 16 * tq + 2 * i, p0 = dir ? 63 - tau : tau, p1 = dir ? p0 - 1 : p0 + 1; const size_t g0 = (size_t)(rowbase + p0) * 512, g1 = (size_t)(rowbase + p1) * 512;
    lfr[i].x = LFc[g0]; lfr[i].y = LFc[g1]; vr[i].x = V[g0]; vr[i].y = V[g1]; if (needq) { qr[i].x = Q[g0]; qr[i].y = Q[g1]; } }
}
__device__ __forceinline__ float h16bits(unsigned short w) { return (float)__builtin_bit_cast(_Float16, w); }
__device__ __forceinline__ void chunk_cumsum_raw(const us2_t (&lfr)[8], int tq, int kch, LAS3 float* totl, float (&lf)[16], float (&bc)[16], float& T0, float& T1, float& T2, float& T3) {
  float run = 0.f;
#pragma unroll
  for (int i = 0; i < 16; ++i) { lf[i] = h16bits((i & 1) ? lfr[i >> 1].y : lfr[i >> 1].x); run += lf[i]; bc[i] = run; }
  totl[tq * 128 + kch] = run;
  __syncthreads();
  T0 = totl[kch]; T1 = totl[128 + kch]; T2 = totl[256 + kch]; T3 = totl[384 + kch];
  const float off = tq == 0 ? 0.f : (tq == 1 ? T0 : (tq == 2 ? T0 + T1 : T0 + T1 + T2));
#pragma unroll
  for (int i = 0; i < 16; ++i) bc[i] += off;
}
__device__ __forceinline__ void ph_h1(const P& p, unsigned char* lds) {
  const int tid = tid_(), wid = tid >> 6, lane = tid & 63, r32 = lane & 31, hi = lane >> 5, kch = tid & 127, tq = tid >> 7;
  LAS3 bf16_t* KD = (LAS3 bf16_t*)lds;
  LAS3 bf16_t* VT = KD + 128 * 72;
  LAS3 float* totl = (LAS3 float*)(VT + 128 * 72);
  const GA bf16_t* V = (const GA bf16_t*)(p.ws + OFF_V);
  GA bf16_t* ST = (GA bf16_t*)(p.ws + OFF_ST); GA float* DEC = (GA float*)(p.ws + OFF_DEC);
  const int ti = wid >> 1;
  const int GS = gridDim.x;
  us2_t lfA[8], vv[8]; unsigned lfN[16], vN[16];
  { const int it0 = bid_(); if (it0 < 4352) { const int rest = it0 >> 3; h1_load_raw(p, rowbase_of(rest / 68, rest % 68), (it0 >> 1) & 3, it0 & 1, tq, kch, lfN, vN); RAW_WAIT16(lfN); RAW_WAIT16(vN); pack2(lfN, lfA); pack2(vN, vv); } }
  for (int it = bid_(); it < 4352; it += GS) {
    const int dir = it & 1, h = (it >> 1) & 3, rest = it >> 3, tb = rest % 68, b = rest / 68;
    const int tc = tcidx(tb, dir), stream = (b * 4 + h) * 2 + dir;
    { const int itn = it + GS; if (itn < 4352) { const int restn = itn >> 3; h1_load_raw(p, rowbase_of(restn / 68, restn % 68), (itn >> 1) & 3, itn & 1, tq, kch, lfN, vN); } }
    float lf[16], bc[16], T0, T1, T2, T3;
    chunk_cumsum_raw(lfA, tq, kch, totl, lf, bc, T0, T1, T2, T3);
    const float blast = T0 + T1 + T2 + T3;
    float kd[16];
#pragma unroll
    for (int i = 0; i < 16; ++i) kd[i] = (1.f - __expf(lf[i])) * __expf(blast - bc[i]);
    u32x4 w0, w1;
    w0.x = cvt_pk_bf16(kd[0], kd[1]); w0.y = cvt_pk_bf16(kd[2], kd[3]); w0.z = cvt_pk_bf16(kd[4], kd[5]); w0.w = cvt_pk_bf16(kd[6], kd[7]);
    w1.x = cvt_pk_bf16(kd[8], kd[9]); w1.y = cvt_pk_bf16(kd[10], kd[11]); w1.z = cvt_pk_bf16(kd[12], kd[13]); w1.w = cvt_pk_bf16(kd[14], kd[15]);
    *(LAS3 u32x4*)(KD + kch * 72 + 16 * tq) = w0; *(LAS3 u32x4*)(KD + kch * 72 + 16 * tq + 8) = w1;
    w0.x = US2U(vv[0]); w0.y = US2U(vv[1]); w0.z = US2U(vv[2]); w0.w = US2U(vv[3]); w1.x = US2U(vv[4]); w1.y = US2U(vv[5]); w1.z = US2U(vv[6]); w1.w = US2U(vv[7]);
    *(LAS3 u32x4*)(VT + kch * 72 + 16 * tq) = w0; *(LAS3 u32x4*)(VT + kch * 72 + 16 * tq + 8) = w1;
    if (tq == 0) DEC[(size_t)(stream * 68 + tc) * 128 + kch] = __expf(blast);
    __syncthreads();
    GA bf16_t* UT = ST + (size_t)(stream * 68 + tc) * 16384;
#pragma unroll
    for (int jj = 0; jj < 2; ++jj) {
      const int tj = (wid & 1) * 2 + jj;
      f32x16 acc = {};
#pragma unroll
      for (int ks = 0; ks < 4; ++ks) {
        const bf16x8 a = *(const LAS3 bf16x8*)(KD + (32 * ti + r32) * 72 + ks * 16 + hi * 8);
        const bf16x8 bq = *(const LAS3 bf16x8*)(VT + (32 * tj + r32) * 72 + ks * 16 + hi * 8);
        acc = __builtin_amdgcn_mfma_f32_32x32x16_bf16(a, bq, acc, 0, 0, 0);
      }
#pragma unroll
      for (int rg = 0; rg < 4; ++rg) { u32x2 w; w.x = cvt_pk_bf16(acc[4 * rg], acc[4 * rg + 1]); w.y = cvt_pk_bf16(acc[4 * rg + 2], acc[4 * rg + 3]);
        *(GA u32x2*)(UT + (size_t)(32 * tj + r32) * 128 + 32 * ti + 8 * rg + 4 * hi) = w; }
    }
    if (it + GS < 4352) { RAW_WAIT16(lfN); RAW_WAIT16(vN); pack2(lfN, lfA); pack2(vN, vv); }
  }
}
__device__ __forceinline__ void ph_h2(const P& p) {
  GA bf16_t* ST = (GA bf16_t*)(p.ws + OFF_ST); const GA float* DEC = (const GA float*)(p.ws + OFF_DEC);
  for (int idx = bid_() * 512 + tid_(); idx < 64 * 2048; idx += gridDim.x * 512) {
    const int stream = idx >> 11, e8 = idx & 2047, k0 = (e8 & 15) * 8;
    GA bf16_t* base = ST + (size_t)stream * 68 * 16384 + e8 * 8; const GA float* dec = DEC + (size_t)stream * 68 * 128 + k0;
    float S[8];
#pragma unroll
    for (int j = 0; j < 8; ++j) S[j] = 0.f;
#pragma unroll 1
    for (int t0 = 0; t0 < 68; t0 += 4) {
      u32x4 u[4]; f32x4 d0[4], d1[4];
#pragma unroll
      for (int q = 0; q < 4; ++q) { u[q] = *(const GA u32x4*)(base + (size_t)(t0 + q) * 16384); d0[q] = *(const GA f32x4*)(dec + (t0 + q) * 128); d1[q] = *(const GA f32x4*)(dec + (t0 + q) * 128 + 4); }
#pragma unroll
      for (int q = 0; q < 4; ++q) {
        u32x4 w; w.x = cvt_pk_bf16(S[0], S[1]); w.y = cvt_pk_bf16(S[2], S[3]); w.z = cvt_pk_bf16(S[4], S[5]); w.w = cvt_pk_bf16(S[6], S[7]);
        *(GA u32x4*)(base + (size_t)(t0 + q) * 16384) = w;
        S[0] = d0[q][0] * S[0] + bflo(u[q].x); S[1] = d0[q][1] * S[1] + bfhi(u[q].x); S[2] = d0[q][2] * S[2] + bflo(u[q].y); S[3] = d0[q][3] * S[3] + bfhi(u[q].y);
        S[4] = d1[q][0] * S[4] + bflo(u[q].z); S[5] = d1[q][1] * S[5] + bfhi(u[q].z); S[6] = d1[q][2] * S[6] + bflo(u[q].w); S[7] = d1[q][3] * S[7] + bfhi(u[q].w);
      }
    }
  }
}
__device__ __forceinline__ void ph_h3(const P& p, int e, unsigned char* lds) {
  const int tid = tid_(), wid = tid >> 6, lane = tid & 63, r32 = lane & 31, hi = lane >> 5, kch = tid & 127, tq = tid >> 7;
  LAS3 bf16_t* QBt = (LAS3 bf16_t*)lds;
  LAS3 bf16_t* QXt = QBt + 64 * 136;
  LAS3 bf16_t* KXt = QXt + 64 * 136;
  LAS3 bf16_t* YTt = KXt + 64 * 136;
  LAS3 bf16_t* VTt = YTt + 64 * 136;
  LAS3 bf16_t* ATt = VTt + 128 * 72;
  LAS3 float* totl = (LAS3 float*)(ATt + 64 * 72);
  LAS3 float* OT = (LAS3 float*)lds;
  const GA bf16_t* Q = (const GA bf16_t*)(p.ws + OFF_Q); const GA bf16_t* V = (const GA bf16_t*)(p.ws + OFF_V); const GA bf16_t* G = (const GA bf16_t*)(p.ws + OFF_G);
  const GA bf16_t* ST = (const GA bf16_t*)(p.ws + OFF_ST); GA bf16_t* MIX = (GA bf16_t*)(p.ws + OFF_MIX);
  const GA float* gn = (const GA float*)(p.hg_ng + e * 512);
  const int ti = wid >> 2, tj = wid & 3;
  const int GS = gridDim.x;
  us2_t lfA[8], qraw[8]; unsigned lfN[16], qN[16];
  { const int it0 = bid_(); if (it0 < 2176) { const int rest = it0 >> 2; h3_load_raw(p, rowbase_of(rest / 68, rest % 68), it0 & 3, 0, tq, kch, lfN, qN); RAW_WAIT16(lfN); RAW_WAIT16(qN); pack2(lfN, lfA); pack2(qN, qraw); } }
  const int ppv = tid >> 3, cgv = tid & 7;
  for (int it = bid_(); it < 2176; it += GS) {
    const int h = it & 3, rest = it >> 2, tb = rest % 68, b = rest / 68;
    const int rowbase = rowbase_of(b, tb);
    f32x16 o = {};
#pragma unroll 1
    for (int dir = 0; dir < 2; ++dir) {
      const int tc = tcidx(tb, dir), stream = (b * 4 + h) * 2 + dir;
      const GA bf16_t* Sg = ST + (size_t)(stream * 68 + tc) * 16384;
      bf16x8 sfr[8];
#pragma unroll
      for (int ks = 0; ks < 8; ++ks) sfr[ks] = *(const GA bf16x8*)(Sg + (size_t)(32 * tj + r32) * 128 + ks * 16 + hi * 8);
      u32x4 vw0, vw1;
      if (dir == 0) { const GA bf16_t* vp = V + (size_t)(rowbase + ppv) * 512 + h * 128 + cgv * 16; vw0 = *(const GA u32x4*)vp; vw1 = *(const GA u32x4*)(vp + 8); }
      if (dir == 0) h3_load_raw(p, rowbase, h, 1, tq, kch, lfN, qN);
      else { const int itn = it + GS; if (itn < 2176) { const int restn = itn >> 2; h3_load_raw(p, rowbase_of(restn / 68, restn % 68), itn & 3, 0, tq, kch, lfN, qN); } }
      float lf[16], bc[16], T0, T1, T2, T3;
      chunk_cumsum_raw(lfA, tq, kch, totl, lf, bc, T0, T1, T2, T3);
      const float R31 = T0 + T1, refx = tq < 2 ? T0 : R31 + T2;
#pragma unroll 1
      for (int rep_ = 0; rep_ < REP_FILL; ++rep_)
#pragma unroll
      for (int i = 0; i < 16; ++i) {
        const int tau = 16 * tq + i, pp = dir ? 63 - tau : tau;
        const float qv = bf2f((i & 1) ? qraw[i >> 1].y : qraw[i >> 1].x), kkv = 1.f - __expf(lf[i]), bi = bc[i];
        QBt[pp * 136 + kch] = f2bf(qv * __expf(bi));
        QXt[pp * 136 + kch] = f2bf(qv * __expf(fminf(bi - refx, 80.f)));
        KXt[pp * 136 + kch] = f2bf(kkv * __expf(fminf(refx - bi, 80.f)));
        YTt[pp * 136 + kch] = tq < 2 ? f2bf(kkv * __expf(R31 - bi)) : f2bf(qv * __expf(bi - R31));
      }
      if (dir == 0) {
#pragma unroll
        for (int j = 0; j < 8; ++j) { VTt[(cgv * 16 + j) * 72 + ppv] = (bf16_t)((j & 1) ? (vw0[j >> 1] >> 16) : (vw0[j >> 1] & 0xffffu)); VTt[(cgv * 16 + 8 + j) * 72 + ppv] = (bf16_t)((j & 1) ? (vw1[j >> 1] >> 16) : (vw1[j >> 1] & 0xffffu)); }
      }
      __syncthreads();
#pragma unroll
      for (int ks = 0; ks < 8; ++ks) {
        const bf16x8 a = *(const LAS3 bf16x8*)(QBt + (32 * ti + r32) * 136 + ks * 16 + hi * 8);
        o = __builtin_amdgcn_mfma_f32_32x32x16_bf16(a, sfr[ks], o, 0, 0, 0);
      }
      if (wid < 4) {
        const int I = wid >> 1, J = wid & 1;
        const bool diag = (I == J), offd = dir ? (I == 0 && J == 1) : (I == 1 && J == 0);
        f32x16 acc = {};
        if (diag || offd) {
          const LAS3 bf16_t* Ap = diag ? QXt : YTt; const LAS3 bf16_t* Bp = diag ? KXt : YTt;
#pragma unroll
          for (int ks = 0; ks < 8; ++ks) {
            const bf16x8 a = *(const LAS3 bf16x8*)(Ap + (32 * I + r32) * 136 + ks * 16 + hi * 8);
            const bf16x8 bq = *(const LAS3 bf16x8*)(Bp + (32 * J + r32) * 136 + ks * 16 + hi * 8);
            acc = __builtin_amdgcn_mfma_f32_32x32x16_bf16(a, bq, acc, 0, 0, 0);
          }
        }
#pragma unroll
        for (int r = 0; r < 16; ++r) { const int t = (r & 3) + 8 * (r >> 2) + 4 * hi;
          const bool keep = !diag || (dir ? (r32 >= t) : (r32 <= t));
          ATt[(32 * I + t) * 72 + 32 * J + r32] = f2bf(keep ? acc[r] : 0.f); }
      }
      __syncthreads();
#pragma unroll
      for (int ks = 0; ks < 4; ++ks) {
        const bf16x8 a = *(const LAS3 bf16x8*)(ATt + (32 * ti + r32) * 72 + ks * 16 + hi * 8);
        const bf16x8 bq = *(const LAS3 bf16x8*)(VTt + (32 * tj + r32) * 72 + ks * 16 + hi * 8);
        o = __builtin_amdgcn_mfma_f32_32x32x16_bf16(a, bq, o, 0, 0, 0);
      }
      if (dir == 0 || it + GS < 2176) { RAW_WAIT16(lfN); RAW_WAIT16(qN); pack2(lfN, lfA); pack2(qN, qraw); }
    }
#pragma unroll
    for (int r = 0; r < 16; ++r) OT[(32 * ti + (r & 3) + 8 * (r >> 2) + 4 * hi) * 132 + 32 * tj + r32] = o[r];
    __syncthreads();
    {
      const int pp = tid >> 3, seg = tid & 7, row = rowbase + pp;
      float ov[16]; float ss = 0.f;
#pragma unroll
      for (int q = 0; q < 4; ++q) { const f32x4 v4 = *(const LAS3 f32x4*)(OT + pp * 132 + seg * 16 + q * 4); ov[q * 4] = v4[0]; ov[q * 4 + 1] = v4[1]; ov[q * 4 + 2] = v4[2]; ov[q * 4 + 3] = v4[3];
        ss += v4[0] * v4[0] + v4[1] * v4[1] + v4[2] * v4[2] + v4[3] * v4[3]; }
      ss += __shfl_xor(ss, 1); ss += __shfl_xor(ss, 2); ss += __shfl_xor(ss, 4);
      const float rs = rsqrtf(ss * (1.f / 128.f) + EPS);
      const u32x4 g0 = *(const GA u32x4*)(G + (size_t)row * 512 + h * 128 + seg * 16), g1 = *(const GA u32x4*)(G + (size_t)row * 512 + h * 128 + seg * 16 + 8);
      float y[16];
#pragma unroll
      for (int j = 0; j < 8; ++j) { y[j] = ov[j] * rs * gn[h * 128 + seg * 16 + j] * silu_f(UNPK(g0, j)); y[8 + j] = ov[8 + j] * rs * gn[h * 128 + seg * 16 + 8 + j] * silu_f(UNPK(g1, j)); }
      u32x4 w0, w1;
      w0.x = cvt_pk_bf16(y[0], y[1]); w0.y = cvt_pk_bf16(y[2], y[3]); w0.z = cvt_pk_bf16(y[4], y[5]); w0.w = cvt_pk_bf16(y[6], y[7]);
      w1.x = cvt_pk_bf16(y[8], y[9]); w1.y = cvt_pk_bf16(y[10], y[11]); w1.z = cvt_pk_bf16(y[12], y[13]); w1.w = cvt_pk_bf16(y[14], y[15]);
      GA bf16_t* dst = MIX + (size_t)row * 1024 + 512 + h * 128 + seg * 16;
      *(GA u32x4*)dst = w0; *(GA u32x4*)(dst + 8) = w1;
    }
    __syncthreads();
  }
}

__device__ __forceinline__ void ph_normrope(const P& p, int o) {
  const int tid = tid_(), wave = tid >> 6, lane = tid & 63;
  GA bf16_t* QB = (GA bf16_t*)(p.ws + OFF_QB); GA bf16_t* KB = (GA bf16_t*)(p.ws + OFF_KB);
  const GA float* ROPE = (const GA float*)(p.ws + OFF_ROPE);
  const float gq0 = p.qn_g[o * 128 + lane * 2], gq1 = p.qn_g[o * 128 + lane * 2 + 1], gk0 = p.kn_g[o * 128 + lane * 2], gk1 = p.kn_g[o * 128 + lane * 2 + 1];
  for (int row = bid_() * 8 + wave; row < NTOK; row += gridDim.x * 8) {
    GA bf16_t* qp = QB + (size_t)row * 1024 + lane * 2; GA bf16_t* kp = KB + (size_t)kvrow(row) * 256 + lane * 2;
    unsigned w[10];
#pragma unroll
    for (int s_ = 0; s_ < 8; ++s_) w[s_] = *(const GA unsigned*)(qp + s_ * 128);
    w[8] = *(const GA unsigned*)kp; w[9] = *(const GA unsigned*)(kp + 128);
    float cs = 1.f, sn = 0.f;
    if (row < NLAT) { const int t = row & 4095; const int pos = lane < 32 ? (t >> 6) : (t & 63); const GA float* cs2 = ROPE + 2 * (pos * 32 + (lane & 31)); cs = cs2[0]; sn = cs2[1]; }
#pragma unroll
    for (int s_ = 0; s_ < 10; ++s_) {
      const float x0 = bflo(w[s_]), x1 = bfhi(w[s_]);
      const float ss = wave_sum(x0 * x0 + x1 * x1);
      const float rs = rsqrtf(ss * (1.f / 128.f) + EPS);
      const float y0 = x0 * rs * (s_ < 8 ? gq0 : gk0), y1 = x1 * rs * (s_ < 8 ? gq1 : gk1);
      const unsigned ow = cvt_pk_bf16(y0 * cs - y1 * sn, y0 * sn + y1 * cs);
      if (s_ < 8) *(GA unsigned*)(qp + s_ * 128) = ow; else *(GA unsigned*)(kp + (s_ - 8) * 128) = ow;
    }
  }
}

__device__ __forceinline__ void ph_attn(const P& p, bool last, unsigned char* lds) {
  const bf16_t* QB = (const bf16_t*)(p.ws + OFF_QB); const bf16_t* KB = (const bf16_t*)(p.ws + OFF_KB); const bf16_t* VB = (const bf16_t*)(p.ws + OFF_VB);
  bf16_t* MIX = (bf16_t*)(p.ws + OFF_MIX);
#pragma unroll 1
  for (int r = 0; r < (last ? 4 : 5); ++r) {
    const int w = bid_(), bb = w & 7, jj = w >> 3;
    size_t qoff, koff; int seq;
    if (r < 4) { const int idx = r * 32 + jj, h = idx >> 4, qb = idx & 15; qoff = (size_t)(bb * 4096 + qb * 256) * 1024 + h * 128; koff = (size_t)bb * 4352 * 256 + (h >> 2) * 128; seq = 4352; }
    else { if (jj >= 8) break; const int h = jj; qoff = (size_t)(NLAT + bb * 256) * 1024 + h * 128; koff = ((size_t)bb * 4352 + 4096) * 256 + (h >> 2) * 128; seq = 256; }
    att::attn_dense_body(QB + qoff, KB + koff, VB + koff, MIX + qoff, seq, (char*)lds);
    __syncthreads();
  }
}

__device__ __forceinline__ void ph_conv(const P& p, int l, bool last) {
  const bf16_t* GATE = (const bf16_t*)(p.ws + OFF_GATE); bf16_t* VAL = (bf16_t*)(p.ws + OFF_VAL);
  const float* cw = p.conv_w + (size_t)l * 9 * 2816; const float* cb = p.conv_b + (size_t)l * 2816;
  const int gsz = gridDim.x * 512, gtid = bid_() * 512 + tid_();
  const u32x4 Z4 = {0u, 0u, 0u, 0u};
  for (int it = gtid; it < 2 * 8 * 64 * 352; it += gsz) {
    const int cg8 = it % 352; int rest = it / 352; const int col = rest & 63; rest >>= 6; const int b = rest & 7, seg = rest >> 3;
    const int c0 = cg8 * 8;
    float w[9][8], bias[8];
#pragma unroll
    for (int k = 0; k < 9; ++k) { const f32x4 a = *(const f32x4*)(cw + k * 2816 + c0), bq = *(const f32x4*)(cw + k * 2816 + c0 + 4);
      w[k][0] = a[0]; w[k][1] = a[1]; w[k][2] = a[2]; w[k][3] = a[3]; w[k][4] = bq[0]; w[k][5] = bq[1]; w[k][6] = bq[2]; w[k][7] = bq[3]; }
    { const f32x4 a = *(const f32x4*)(cb + c0), bq = *(const f32x4*)(cb + c0 + 4); bias[0] = a[0]; bias[1] = a[1]; bias[2] = a[2]; bias[3] = a[3]; bias[4] = bq[0]; bias[5] = bq[1]; bias[6] = bq[2]; bias[7] = bq[3]; }
    const size_t tb = (size_t)b * 4096;
#define LD3(r, A, Mi, C) do { if ((r) < 0 || (r) > 63) { A = Z4; Mi = Z4; C = Z4; } else { const bf16_t* q_ = GATE + (tb + (r) * 64 + col) * 2816 + c0; \
      Mi = *(const u32x4*)q_; A = col > 0 ? *(const u32x4*)(q_ - 2816) : Z4; C = col < 63 ? *(const u32x4*)(q_ + 2816) : Z4; } } while (0)
    u32x4 p0, p1, p2, q0, q1, q2, n0, n1, n2;
    const int r0 = seg * 32;
    LD3(r0 - 1, p0, p1, p2); LD3(r0, q0, q1, q2);
    for (int r = r0; r < r0 + 32; ++r) {
      LD3(r + 1, n0, n1, n2);
      bf16_t* vp = VAL + (tb + r * 64 + col) * 2816 + c0;
      const u32x4 vv = *(const u32x4*)vp;
      float a[8];
#pragma unroll
      for (int j = 0; j < 8; ++j) {
        float s = bias[j];
        s += w[0][j] * UNPK(p0, j) + w[1][j] * UNPK(p1, j) + w[2][j] * UNPK(p2, j);
        s += w[3][j] * UNPK(q0, j) + w[4][j] * UNPK(q1, j) + w[5][j] * UNPK(q2, j);
        s += w[6][j] * UNPK(n0, j) + w[7][j] * UNPK(n1, j) + w[8][j] * UNPK(n2, j);
        a[j] = silu_f(s) * UNPK(vv, j);
      }
      u32x4 ow; ow.x = cvt_pk_bf16(a[0], a[1]); ow.y = cvt_pk_bf16(a[2], a[3]); ow.z = cvt_pk_bf16(a[4], a[5]); ow.w = cvt_pk_bf16(a[6], a[7]);
      *(u32x4*)vp = ow;
      p0 = q0; p1 = q1; p2 = q2; q0 = n0; q1 = n1; q2 = n2;
    }
#undef LD3
  }
  if (!last) {
    for (int it = gtid; it < 8 * 32 * 352; it += gsz) {
      const int cg8 = it % 352, rest = it / 352, seg = rest & 31, b = rest >> 5, c0 = cg8 * 8, j0 = seg * 8;
      float w3[3][8], bias[8];
#pragma unroll
      for (int k = 0; k < 3; ++k) { const f32x4 wa = *(const f32x4*)(cw + (3 + k) * 2816 + c0), wb = *(const f32x4*)(cw + (3 + k) * 2816 + c0 + 4);
        w3[k][0] = wa[0]; w3[k][1] = wa[1]; w3[k][2] = wa[2]; w3[k][3] = wa[3]; w3[k][4] = wb[0]; w3[k][5] = wb[1]; w3[k][6] = wb[2]; w3[k][7] = wb[3]; }
      { const f32x4 wa = *(const f32x4*)(cb + c0), wb = *(const f32x4*)(cb + c0 + 4); bias[0] = wa[0]; bias[1] = wa[1]; bias[2] = wa[2]; bias[3] = wa[3]; bias[4] = wb[0]; bias[5] = wb[1]; bias[6] = wb[2]; bias[7] = wb[3]; }
      const size_t row0 = (size_t)NLAT + b * 256 + j0;
      const bf16_t* gq = GATE + row0 * 2816 + c0; bf16_t* vq = VAL + row0 * 2816 + c0;
      u32x4 g[10], vv[8];
#pragma unroll
      for (int i = 0; i < 10; ++i) { const int j = j0 - 1 + i; g[i] = (j >= 0 && j <= 255) ? *(const u32x4*)(gq + (ptrdiff_t)(i - 1) * 2816) : Z4; }
#pragma unroll
      for (int i = 0; i < 8; ++i) vv[i] = *(const u32x4*)(vq + (size_t)i * 2816);
#pragma unroll
      for (int i = 0; i < 8; ++i) {
        float a[8];
#pragma unroll
        for (int j = 0; j < 8; ++j) {
          const float sacc = bias[j] + w3[0][j] * UNPK(g[i], j) + w3[1][j] * UNPK(g[i + 1], j) + w3[2][j] * UNPK(g[i + 2], j);
          a[j] = silu_f(sacc) * UNPK(vv[i], j);
        }
        u32x4 ow; ow.x = cvt_pk_bf16(a[0], a[1]); ow.y = cvt_pk_bf16(a[2], a[3]); ow.z = cvt_pk_bf16(a[4], a[5]); ow.w = cvt_pk_bf16(a[6], a[7]);
        *(u32x4*)(vq + (size_t)i * 2816) = ow;
      }
    }
  }
}

__device__ __forceinline__ void ph_final(const P& p) {
  const int tid = tid_(), wave = tid >> 6, lane = tid & 63;
  f32x4 g4[4];
#pragma unroll
  for (int j = 0; j < 4; ++j) g4[j] = *(const GA f32x4*)((const GA float*)p.fn_g + j * 256 + lane * 4);
  for (int row = bid_() * 16 + wave; row < NLAT; row += gridDim.x * 16) {
    GA float* src = (GA float*)(p.out + (size_t)row * 1024);
    f32x4 v[2][4]; float ss0 = 0.f, ss1 = 0.f;
#pragma unroll
    for (int j = 0; j < 4; ++j) { v[0][j] = *(const GA f32x4*)(src + j * 256 + lane * 4); v[1][j] = *(const GA f32x4*)(src + 8 * 1024 + j * 256 + lane * 4); }
#pragma unroll
    for (int j = 0; j < 4; ++j) { ss0 += v[0][j][0] * v[0][j][0] + v[0][j][1] * v[0][j][1] + v[0][j][2] * v[0][j][2] + v[0][j][3] * v[0][j][3];
      ss1 += v[1][j][0] * v[1][j][0] + v[1][j][1] * v[1][j][1] + v[1][j][2] * v[1][j][2] + v[1][j][3] * v[1][j][3]; }
    ss0 = wave_sum(ss0); ss1 = wave_sum(ss1);
    const float rs0 = rsqrtf(ss0 * (1.f / 1024.f) + EPS), rs1 = rsqrtf(ss1 * (1.f / 1024.f) + EPS);
#pragma unroll
    for (int j = 0; j < 4; ++j) { f32x4 o0, o1; for (int q = 0; q < 4; ++q) { o0[q] = v[0][j][q] * rs0 * g4[j][q]; o1[q] = v[1][j][q] * rs1 * g4[j][q]; }
      *(GA f32x4*)(src + j * 256 + lane * 4) = o0; *(GA f32x4*)(src + 8 * 1024 + j * 256 + lane * 4) = o1; }
  }
}

__device__ __forceinline__ void run_phase(const P& p_in, int l, int ph, unsigned char* lds) {
  const bool even = !(l & 1), last = (l == 3); const int e = l >> 1;
  P p = p_in; asm volatile("" : "+s"(p.ws), "+s"(p.out));
  unsigned char* ws = p.ws;
  const float* MOD = (const float*)(ws + OFF_MOD);
  bf16_t* HB = (bf16_t*)(ws + OFF_HB); bf16_t* MIX = (bf16_t*)(ws + OFF_MIX);
  bf16_t* W1 = (bf16_t*)(ws + OFF_W1); bf16_t* W2 = (bf16_t*)(ws + OFF_W2); bf16_t* W3 = (bf16_t*)(ws + OFF_W3); bf16_t* W4 = (bf16_t*)(ws + OFF_W4);
  const int Mres = last ? NLAT : NTOK;
  if (ph == 0) {
    modulate_rows(p, l, 0, NTOK, l == 0, l > 0 ? (const float*)(ws + OFF_GATE) : nullptr, MOD + (size_t)((l > 0 ? l - 1 : 0) * 9 + 8) * 6144 + 5120);
    if (l == 0) { convert_weights(p, 0, lds, bid_(), (int)gridDim.x); fold_dft(p, 0, lds, bid_(), (int)gridDim.x); }
    if (even) gen_cm(p, lds);
  } else if (ph == 7) {
    EpiRes E{p.out, (float*)(ws + OFF_CTXR), MOD + (size_t)l * 9 * 6144 + 2048, l == 0 ? p.x : (const float*)p.out};
    run_gemm(lds, MIX, W2, NLAT, 1024, 1024, E);
    if (!last) { EpiPart Ep{(float*)(ws + OFF_MX), 512}; run_gemm_splitk(lds, MIX + (size_t)NLAT * 1024, W2, NCTX, 1024, 1024, 2, Ep); }
  } else if (ph == 8) {
    modulate_rows(p, l, 1, Mres, false, (const float*)(ws + OFF_MX), MOD + (size_t)(l * 9 + 8) * 6144 + 2048);
  } else if (ph == 9) {
    EpiUp E{(bf16_t*)(ws + OFF_GATE), (bf16_t*)(ws + OFF_VAL)};
    run_gemm(lds, HB, W3, Mres, 5632, 1024, E);
    if (!last) {
      __syncthreads();
      convert_weights(p, l + 1, lds, (int)bid_() - 176, (int)gridDim.x - 176, 0, 2);
    }
  } else if (ph == 10) {
    ph_conv(p, l, last);
  } else if (ph == 11) {
    EpiRes E{p.out, (float*)(ws + OFF_CTXR), MOD + (size_t)l * 9 * 6144 + 5120, (const float*)p.out};
    run_gemm(lds, (const bf16_t*)(ws + OFF_VAL), (const bf16_t*)(ws + ((l & 1) ? OFF_W4B : OFF_W4)), NLAT, 1024, 2816, E);
    if (!last) { EpiPart Ep{(float*)(ws + OFF_GATE), 1408}; run_gemm_splitk(lds, (const bf16_t*)(ws + OFF_VAL) + (size_t)NLAT * 2816, (const bf16_t*)(ws + ((l & 1) ? OFF_W4B : OFF_W4)), NCTX, 1024, 2816, 2, Ep); }
    if (!last) {
      const int wg = (int)bid_() - 64, nwg = (int)gridDim.x - 64;
      __syncthreads();
      convert_weights(p, l + 1, lds, wg, nwg, 2, 4);
      if (l & 1) fold_dft(p, (l + 1) >> 1, lds, wg, nwg);
    }
  } else if (even) {
    if (ph == 1) { EpiAB E{EpiZ{(bf16_t*)(ws + OFF_ZT), (bf16_t*)(ws + OFF_ZTC)},
                           EpiHG{(bf16_t*)(ws + OFF_Q), (bf16_t*)(ws + OFF_V), (bf16_t*)(ws + OFF_G), (_Float16*)(ws + OFF_LF0), (_Float16*)(ws + OFF_LF1), (const float*)(ws + OFF_LB) + e * 1024}};
      run_gemm(lds, HB, W1, NTOK, 3584, 1024, E);
      if (l == 0) { __syncthreads(); mod_gemv(p, lds, 1, 4, (int)bid_() - 112, (int)gridDim.x - 112); } }
    else if (ph == 12) ph_fold(p, lds);
    else if (ph == 2) {
      { EpiDFT E{MIX, 0}; run_gemm(lds, (const bf16_t*)(ws + OFF_CM2), (const bf16_t*)(ws + OFF_ZF), 4096, 4096, 4096, E); }
      { EpiDFT E{MIX, 1}; run_gemm(lds, (const bf16_t*)(ws + OFF_CM256), (const bf16_t*)(ws + OFF_ZTC), 256, 4096, 512, E); }
    }
    else if (ph == 4) ph_h1(p, lds);
    else if (ph == 5) ph_h2(p);
    else if (ph == 6) ph_h3(p, e, lds);
  } else {
    if (ph == 1) { EpiQKV E{(bf16_t*)(ws + OFF_QB), (bf16_t*)(ws + OFF_KB), (bf16_t*)(ws + OFF_VB)}; run_gemm(lds, HB, W1, NTOK, 1536, 1024, E); }
    else if (ph == 2) ph_normrope(p, e);
    else if (ph == 3) ph_attn(p, last, lds);
  }
}

#if MULTI
__global__ void __launch_bounds__(512, 2) k_phase(P p, int l, int ph) {
  extern __shared__ __attribute__((aligned(16))) unsigned char lds[];
  if (l < 0) ph0(p, lds); else if (l >= 4) ph_final(p); else run_phase(p, l, ph, lds);
}
#else
__global__ void __launch_bounds__(512, 2) k_mega(P p) {
  extern __shared__ __attribute__((aligned(16))) unsigned char lds[];
  cg::grid_group grid = cg::this_grid();
  volatile LAS3 unsigned* st = (volatile LAS3 unsigned*)((LAS3 unsigned char*)lds + 131072);
  if (threadIdx.x == 0) { st[0] = 0u; st[1] = 0u; st[2] = 0u; st[3] = 0u; }
  __syncthreads();
  XcdBarrier bar = xcd_barrier_post((unsigned*)(p.ws + OFF_BAR), st);
  grid.sync();
  ph0(p, lds); xcd_barrier(bar);
#pragma unroll 1
  for (int l = 0; l < 4; ++l) {
#pragma unroll 1
    for (int sq = 0; sq <= 12; ++sq) {
      const int ph = sq < 2 ? sq : (sq == 2 ? 12 : sq - 1);
      if ((l & 1) ? ((ph >= 4 && ph <= 6) || ph == 12) : (ph == 3)) continue;
      run_phase(p, l, ph, lds);
      xcd_barrier(bar);
#if REP_MASK != 0
      if (((REP_MASK >> ph) & 1) && !(ph == 2 && (l & 1))) { run_phase(p, l, ph, lds); xcd_barrier(bar); }
#endif
    }
  }
  ph_final(p);
}
#endif

constexpr int LDS_BYTES = 131072 + 16;
extern "C" void kernel_launch(void* const* d_in, const int* in_sizes, int n_in, void* d_out, int out_size, void* d_ws, size_t ws_size, hipStream_t stream) {
  static int ok = 0;
  if (!ok) {
    if (n_in != 19 || ws_size < WS_END) { fprintf(stderr, "kernel_launch: unexpected n_in %d / ws %zu (need %zu)\n", n_in, ws_size, (size_t)WS_END); return; }
#if MULTI
    if (hipFuncSetAttribute((const void*)k_phase, hipFuncAttributeMaxDynamicSharedMemorySize, LDS_BYTES) != hipSuccess) { fprintf(stderr, "hipFuncSetAttribute failed\n"); return; }
#else
    if (hipFuncSetAttribute((const void*)k_mega, hipFuncAttributeMaxDynamicSharedMemorySize, LDS_BYTES) != hipSuccess) { fprintf(stderr, "hipFuncSetAttribute failed\n"); return; }
#endif
    ok = 1;
  }
  P p{};
  p.x = (const float*)d_in[0]; p.c = (const float*)d_in[1]; p.ctx = (const float*)d_in[2]; p.c_ctx = (const float*)d_in[3]; p.w_mod = (const float*)d_in[4]; p.b_mod = (const float*)d_in[5];
  p.w_in_ab = (const float*)d_in[6]; p.w_out_ab = (const float*)d_in[7]; p.hg_lb = (const float*)d_in[8]; p.hg_ng = (const float*)d_in[9]; p.w_qkv = (const float*)d_in[10];
  p.qn_g = (const float*)d_in[11]; p.kn_g = (const float*)d_in[12]; p.w_out_att = (const float*)d_in[13]; p.w_up = (const float*)d_in[14]; p.conv_w = (const float*)d_in[15];
  p.conv_b = (const float*)d_in[16]; p.w_down = (const float*)d_in[17]; p.fn_g = (const float*)d_in[18];
  p.out = (float*)d_out; p.ws = (unsigned char*)d_ws;
#if MULTI
  hipLaunchKernelGGL(k_phase, dim3(256), dim3(512), LDS_BYTES, stream, p, -1, 0);
  for (int l = 0; l < 4; ++l) for (int ph = 0; ph <= 11; ++ph) { if ((l & 1) && (ph >= 4 && ph <= 6)) continue; hipLaunchKernelGGL(k_phase, dim3(256), dim3(512), LDS_BYTES, stream, p, l, ph); }
  hipLaunchKernelGGL(k_phase, dim3(256), dim3(512), LDS_BYTES, stream, p, 4, 0);
#else
  if (hipMemsetAsync((char*)d_ws + OFF_BAR, 0, 16384, stream) != hipSuccess) { fprintf(stderr, "memset failed\n"); return; }
  void* args[] = {&p};
  hipError_t e = hipLaunchCooperativeKernel((const void*)k_mega, dim3(256), dim3(512), args, LDS_BYTES, stream);
  if (e != hipSuccess) fprintf(stderr, "cooperative launch failed: %s\n", hipGetErrorString(e));
#endif
}
```

```cpp
#include <hip/hip_runtime.h>
#include <hip/hip_bf16.h>
#include <hip/hip_cooperative_groups.h>
#include <cstdio>
namespace cg = cooperative_groups;

#ifndef REP_FILL
#define REP_FILL 1
#endif
#ifndef REP_MASK
#define REP_MASK 0
#endif
#ifndef MULTI
#define MULTI 0
#endif

typedef unsigned short bf16_t;
typedef short bf16x8 __attribute__((ext_vector_type(8)));
typedef short s16x4 __attribute__((ext_vector_type(4)));
typedef float f32x4 __attribute__((ext_vector_type(4)));
typedef float f32x16 __attribute__((ext_vector_type(16)));
typedef unsigned u32x4 __attribute__((ext_vector_type(4)));
typedef unsigned u32x2 __attribute__((ext_vector_type(2)));
typedef _Float16 h16x8 __attribute__((ext_vector_type(8)));

constexpr int NLAT = 32768, NCTX = 2048, NTOK = 34816;
constexpr float EPS = 1e-6f;

constexpr size_t OFF_CTXR = 0;
constexpr size_t OFF_MOD = OFF_CTXR + 8388608;
constexpr size_t OFF_LB = OFF_MOD + 1048576;
constexpr size_t OFF_CM256 = OFF_LB + 8192;
constexpr size_t OFF_HB = OFF_CM256 + 262144;
constexpr size_t OFF_W1 = OFF_HB + 71303168;
constexpr size_t OFF_W2 = OFF_W1 + 7340032;
constexpr size_t OFF_W3 = OFF_W2 + 2097152;
constexpr size_t OFF_W4 = OFF_W3 + 11534336;
constexpr size_t OFF_AL = OFF_W4 + 5767168;
constexpr size_t OFF_GATE = OFF_AL;
constexpr size_t OFF_VAL = OFF_GATE + 196083712;
constexpr size_t OFF_MIX = OFF_AL;
constexpr size_t OFF_MX = OFF_MIX + 71303168;
constexpr size_t OFF_Q = OFF_MX;
constexpr size_t OFF_V = OFF_Q + 35651584;
constexpr size_t OFF_G = OFF_V + 35651584;
constexpr size_t OFF_LF0 = OFF_G + 35651584;
constexpr size_t OFF_LF1 = OFF_LF0 + 35651584;
constexpr size_t OFF_O0 = OFF_LF1 + 35651584;
constexpr size_t OFF_O1 = OFF_O0 + 71303168;
constexpr size_t OFF_ZT = OFF_O0;
constexpr size_t OFF_ZTC = OFF_ZT + 67108864;
constexpr size_t OFF_ZF = OFF_ZTC + 4194304;
constexpr size_t OFF_CM2 = OFF_ZF + 33554432;
constexpr size_t OFF_CM = OFF_CM2;
constexpr size_t OFF_QB = OFF_MX;
constexpr size_t OFF_KB = OFF_QB + 71303168;
constexpr size_t OFF_VB = OFF_KB + 17825792;
constexpr size_t OFF_ST = OFF_O0;
constexpr size_t OFF_DEC = OFF_VAL + 196083712;
constexpr size_t OFF_W4B = OFF_DEC + 2228224;
constexpr size_t OFF_BAR = OFF_W4B + 5767168;
constexpr size_t OFF_ROPE = OFF_BAR + 16384;
constexpr size_t WS_END = OFF_ROPE + 16384;
static_assert(OFF_O1 + 71303168 <= OFF_DEC && OFF_CM2 + 33554432 <= OFF_DEC && OFF_VB + 17825792 <= WS_END, "alias region");

struct P {
  const float *x, *c, *ctx, *c_ctx, *w_mod, *b_mod, *w_in_ab, *w_out_ab, *hg_lb, *hg_ng, *w_qkv, *qn_g, *kn_g, *w_out_att, *w_up, *conv_w, *conv_b, *w_down, *fn_g;
  float* out; unsigned char* ws;
};

typedef __bf16 bf16v2_t __attribute__((ext_vector_type(2)));
typedef float f32v2_t __attribute__((ext_vector_type(2)));
__device__ __forceinline__ unsigned cvt_pk_bf16(float lo, float hi) { const f32v2_t v = {lo, hi}; const bf16v2_t r = __builtin_convertvector(v, bf16v2_t); return __builtin_bit_cast(unsigned, r); }
__device__ __forceinline__ bf16_t f2bf(float f) { return (bf16_t)(cvt_pk_bf16(f, 0.f) & 0xffffu); }
__device__ __forceinline__ float bflo(unsigned w) { return __uint_as_float(w << 16); }
__device__ __forceinline__ float bfhi(unsigned w) { return __uint_as_float(w & 0xffff0000u); }
__device__ __forceinline__ float bf2f(bf16_t v) { return __uint_as_float(((unsigned)v) << 16); }
#define GA __attribute__((address_space(1)))
#define LAS3 __attribute__((address_space(3)))
#define UNPK(w, j) (((j) & 1) ? bfhi((w)[(j) >> 1]) : bflo((w)[(j) >> 1]))
__device__ __forceinline__ float silu_f(float v) { return v * __builtin_amdgcn_rcpf(1.f + __expf(-v)); }
__device__ __forceinline__ float wave_sum(float v) {
#pragma unroll
  for (int o = 32; o > 0; o >>= 1) v += __shfl_xor(v, o);
  return v;
}
__device__ __forceinline__ int tid_() { int t = threadIdx.x; asm volatile("" : "+v"(t)); return t; }
__device__ __forceinline__ int bid_() { int b = blockIdx.x; asm volatile("" : "+s"(b)); return b; }
__device__ __forceinline__ int kvrow(int row) { return row < NLAT ? (row >> 12) * 4352 + (row & 4095) : ((row - NLAT) >> 8) * 4352 + 4096 + ((row - NLAT) & 255); }

#define XB_TMO      128
#define XB_XCNT(j)  (256  + 64 * (j))
#define XB_XSUB(j)  (1280 + 64 * (j))
#define XB_XGEN(j)  (2304 + 64 * (j))
#define XB_TOP      3328
#define XB_TOPGEN   3392
#define XCD_BAR_WORDS 3456
#define XB_SPIN_CAP (1u << 22)
__device__ __forceinline__ unsigned xb_ld(unsigned* p)              { return __hip_atomic_load(p, __ATOMIC_RELAXED, __HIP_MEMORY_SCOPE_AGENT); }
__device__ __forceinline__ unsigned xb_add(unsigned* p, unsigned v) { return __hip_atomic_fetch_add(p, v, __ATOMIC_RELAXED, __HIP_MEMORY_SCOPE_AGENT); }
__device__ __forceinline__ unsigned xb_xcc_id() { return (unsigned)__builtin_amdgcn_s_getreg((3 << 11) | 20) & 0xFu; }
#define XB_SPIN(cond, bar) do { unsigned _sp = 0; while (cond) { __builtin_amdgcn_s_sleep(3); \
    if ((++_sp & 255u) == 0u) { if (xb_ld(&(bar)[XB_TMO])) break; if (_sp > XB_SPIN_CAP) { atomicAdd(&(bar)[XB_TMO], 1u); break; } } } } while (0)
struct XcdBarrier { unsigned* bar; unsigned x; volatile LAS3 unsigned* st; };
__device__ __forceinline__ XcdBarrier xcd_barrier_post(unsigned* bar, volatile LAS3 unsigned* st) {
  XcdBarrier b; b.bar = bar; b.x = xb_xcc_id(); b.st = st;
  if (threadIdx.x == 0) (void)xb_add(&bar[XB_XCNT(b.x)], 1u);
  return b;
}
__device__ __forceinline__ void xcd_barrier_complete(unsigned* bar, unsigned x, unsigned& nloc, unsigned& nx) {
  const unsigned G = gridDim.x * gridDim.y * gridDim.z;
  unsigned sum, cnt, mine, sp = 0u;
  for (;;) {
    sum = 0u; cnt = 0u; mine = 0u;
#pragma unroll
    for (unsigned j = 0; j < 16; ++j) { const unsigned c = xb_ld(&bar[XB_XCNT(j)]); sum += c; cnt += (c > 0u) ? 1u : 0u; mine = (j == x) ? c : mine; }
    if (sum == G) break;
    __builtin_amdgcn_s_sleep(1);
    if ((++sp & 255u) == 0u) { if (xb_ld(&bar[XB_TMO])) break; if (sp > XB_SPIN_CAP) { atomicAdd(&bar[XB_TMO], 1u); break; } }
  }
  nloc = mine > 0u ? mine : 1u; nx = cnt > 0u ? cnt : 1u;
}
__device__ __forceinline__ void xcd_barrier(const XcdBarrier& b) {
  asm volatile("s_waitcnt vmcnt(0)" ::: "memory");
  __syncthreads();
  if (threadIdx.x == 0) {
    unsigned* bar = b.bar; unsigned bx = __builtin_amdgcn_readfirstlane(b.x);
    asm volatile("" : "+s"(bar), "+s"(bx));
    __builtin_amdgcn_s_waitcnt(0);
    unsigned nloc = b.st[0], nx = b.st[1];
    if (nloc == 0u) { xcd_barrier_complete(bar, bx, nloc, nx); b.st[0] = nloc; b.st[1] = nx; }
    const unsigned old = xb_add(&bar[XB_XSUB(bx)], 1u);
    const unsigned gen = old / nloc;
    if (old + 1u == (gen + 1u) * nloc) {
      __builtin_amdgcn_fence(__ATOMIC_RELEASE, "agent");
      asm volatile("s_waitcnt vmcnt(0)" ::: "memory");
      const unsigned og = xb_add(&bar[XB_TOP], 1u);
      const unsigned tg = og / nx;
      if (og + 1u == (tg + 1u) * nx) xb_add(&bar[XB_TOPGEN], 1u);
      else XB_SPIN(xb_ld(&bar[XB_TOPGEN]) == tg, bar);
      __builtin_amdgcn_fence(__ATOMIC_ACQUIRE, "agent");
      xb_add(&bar[XB_XGEN(bx)], 1u);
      asm volatile("s_waitcnt vmcnt(0)" ::: "memory");
    } else {
      XB_SPIN(xb_ld(&bar[XB_XGEN(bx)]) == gen, bar);
      __builtin_amdgcn_fence(__ATOMIC_ACQUIRE, "agent");
      asm volatile("s_waitcnt vmcnt(0)" ::: "memory");
    }
  }
  __syncthreads();
}

namespace pg8 {
#define PG8_LAS __attribute__((address_space(3)))
constexpr int BM = 256, BK = 64, HALF = 128, HTB = HALF * BK * 2, STAGE_BYTES = 8 * HTB, NXCD = 8, WGM = 8;
__device__ __forceinline__ int lds_byte(int r, int c) { const int st = (r >> 4) * 2 + (c >> 5), rr = r & 15, cc = c & 31, ob = rr * 64 + cc * 2; return st * 1024 + (ob ^ (((ob >> 9) & 1) << 5)); }
__device__ __forceinline__ void stage_rc(int b, int& R, int& C) { const int st = b / 1024, sb = b % 1024, swz = sb ^ (((sb >> 9) & 1) << 5); R = (st >> 1) * 16 + swz / 64; C = (st & 1) * 32 + (swz % 64) / 2; }
__device__ __forceinline__ int perm32(int rho) { const int n = rho >> 4, i = rho & 15; return 8 * (i >> 2) + 4 * n + (i & 3); }
struct Unit { int pm, pn, ko; };
struct Gemm { const bf16_t* A; const bf16_t* Bt; int M, N, K, ldk; };
struct StaticOrder {
  int nM, nN, nwg, G, c;
  __device__ void init(int M, int N, int G_, int c_) { nM = M / BM; nN = N / BM; nwg = nM * nN; G = G_; c = c_; }
  __device__ bool next(int i, Unit& u) const {
    const long L = (long)i * G + c; if (L >= nwg) return false;
    int wgid = (int)L; { const int q = nwg / NXCD, r = nwg % NXCD, xcd = wgid % NXCD, off = wgid / NXCD; wgid = (xcd < r ? xcd * (q + 1) : r * (q + 1) + (xcd - r) * q) + off; }
    const int nig = WGM * nN, gid = wgid / nig, fm = gid * WGM, gsz = (nM - fm) < WGM ? (nM - fm) : WGM;
    u.pm = fm + ((wgid % nig) % gsz); u.pn = (wgid % nig) / gsz; u.ko = 0; return true;
  }
};
struct SplitKOrder {
  int nN, ns, nwg, G, c, ksub;
  __device__ void init(int M, int N, int ns_, int ksub_, int G_, int c_) { nN = N / BM; ns = ns_; ksub = ksub_; nwg = (M / BM) * nN * ns; G = G_; c = c_; }
  __device__ bool next(int i, Unit& u) const {
    const int L = i * G + c; if (L >= nwg) return false;
    u.ko = (L % ns) * ksub; u.pn = (L / ns) % nN; u.pm = L / (ns * nN); return true;
  }
};

#ifndef GEMM_SP2
#define GEMM_SP2 1
#endif
#ifndef GEMM_ALIGN
#define GEMM_ALIGN 1
#endif
template <class Epi, class Sched>
__device__ __forceinline__ void gemm_phase(PG8_LAS unsigned char* lds, const Gemm g, const Sched& S, const Epi& E) {
  const int tid = tid_(), wid = __builtin_amdgcn_readfirstlane(tid >> 6), lane = tid & 63, wr = wid >> 2, wc = wid & 3, fr = lane & 15, fq = lane >> 4;
  const int K = g.ldk, nt = g.K / BK;
  unsigned voffA[2], voffB[2];
#pragma unroll
  for (int i = 0; i < 2; ++i) { int R, C; stage_rc(tid * 16 + i * 8192, R, C); const int Rb = Epi::PERM ? ((R & ~31) + perm32(R & 31)) : R;
    voffA[i] = (unsigned)(R * K + C) * 2u; voffB[i] = (unsigned)(Rb * K + C) * 2u; }
  const size_t kstep = (size_t)(BK * 2);
  const size_t hstep = (size_t)HALF * K * 2;
  const size_t tstep = 2 * hstep;
  const unsigned ldsw = (unsigned)wid * 1024u;
  const int aoff = lds_byte(wr * 64 + fr, fq * 8), boff = lds_byte(wc * 32 + fr, fq * 8);
#define PG8_SA(b, h) (((b) * 2 + (h)) * HTB)
#define PG8_SB(b, h) ((4 + (b) * 2 + (h)) * HTB)
#define PG8_STAGE(bufoff, gbase, voff) do { _Pragma("unroll") for (int _i = 0; _i < 2; ++_i) \
    __builtin_amdgcn_global_load_lds((const unsigned*)((const char*)(gbase) + (voff)[_i]), (PG8_LAS unsigned*)(lds + (bufoff) + ldsw + _i * 8192), 16, 0, 0); } while (0)
#define PG8_LDA(dst, b, h) do { _Pragma("unroll") for (int m = 0; m < 4; ++m) _Pragma("unroll") for (int k = 0; k < 2; ++k) dst[m][k] = *(const PG8_LAS bf16x8*)(lds + PG8_SA(b, h) + aoff + m * 2048 + k * 1024); } while (0)
#define PG8_LDB(dst, b, h) do { _Pragma("unroll") for (int n = 0; n < 2; ++n) _Pragma("unroll") for (int k = 0; k < 2; ++k) dst[n][k] = *(const PG8_LAS bf16x8*)(lds + PG8_SB(b, h) + boff + n * 2048 + k * 1024); } while (0)
#define PG8_MMA(ai, bj, At, Bt) do { __builtin_amdgcn_s_setprio(1); _Pragma("unroll") for (int m = 0; m < 4; ++m) _Pragma("unroll") for (int n = 0; n < 2; ++n) _Pragma("unroll") for (int k = 0; k < 2; ++k) \
    acc[ai][bj][m][n] = __builtin_amdgcn_mfma_f32_16x16x32_bf16(Bt[n][k], At[m][k], acc[ai][bj][m][n], 0, 0, 0); __builtin_amdgcn_s_setprio(0); } while (0)
#define PG8_WAIT_V(n) asm volatile("s_waitcnt vmcnt(" #n ")" ::: "memory")
#define PG8_WAIT_L(n) asm volatile("s_waitcnt lgkmcnt(" #n ")" ::: "memory")
#define PG8_BAR __builtin_amdgcn_s_barrier()
#define PG8_SCHED __builtin_amdgcn_sched_barrier(0)
  Unit cur, nxt; int ui = 0;
  if (!S.next(0, cur)) return;
  f32x4 acc[2][2][4][2];
#pragma unroll
  for (int a = 0; a < 2; ++a)
#pragma unroll
    for (int b = 0; b < 2; ++b)
#pragma unroll
      for (int m = 0; m < 4; ++m)
#pragma unroll
        for (int n = 0; n < 2; ++n) acc[a][b][m][n] = (f32x4){0.f, 0.f, 0.f, 0.f};
  bf16x8 At[4][2], B0[2][2], B1[2][2];
  const char* cA = (const char*)g.A + (size_t)cur.pm * tstep + (size_t)cur.ko * 2; const char* cB = (const char*)g.Bt + (size_t)cur.pn * tstep + (size_t)cur.ko * 2;
#if GEMM_SP2
  PG8_STAGE(PG8_SB(0, 0), cB, voffB); PG8_STAGE(PG8_SB(0, 1), cB + hstep, voffB); PG8_STAGE(PG8_SA(0, 0), cA, voffA); PG8_STAGE(PG8_SA(0, 1), cA + hstep, voffA);
  if (wr == 1) PG8_BAR;
  PG8_WAIT_V(2); PG8_BAR;
  PG8_STAGE(PG8_SB(1, 0), cB + kstep, voffB); PG8_STAGE(PG8_SA(1, 0), cA + kstep, voffA); PG8_STAGE(PG8_SB(1, 1), cB + hstep + kstep, voffB);
  PG8_WAIT_V(6); PG8_BAR;
#else
  PG8_STAGE(PG8_SB(0, 0), cB, voffB); PG8_STAGE(PG8_SA(0, 0), cA, voffA); PG8_STAGE(PG8_SB(0, 1), cB + hstep, voffB); PG8_STAGE(PG8_SA(0, 1), cA + hstep, voffA);
  if (wr == 1) PG8_BAR;
  PG8_WAIT_V(4); PG8_BAR;
  PG8_STAGE(PG8_SB(1, 0), cB + kstep, voffB); PG8_STAGE(PG8_SA(1, 0), cA + kstep, voffA); PG8_STAGE(PG8_SB(1, 1), cB + hstep + kstep, voffB);
  PG8_WAIT_V(6); PG8_BAR;
#endif
  for (;;) {
    const bool has_next = S.next(ui + 1, nxt);
    const char* nA = has_next ? (const char*)g.A + (size_t)nxt.pm * tstep + (size_t)nxt.ko * 2 : cA; const char* nB = has_next ? (const char*)g.Bt + (size_t)nxt.pn * tstep + (size_t)nxt.ko * 2 : cB;
    for (int t = 0; t < nt; t += 2) {
      const bool last = (t == nt - 2);
      const char* a1 = cA + (size_t)(t + 1) * kstep;
      const char* a2 = last ? nA : cA + (size_t)(t + 2) * kstep; const char* b2 = last ? nB : cB + (size_t)(t + 2) * kstep;
      const char* a3 = a2 + kstep; const char* b3 = b2 + kstep;
#if GEMM_SP2
      PG8_LDB(B0, 0, 0); PG8_LDB(B1, 0, 1); PG8_SCHED; PG8_LDA(At, 0, 0); PG8_STAGE(PG8_SA(1, 1), a1 + hstep, voffA);
      PG8_WAIT_V(8); PG8_WAIT_L(0); PG8_BAR; PG8_MMA(0, 0, At, B0); PG8_MMA(0, 1, At, B1); PG8_BAR; PG8_SCHED;
      PG8_LDA(At, 0, 1); PG8_STAGE(PG8_SB(0, 0), b2, voffB); PG8_STAGE(PG8_SB(0, 1), b2 + hstep, voffB); PG8_STAGE(PG8_SA(0, 0), a2, voffA);
      PG8_WAIT_V(8); PG8_WAIT_L(0); PG8_BAR; PG8_MMA(1, 0, At, B0); PG8_MMA(1, 1, At, B1); PG8_BAR; PG8_SCHED;
      PG8_LDB(B0, 1, 0); PG8_LDB(B1, 1, 1); PG8_SCHED; PG8_LDA(At, 1, 0); PG8_STAGE(PG8_SA(0, 1), a2 + hstep, voffA);
      PG8_WAIT_V(8); PG8_WAIT_L(0); PG8_BAR; PG8_MMA(0, 0, At, B0); PG8_MMA(0, 1, At, B1); PG8_BAR; PG8_SCHED;
      PG8_LDA(At, 1, 1); PG8_STAGE(PG8_SB(1, 0), b3, voffB); PG8_STAGE(PG8_SB(1, 1), b3 + hstep, voffB); PG8_STAGE(PG8_SA(1, 0), a3, voffA);
      PG8_WAIT_V(8); PG8_WAIT_L(0); PG8_BAR; PG8_MMA(1, 0, At, B0); PG8_MMA(1, 1, At, B1); PG8_BAR; PG8_SCHED;
#else
      PG8_LDB(B0, 0, 0); PG8_SCHED; PG8_LDA(At, 0, 0); PG8_STAGE(PG8_SA(1, 1), a1 + hstep, voffA);
      PG8_WAIT_L(8); PG8_BAR; PG8_WAIT_L(0); PG8_MMA(0, 0, At, B0); PG8_BAR; PG8_SCHED;
      PG8_LDB(B1, 0, 1); PG8_STAGE(PG8_SB(0, 0), b2, voffB);
      PG8_BAR; PG8_WAIT_L(0); PG8_MMA(0, 1, At, B1); PG8_BAR;
      PG8_LDA(At, 0, 1); PG8_STAGE(PG8_SA(0, 0), a2, voffA);
      PG8_BAR; PG8_WAIT_L(0); PG8_MMA(1, 0, At, B0); PG8_BAR; PG8_SCHED;
      PG8_STAGE(PG8_SB(0, 1), b2 + hstep, voffB);
      PG8_WAIT_V(6); PG8_BAR; PG8_MMA(1, 1, At, B1); PG8_BAR;
      PG8_LDB(B0, 1, 0); PG8_SCHED; PG8_LDA(At, 1, 0); PG8_STAGE(PG8_SA(0, 1), a2 + hstep, voffA);
      PG8_WAIT_L(8); PG8_BAR; PG8_WAIT_L(0); PG8_MMA(0, 0, At, B0); PG8_BAR; PG8_SCHED;
      PG8_LDB(B1, 1, 1); PG8_STAGE(PG8_SB(1, 0), b3, voffB);
      PG8_BAR; PG8_WAIT_L(0); PG8_MMA(0, 1, At, B1); PG8_BAR;
      PG8_LDA(At, 1, 1); PG8_STAGE(PG8_SA(1, 0), a3, voffA);
      PG8_BAR; PG8_WAIT_L(0); PG8_MMA(1, 0, At, B0); PG8_BAR; PG8_SCHED;
      PG8_STAGE(PG8_SB(1, 1), b3 + hstep, voffB);
      PG8_WAIT_V(6); PG8_BAR; PG8_MMA(1, 1, At, B1); PG8_BAR;
#endif
    }
#if GEMM_ALIGN
    if (wr == 0) PG8_BAR;
#endif
    E(acc, cur, wr, wc, fr, fq);
    if (!has_next) break;
#pragma unroll
    for (int a = 0; a < 2; ++a)
#pragma unroll
      for (int b = 0; b < 2; ++b)
#pragma unroll
        for (int m = 0; m < 4; ++m)
#pragma unroll
          for (int n = 0; n < 2; ++n) acc[a][b][m][n] = (f32x4){0.f, 0.f, 0.f, 0.f};
    cur = nxt; cA = nA; cB = nB; ++ui;
#if GEMM_ALIGN
    if (wr == 1) PG8_BAR;
#endif
  }
  PG8_WAIT_V(0);
#if !GEMM_ALIGN
  if (wr == 0) PG8_BAR;
#endif
  PG8_BAR;
#undef PG8_SA
#undef PG8_SB
#undef PG8_STAGE
#undef PG8_LDA
#undef PG8_LDB
#undef PG8_MMA
#undef PG8_WAIT_V
#undef PG8_WAIT_L
#undef PG8_BAR
#undef PG8_SCHED
}
}

typedef const f32x4 (&AccRef)[2][2][4][2];
__device__ __forceinline__ u32x4 pack8(f32x4 v0, f32x4 v1) { u32x4 w; w.x = cvt_pk_bf16(v0[0], v0[1]); w.y = cvt_pk_bf16(v0[2], v0[3]); w.z = cvt_pk_bf16(v1[0], v1[1]); w.w = cvt_pk_bf16(v1[2], v1[3]); return w; }

struct EpiZ {
  static constexpr bool PERM = true;
  bf16_t* Z; bf16_t* ZTC;
  __device__ __forceinline__ void operator()(AccRef acc, const pg8::Unit& u, int wr, int wc, int fr, int fq) const {
#pragma unroll
    for (int ai = 0; ai < 2; ++ai)
#pragma unroll
      for (int m = 0; m < 4; ++m) {
        const int row = u.pm * 256 + ai * 128 + wr * 64 + m * 16 + fr;
        if (row < NLAT) {
          bf16_t* dst = Z + (size_t)row * 1024 + u.pn * 256 + wc * 32 + fq * 8;
#pragma unroll
          for (int bj = 0; bj < 2; ++bj) *(u32x4*)(dst + bj * 128) = pack8(acc[ai][bj][m][0], acc[ai][bj][m][1]);
        } else {
          const int rr = row - NLAT; bf16_t* base = ZTC + (size_t)(rr >> 8) * 512 * 512 + (rr & 255);
#pragma unroll
          for (int bj = 0; bj < 2; ++bj)
#pragma unroll
            for (int n = 0; n < 2; ++n)
#pragma unroll
              for (int j = 0; j < 4; ++j) { const int col = u.pn * 256 + bj * 128 + wc * 32 + fq * 8 + n * 4 + j;
                base[(size_t)(col & 511) * 512 + (col >> 9) * 256] = f2bf(acc[ai][bj][m][n][j]); }
        }
      }
  }
};
struct EpiHG {
  static constexpr bool PERM = true;
  bf16_t *Q, *V, *G; _Float16 *LF0, *LF1; const float* LB;
  __device__ __forceinline__ void operator()(AccRef acc, const pg8::Unit& u, int wr, int wc, int fr, int fq) const {
    const int region = u.pn >> 1;
#pragma unroll
    for (int bj = 0; bj < 2; ++bj) {
      const int cl = (u.pn & 1) * 256 + bj * 128 + wc * 32 + fq * 8;
      float lb[8];
      if (region == 1 || region == 2) {
        const f32x4 a = *(const f32x4*)(LB + (region - 1) * 512 + cl), b = *(const f32x4*)(LB + (region - 1) * 512 + cl + 4);
        lb[0] = a[0]; lb[1] = a[1]; lb[2] = a[2]; lb[3] = a[3]; lb[4] = b[0]; lb[5] = b[1]; lb[6] = b[2]; lb[7] = b[3];
      } else {
#pragma unroll
        for (int j = 0; j < 8; ++j) lb[j] = 0.f;
      }
#pragma unroll
      for (int ai = 0; ai < 2; ++ai)
#pragma unroll
        for (int m = 0; m < 4; ++m) {
          const size_t off = (size_t)(u.pm * 256 + ai * 128 + wr * 64 + m * 16 + fr) * 512 + cl;
          f32x4 v0 = acc[ai][bj][m][0], v1 = acc[ai][bj][m][1];
          if (region == 0) {
#pragma unroll
            for (int j = 0; j < 4; ++j) { v0[j] = silu_f(v0[j]); v1[j] = silu_f(v1[j]); }
            *(u32x4*)(Q + off) = pack8(v0, v1);
          } else if (region == 1 || region == 2) {
            h16x8 hv;
#pragma unroll
            for (int j = 0; j < 4; ++j) {
              const float f0 = lb[j] + (1.f - lb[j]) * __builtin_amdgcn_rcpf(1.f + __expf(-v0[j])), f1 = lb[4 + j] + (1.f - lb[4 + j]) * __builtin_amdgcn_rcpf(1.f + __expf(-v1[j]));
              hv[j] = (_Float16)__logf(fmaxf(f0, 1e-30f)); hv[4 + j] = (_Float16)__logf(fmaxf(f1, 1e-30f));
            }
            *(h16x8*)((region == 1 ? LF0 : LF1) + off) = hv;
          } else if (region == 3) { *(u32x4*)(V + off) = pack8(v0, v1); }
          else { *(u32x4*)(G + off) = pack8(v0, v1); }
        }
    }
  }
};
struct EpiAB {
  static constexpr bool PERM = true;
  EpiZ z; EpiHG hg;
  __device__ __forceinline__ void operator()(AccRef acc, const pg8::Unit& u, int wr, int wc, int fr, int fq) const {
    if (u.pn < 4) z(acc, u, wr, wc, fr, fq);
    else { pg8::Unit v = u; v.pn = u.pn - 4; hg(acc, v, wr, wc, fr, fq); }
  }
};
struct EpiQKV {
  static constexpr bool PERM = true;
  bf16_t *QB, *KB, *VB;
  __device__ __forceinline__ void operator()(AccRef acc, const pg8::Unit& u, int wr, int wc, int fr, int fq) const {
#pragma unroll
    for (int ai = 0; ai < 2; ++ai)
#pragma unroll
      for (int m = 0; m < 4; ++m) {
        const int row = u.pm * 256 + ai * 128 + wr * 64 + m * 16 + fr;
        bf16_t* dst;
        if (u.pn < 4) dst = QB + (size_t)row * 1024 + u.pn * 256;
        else dst = (u.pn == 4 ? KB : VB) + (size_t)kvrow(row) * 256;
#pragma unroll
        for (int bj = 0; bj < 2; ++bj) *(u32x4*)(dst + bj * 128 + wc * 32 + fq * 8) = pack8(acc[ai][bj][m][0], acc[ai][bj][m][1]);
      }
  }
};
struct EpiRes {
  static constexpr bool PERM = false;
  float* X; float* CX; const float* gate;
  __device__ __forceinline__ void operator()(AccRef acc, const pg8::Unit& u, int wr, int wc, int fr, int fq) const {
    const int row0 = u.pm * 256;
    const int mr = row0 < NLAT ? (row0 >> 12) : 8;
    const int colb = u.pn * 256 + wc * 32 + fq * 4;
    f32x4 gv[2][2];
#pragma unroll
    for (int bj = 0; bj < 2; ++bj)
#pragma unroll
      for (int n = 0; n < 2; ++n) gv[bj][n] = *(const f32x4*)(gate + (size_t)mr * 6144 + colb + bj * 128 + n * 16);
#pragma unroll
    for (int ai = 0; ai < 2; ++ai)
#pragma unroll
      for (int m = 0; m < 4; ++m) {
        const int row = row0 + ai * 128 + wr * 64 + m * 16 + fr;
        float* dst = (row < NLAT ? X + (size_t)row * 1024 : CX + (size_t)(row - NLAT) * 1024) + colb;
#pragma unroll
        for (int bj = 0; bj < 2; ++bj)
#pragma unroll
          for (int n = 0; n < 2; ++n) { f32x4 xv = *(f32x4*)(dst + bj * 128 + n * 16); xv += gv[bj][n] * acc[ai][bj][m][n]; *(f32x4*)(dst + bj * 128 + n * 16) = xv; }
      }
  }
};
struct EpiPart {
  static constexpr bool PERM = false;
  float* PART; int ksub;
  __device__ __forceinline__ void operator()(AccRef acc, const pg8::Unit& u, int wr, int wc, int fr, int fq) const {
    float* base = PART + (size_t)(u.ko / ksub) * NCTX * 1024 + u.pn * 256 + wc * 32 + fq * 4;
#pragma unroll
    for (int ai = 0; ai < 2; ++ai)
#pragma unroll
      for (int m = 0; m < 4; ++m) {
        float* dst = base + (size_t)(u.pm * 256 + ai * 128 + wr * 64 + m * 16 + fr) * 1024;
#pragma unroll
        for (int bj = 0; bj < 2; ++bj)
#pragma unroll
          for (int n = 0; n < 2; ++n) *(f32x4*)(dst + bj * 128 + n * 16) = acc[ai][bj][m][n];
      }
  }
};
struct EpiUp {
  static constexpr bool PERM = true;
  bf16_t *GATE, *VAL;
  __device__ __forceinline__ void operator()(AccRef acc, const pg8::Unit& u, int wr, int wc, int fr, int fq) const {
    bf16_t* base = (u.pn < 11 ? GATE + u.pn * 256 : VAL + (u.pn - 11) * 256) + wc * 32 + fq * 8;
#pragma unroll
    for (int ai = 0; ai < 2; ++ai)
#pragma unroll
      for (int m = 0; m < 4; ++m) {
        bf16_t* dst = base + (size_t)(u.pm * 256 + ai * 128 + wr * 64 + m * 16 + fr) * 2816;
#pragma unroll
        for (int bj = 0; bj < 2; ++bj) *(u32x4*)(dst + bj * 128) = pack8(acc[ai][bj][m][0], acc[ai][bj][m][1]);
      }
  }
};
struct EpiDFT {
  static constexpr bool PERM = true;
  bf16_t* MIX; int ctxmode;
  __device__ __forceinline__ void operator()(AccRef acc, const pg8::Unit& u, int wr, int wc, int fr, int fq) const {
    const int b = u.pn >> 1;
    const int tok0 = ctxmode ? NLAT + b * 256 : b * 4096 + u.pm * 256;
    bf16_t* base = MIX + (u.pn & 1) * 256 + wc * 32 + fq * 8;
#pragma unroll
    for (int ai = 0; ai < 2; ++ai)
#pragma unroll
      for (int m = 0; m < 4; ++m) {
        bf16_t* dst = base + (size_t)(tok0 + ai * 128 + wr * 64 + m * 16 + fr) * 1024;
#pragma unroll
        for (int bj = 0; bj < 2; ++bj) *(u32x4*)(dst + bj * 128) = pack8(acc[ai][bj][m][0], acc[ai][bj][m][1]);
      }
  }
};
template <class Epi> __device__ __forceinline__ void run_gemm(unsigned char* lds, const bf16_t* A, const bf16_t* Bt, int M, int N, int K, const Epi& E) {
  pg8::Gemm g{A, Bt, M, N, K, K}; pg8::StaticOrder S; S.init(M, N, (int)gridDim.x, bid_());
  pg8::gemm_phase<Epi, pg8::StaticOrder>((PG8_LAS unsigned char*)lds, g, S, E);
}
template <class Epi> __device__ __forceinline__ void run_gemm_splitk(unsigned char* lds, const bf16_t* A, const bf16_t* Bt, int M, int N, int K, int ns, const Epi& E) {
  pg8::Gemm g{A, Bt, M, N, K / ns, K}; pg8::SplitKOrder S; S.init(M, N, ns, K / ns, (int)gridDim.x, bid_());
  pg8::gemm_phase<Epi, pg8::SplitKOrder>((PG8_LAS unsigned char*)lds, g, S, E);
}

namespace att {
constexpr int D = 128, NW = 8, QBLK = 32, KVBLK = 64;
constexpr float SCALE = 0.088388347648318440f;
constexpr float THR = 8.f;
constexpr int LDQ = 1024, LDK = 256, LDO = 1024;
constexpr size_t SHM_V = KVBLK * D * 2, SHM_K = KVBLK * D * 2;
#define KSWZ(row, colB) ((row) * 256 + ((colB) ^ (((row) & 7) << 4)))
#define SBAR() __builtin_amdgcn_sched_barrier(0)
__device__ __forceinline__ int crow(int r, int hi) { return (r & 3) + 8 * (r >> 2) + 4 * hi; }
__device__ __forceinline__ unsigned cvtpk(float lo, float hi) { return cvt_pk_bf16(lo, hi); }
__device__ __forceinline__ void partialSM(f32x16& p0, f32x16& p1, float& m_reg, float& mn, float& alpha) {
  constexpr float C = SCALE * 1.4426950408889634f;
  float pmax = p0[0]; _Pragma("unroll") for (int r = 1; r < 16; ++r) pmax = fmaxf(pmax, p0[r]); _Pragma("unroll") for (int r = 0; r < 16; ++r) pmax = fmaxf(pmax, p1[r]);
  { auto rr = __builtin_amdgcn_permlane32_swap(__float_as_uint(pmax), __float_as_uint(pmax), false, false);
    pmax = fmaxf(__uint_as_float(rr[0]), __uint_as_float(rr[1])); }
  if (__builtin_expect(__all(pmax - m_reg <= THR / SCALE), 1)) { mn = m_reg; alpha = 1.f; }
  else { mn = fmaxf(m_reg, pmax); alpha = __builtin_amdgcn_exp2f((m_reg - mn) * C); m_reg = mn; }
  float mnC = -mn * C;
  _Pragma("unroll") for (int r = 0; r < 16; ++r) p0[r] = fmaf(p0[r], C, mnC); _Pragma("unroll") for (int r = 0; r < 16; ++r) p1[r] = fmaf(p1[r], C, mnC);
  _Pragma("unroll") for (int r = 0; r < 16; ++r) p0[r] = __builtin_amdgcn_exp2f(p0[r]);
}
__device__ __forceinline__ void finishSM(f32x16& p0, f32x16& p1, float alpha, float& l_reg, bf16x8& pa0, bf16x8& pa1, bf16x8& pa2, bf16x8& pa3) {
  _Pragma("unroll") for (int r = 0; r < 16; ++r) p1[r] = __builtin_amdgcn_exp2f(p1[r]);
  float ps = 0; _Pragma("unroll") for (int r = 0; r < 16; ++r) ps += p0[r]; _Pragma("unroll") for (int r = 0; r < 16; ++r) ps += p1[r];
  { auto rr = __builtin_amdgcn_permlane32_swap(__float_as_uint(ps), __float_as_uint(ps), false, false);
    ps = __uint_as_float(rr[0]) + __uint_as_float(rr[1]); }
  l_reg = l_reg * alpha + ps;
#define PK4(Pv, BASE, OUT) do { unsigned a0 = cvtpk(Pv[BASE + 0], Pv[BASE + 1]), a1 = cvtpk(Pv[BASE + 2], Pv[BASE + 3]);   \
    unsigned b0 = cvtpk(Pv[BASE + 4], Pv[BASE + 5]), b1 = cvtpk(Pv[BASE + 6], Pv[BASE + 7]);                              \
    auto r0 = __builtin_amdgcn_permlane32_swap(a0, b0, false, false); auto r1 = __builtin_amdgcn_permlane32_swap(a1, b1, false, false); \
    u32x4 w = {r0[0], r1[0], r0[1], r1[1]}; OUT = *reinterpret_cast<bf16x8*>(&w); } while (0)
  PK4(p0, 0, pa0); PK4(p0, 8, pa1); PK4(p1, 0, pa2); PK4(p1, 8, pa3);
#undef PK4
}
__device__ __forceinline__ void qkt(f32x16& p0, f32x16& p1, const bf16_t* Ks, const bf16x8* qr, int r32, int hi) {
  p0 = f32x16{}; p1 = f32x16{};
  _Pragma("unroll") for (int d0 = 0; d0 < 8; ++d0) { int cb = (d0 * 16 + hi * 8) * 2;
    bf16x8 b0 = *reinterpret_cast<const bf16x8*>((const char*)Ks + KSWZ(r32, cb));
    bf16x8 b1 = *reinterpret_cast<const bf16x8*>((const char*)Ks + KSWZ(32 + r32, cb));
    p0 = __builtin_amdgcn_mfma_f32_32x32x16_bf16(b0, qr[d0], p0, 0, 0, 0);
    p1 = __builtin_amdgcn_mfma_f32_32x32x16_bf16(b1, qr[d0], p1, 0, 0, 0); }
}
__device__ __forceinline__ int v_st(int k, int c) { const int kk = (k & ~0xC) | ((k & 4) << 1) | ((k & 8) >> 1); return ((kk >> 3) * 4 + (c >> 5)) * 512 + ((kk & 7) * 32 + (c & 31)) * 2; }
__device__ __forceinline__ int v_rd_base(int lane) { return ((lane & 3) << 3) | (((lane >> 2) & 3) << 6) | (((lane >> 4) & 1) << 5) | (((lane >> 5) & 1) << 8); }
constexpr int v_rd_off(int d0, int ks, int half) { return d0 * 512 + ks * 4096 + half * 2048; }
template <int OFF> __device__ __forceinline__ s16x4 tr_read(int vb) {
  s16x4 r; asm volatile("ds_read_b64_tr_b16 %0, %1 offset:%2" : "=&v"(r) : "v"(vb), "i"(OFF) : "memory"); return r;
}
template <int D0> __device__ __forceinline__ void pv_one(f32x16& od, int vb, bf16x8 pa0, bf16x8 pa1, bf16x8 pa2, bf16x8 pa3) {
  const s16x4 l0 = tr_read<v_rd_off(D0, 0, 0)>(vb), h0 = tr_read<v_rd_off(D0, 0, 1)>(vb), l1 = tr_read<v_rd_off(D0, 1, 0)>(vb), h1 = tr_read<v_rd_off(D0, 1, 1)>(vb);
  const s16x4 l2 = tr_read<v_rd_off(D0, 2, 0)>(vb), h2 = tr_read<v_rd_off(D0, 2, 1)>(vb), l3 = tr_read<v_rd_off(D0, 3, 0)>(vb), h3 = tr_read<v_rd_off(D0, 3, 1)>(vb);
  asm volatile("s_waitcnt lgkmcnt(0)" ::: "memory"); SBAR();
#define PK(L, H) (bf16x8){L[0], L[1], L[2], L[3], H[0], H[1], H[2], H[3]}
  od = __builtin_amdgcn_mfma_f32_32x32x16_bf16(pa0, PK(l0, h0), od, 0, 0, 0);
  od = __builtin_amdgcn_mfma_f32_32x32x16_bf16(pa1, PK(l1, h1), od, 0, 0, 0);
  od = __builtin_amdgcn_mfma_f32_32x32x16_bf16(pa2, PK(l2, h2), od, 0, 0, 0);
  od = __builtin_amdgcn_mfma_f32_32x32x16_bf16(pa3, PK(l3, h3), od, 0, 0, 0);
#undef PK
}
__device__ __forceinline__ void pv_d0(f32x16* o, int vb, bf16x8 pa0, bf16x8 pa1, bf16x8 pa2, bf16x8 pa3) {
  pv_one<0>(o[0], vb, pa0, pa1, pa2, pa3); pv_one<1>(o[1], vb, pa0, pa1, pa2, pa3); pv_one<2>(o[2], vb, pa0, pa1, pa2, pa3); pv_one<3>(o[3], vb, pa0, pa1, pa2, pa3);
}
__device__ __forceinline__ void attn_dense_body(const bf16_t* __restrict__ Qb, const bf16_t* __restrict__ Kh, const bf16_t* __restrict__ Vh,
                                                bf16_t* __restrict__ Ob, int seq, char* lds) {
  const int tid = tid_(), wid = tid >> 6, lane = tid & 63, r32 = lane & 31, hi = lane >> 5;
  bf16_t* V_lds = (bf16_t*)lds; bf16_t* K_lds = (bf16_t*)(lds + 2 * SHM_V);
  float* ws = (float*)(lds + 2 * SHM_V + 2 * SHM_K) + wid * 64; float* li_l = ws; float* al_l = ws + 32;
  float m_reg = -1e30f, l_reg = 0; f32x16 o[4] = {}; bf16x8 qr[8];
  const bf16_t* Qw = Qb + (long)(wid * QBLK + r32) * LDQ + hi * 8;
_Pragma("unroll") for (int d0 = 0; d0 < 8; ++d0) qr[d0] = *reinterpret_cast<const bf16x8*>(Qw + d0 * 16);
  const int sr = tid >> 4, sc = (tid & 15) * 8, vst0 = v_st(sr, sc), vst1 = v_st(32 + sr, sc);
  const int vb0 = (int)(uintptr_t)V_lds + v_rd_base(lane);
  struct { bf16x8 vs0, vs1, ks0, ks1; } sr_[2];
#define SLOAD(i, k0) do { sr_[i].vs0 = *(const bf16x8*)(&Vh[(long)((k0) + sr) * LDK + sc]); sr_[i].vs1 = *(const bf16x8*)(&Vh[(long)((k0) + 32 + sr) * LDK + sc]); \
    sr_[i].ks0 = *(const bf16x8*)(&Kh[(long)((k0) + sr) * LDK + sc]); sr_[i].ks1 = *(const bf16x8*)(&Kh[(long)((k0) + 32 + sr) * LDK + sc]); } while (0)
#define SWRITE(b, i) do { *(bf16x8*)((char*)V_lds + (b) * SHM_V + vst0) = sr_[i].vs0;          \
    *(bf16x8*)((char*)V_lds + (b) * SHM_V + vst1) = sr_[i].vs1; int kc = sc * 2;               \
    *(bf16x8*)((char*)K_lds + (b) * SHM_K + KSWZ(sr, kc)) = sr_[i].ks0;                       \
    *(bf16x8*)((char*)K_lds + (b) * SHM_K + KSWZ(32 + sr, kc)) = sr_[i].ks1; } while (0)
#define SWAIT() asm volatile("s_waitcnt vmcnt(4)" ::: "memory")
#define RESC(a) do { if (__any((a) < 1.f)) { if (hi == 0) al_l[r32] = (a); asm volatile("s_waitcnt lgkmcnt(0)" ::: "memory"); \
    _Pragma("unroll") for (int d = 0; d < 4; ++d) _Pragma("unroll") for (int r = 0; r < 16; ++r) o[d][r] *= al_l[crow(r, hi)]; } } while (0)
  f32x16 pA0, pA1, pB0, pB1; float mnA, mnB, alA, alB; bf16x8 pa0, pa1, pa2, pa3; const int NT = seq / KVBLK;
  constexpr int SE = 0, SO = 1;
  SLOAD(SE, 0); asm volatile("s_waitcnt vmcnt(0)" ::: "memory"); SWRITE(0, SE); __syncthreads();
  qkt(pA0, pA1, K_lds, qr, r32, hi); partialSM(pA0, pA1, m_reg, mnA, alA);
  SLOAD(SO, KVBLK); if (2 < NT) SLOAD(SE, 2 * KVBLK);
  SWAIT(); SWRITE(1, SO); __syncthreads();
  for (int j = 1; j + 1 < NT; j += 2) {
    SBAR(); qkt(pB0, pB1, (bf16_t*)((char*)K_lds + SHM_K), qr, r32, hi);
    finishSM(pA0, pA1, alA, l_reg, pa0, pa1, pa2, pa3); SBAR();
    SLOAD(SO, (j + 2) * KVBLK); SBAR();
    pv_d0(o, vb0, pa0, pa1, pa2, pa3); partialSM(pB0, pB1, m_reg, mnB, alB);
    __syncthreads(); SWAIT(); SWRITE(0, SE);
    RESC(alB); __syncthreads();
    SBAR(); qkt(pA0, pA1, K_lds, qr, r32, hi);
    finishSM(pB0, pB1, alB, l_reg, pa0, pa1, pa2, pa3); SBAR();
    if (j + 3 < NT) SLOAD(SE, (j + 3) * KVBLK); SBAR();
    pv_d0(o, vb0 + (int)SHM_V, pa0, pa1, pa2, pa3); partialSM(pA0, pA1, m_reg, mnA, alA);
    __syncthreads(); SWAIT(); SWRITE(1, SO);
    RESC(alA); __syncthreads();
  }
  SBAR(); qkt(pB0, pB1, (bf16_t*)((char*)K_lds + SHM_K), qr, r32, hi);
  finishSM(pA0, pA1, alA, l_reg, pa0, pa1, pa2, pa3); SBAR();
  pv_d0(o, vb0, pa0, pa1, pa2, pa3); partialSM(pB0, pB1, m_reg, mnB, alB);
  __syncthreads(); RESC(alB);
  finishSM(pB0, pB1, alB, l_reg, pa0, pa1, pa2, pa3); SBAR();
  pv_d0(o, vb0 + (int)SHM_V, pa0, pa1, pa2, pa3);
  if (hi == 0) li_l[r32] = l_reg; asm volatile("s_waitcnt lgkmcnt(0)" ::: "memory");
  float rli[16];
_Pragma("unroll") for (int r = 0; r < 16; ++r) rli[r] = __builtin_amdgcn_rcpf(li_l[crow(r, hi)]);
  bf16_t* Ow = Ob + (long)(wid * QBLK) * LDO;
_Pragma("unroll") for (int r = 0; r < 16; ++r) { int orow = crow(r, hi);
    _Pragma("unroll") for (int d0 = 0; d0 < 4; ++d0) Ow[(long)orow * LDO + d0 * 32 + r32] = f2bf(o[d0][r] * rli[r]); }
#undef SLOAD
#undef SWRITE
#undef SWAIT
#undef RESC
}
}

__device__ __forceinline__ void ph0(const P& p, unsigned char* lds) {
  const int tid = tid_();
  float* MOD = (float*)(p.ws + OFF_MOD);
  float* sc = (float*)lds;
  float* red = sc + 9 * 1024;
  for (int i = tid; i < 9 * 1024; i += 512) { const int r = i >> 10, k = i & 1023; const float v = r < 8 ? p.c[r * 1024 + k] : p.c_ctx[k]; sc[i] = v / (1.f + expf(-v)); }
  __syncthreads();
  const int ng = tid & 31, kg = tid >> 5;
  for (int it = bid_(); it < 4 * 48; it += gridDim.x) {
    const int l = it / 48, nb = (it % 48) * 128;
    const float* w = p.w_mod + ((size_t)l * 1024 + kg * 64) * 6144 + nb + ng * 4;
    float acc[9][4];
#pragma unroll
    for (int r = 0; r < 9; ++r) { acc[r][0] = 0.f; acc[r][1] = 0.f; acc[r][2] = 0.f; acc[r][3] = 0.f; }
#pragma unroll 4
    for (int k = 0; k < 64; ++k) {
      const f32x4 wv = *(const f32x4*)(w + (size_t)k * 6144);
#pragma unroll
      for (int r = 0; r < 9; ++r) { const float s = sc[r * 1024 + kg * 64 + k]; acc[r][0] += s * wv[0]; acc[r][1] += s * wv[1]; acc[r][2] += s * wv[2]; acc[r][3] += s * wv[3]; }
    }
#pragma unroll
    for (int r = 0; r < 9; ++r) { float* d = red + (kg * 9 + r) * 128 + ng * 4; d[0] = acc[r][0]; d[1] = acc[r][1]; d[2] = acc[r][2]; d[3] = acc[r][3]; }
    __syncthreads();
    for (int o = tid; o < 9 * 128; o += 512) { const int r = o >> 7, n = o & 127; float s = 0.f;
      for (int g = 0; g < 16; ++g) s += red[(g * 9 + r) * 128 + n];
      MOD[(size_t)(l * 9 + r) * 6144 + nb + n] = s + p.b_mod[l * 6144 + nb + n]; }
    __syncthreads();
  }
  const int gtid = bid_() * 512 + tid, gsz = gridDim.x * 512;
  float* LB = (float*)(p.ws + OFF_LB);
  for (int i = gtid; i < 1024; i += gsz) { const float a0 = p.hg_lb[i], a1 = p.hg_lb[1024 + i]; LB[i] = 0.f; LB[1024 + i] = 1.f / (1.f + expf(a0 - a1)); }
  { float* ROPE = (float*)(p.ws + OFF_ROPE);
    for (int i = gtid; i < 64 * 32; i += gsz) { const int pos = i >> 5, j = i & 31; const float fr = exp2f(-(float)j * (13.287712379549449f / 32.f)); float sn, cs; sincosf((float)pos * fr, &sn, &cs); ROPE[2 * i] = cs; ROPE[2 * i + 1] = sn; } }
  bf16_t* CM256 = (bf16_t*)(p.ws + OFF_CM256);
  for (int i = gtid; i < 256 * 256; i += gsz) { const int k = i >> 8, j = i & 255; float s, c; sincospif((float)((k * j) & 255) * (1.f / 128.f), &s, &c);
    CM256[k * 512 + j] = f2bf(c * 0.0625f); CM256[k * 512 + 256 + j] = f2bf(-s * 0.0625f); }
}

__device__ __forceinline__ void modulate_rows(const P& p, int l, int which, int nrows, bool first, const float* fixP, const float* fixG) {
  const int tid = tid_(), wave = tid >> 6, lane = tid & 63;
  const GA float* MOD = (const GA float*)(p.ws + OFF_MOD);
  GA float* CX = (GA float*)(p.ws + OFF_CTXR);
  GA bf16_t* HB = (GA bf16_t*)(p.ws + OFF_HB);
  for (int row0 = bid_() * 16 + wave; row0 < nrows; row0 += gridDim.x * 16) {
    const bool lat = row0 < NLAT;
    const GA float* src = (const GA float*)(first ? (lat ? p.x + (size_t)row0 * 1024 : p.ctx + (size_t)(row0 - NLAT) * 1024) : (lat ? p.out + (size_t)row0 * 1024 : (float*)CX + (size_t)(row0 - NLAT) * 1024));
    f32x4 v[2][4]; float ss0 = 0.f, ss1 = 0.f;
#pragma unroll
    for (int j = 0; j < 4; ++j) { v[0][j] = *(const GA f32x4*)(src + j * 256 + lane * 4); v[1][j] = *(const GA f32x4*)(src + 8 * 1024 + j * 256 + lane * 4); }
    if (!lat && fixP) {
      const GA float* P0 = (const GA float*)fixP + (size_t)(row0 - NLAT) * 1024; const GA float* G0 = (const GA float*)fixG; GA float* xw = CX + (size_t)(row0 - NLAT) * 1024;
#pragma unroll
      for (int j = 0; j < 4; ++j) { const int col = j * 256 + lane * 4; const f32x4 g4 = *(const GA f32x4*)(G0 + col);
        v[0][j] += g4 * (*(const GA f32x4*)(P0 + col) + *(const GA f32x4*)(P0 + (size_t)NCTX * 1024 + col));
        v[1][j] += g4 * (*(const GA f32x4*)(P0 + 8 * 1024 + col) + *(const GA f32x4*)(P0 + (size_t)NCTX * 1024 + 8 * 1024 + col));
        *(GA f32x4*)(xw + col) = v[0][j]; *(GA f32x4*)(xw + 8 * 1024 + col) = v[1][j]; }
    }
    const GA float* sh = MOD + (size_t)(l * 9 + (lat ? (row0 >> 12) : 8)) * 6144 + (which ? 3072 : 0);
    f32x4 s4[4], c4[4];
#pragma unroll
    for (int j = 0; j < 4; ++j) { s4[j] = *(const GA f32x4*)(sh + j * 256 + lane * 4); c4[j] = *(const GA f32x4*)(sh + 1024 + j * 256 + lane * 4); }
#pragma unroll
    for (int j = 0; j < 4; ++j) { ss0 += v[0][j][0] * v[0][j][0] + v[0][j][1] * v[0][j][1] + v[0][j][2] * v[0][j][2] + v[0][j][3] * v[0][j][3];
      ss1 += v[1][j][0] * v[1][j][0] + v[1][j][1] * v[1][j][1] + v[1][j][2] * v[1][j][2] + v[1][j][3] * v[1][j][3]; }
    ss0 = wave_sum(ss0); ss1 = wave_sum(ss1);
    const float rs0 = rsqrtf(ss0 * (1.f / 1024.f) + EPS), rs1 = rsqrtf(ss1 * (1.f / 1024.f) + EPS);
    if (first) { GA float* dst = (GA float*)(lat ? p.out + (size_t)row0 * 1024 : (float*)CX + (size_t)(row0 - NLAT) * 1024);
#pragma unroll
      for (int j = 0; j < 4; ++j) { *(GA f32x4*)(dst + j * 256 + lane * 4) = v[0][j]; *(GA f32x4*)(dst + 8 * 1024 + j * 256 + lane * 4) = v[1][j]; } }
#pragma unroll
    for (int j = 0; j < 4; ++j) { const int col = j * 256 + lane * 4;
      f32x4 h0, h1; for (int q = 0; q < 4; ++q) { h0[q] = v[0][j][q] * rs0 * (1.f + c4[j][q]) + s4[j][q]; h1[q] = v[1][j][q] * rs1 * (1.f + c4[j][q]) + s4[j][q]; }
      u32x2 w0, w1; w0.x = cvt_pk_bf16(h0[0], h0[1]); w0.y = cvt_pk_bf16(h0[2], h0[3]); w1.x = cvt_pk_bf16(h1[0], h1[1]); w1.y = cvt_pk_bf16(h1[2], h1[3]);
      *(GA u32x2*)(HB + (size_t)row0 * 1024 + col) = w0; *(GA u32x2*)(HB + (size_t)(row0 + 8) * 1024 + col) = w1; }
  }
}

__device__ __forceinline__ void convert_weights(const P& p, int l, unsigned char* lds, int wg, int nwg, int jlo = 0, int jhi = 4) {
  float* tile = (float*)lds;
  const int tid = tid_(), e = l >> 1; const bool even = !(l & 1);
  bf16_t* W1 = (bf16_t*)(p.ws + OFF_W1); bf16_t* W2 = (bf16_t*)(p.ws + OFF_W2); bf16_t* W3 = (bf16_t*)(p.ws + OFF_W3); bf16_t* W4 = (bf16_t*)(p.ws + ((l & 1) ? OFF_W4B : OFF_W4));
  if (wg < 0) return;
  int base = 0;
#pragma unroll 1
  for (int j = jlo; j < jhi; ++j) {
    const float* W; int K, N, ldw; bf16_t* Wt;
    if (j == 0) { if (even) { W = p.w_in_ab + (size_t)e * 1024 * 3072 + 512; K = 1024; N = 2560; ldw = 3072; Wt = W1 + 1024 * 1024; } else { W = p.w_qkv + (size_t)e * 1024 * 1536; K = 1024; N = 1536; ldw = 1536; Wt = W1; } }
    else if (j == 1) { W = (even ? p.w_out_ab : p.w_out_att) + (size_t)e * 1024 * 1024; K = 1024; N = 1024; ldw = 1024; Wt = W2; }
    else if (j == 2) { W = p.w_up + (size_t)l * 1024 * 5632; K = 1024; N = 5632; ldw = 5632; Wt = W3; }
    else { W = p.w_down + (size_t)l * 2816 * 1024; K = 2816; N = 1024; ldw = 1024; Wt = W4; }
    const int tn = N / 64, nt = (K / 64) * tn;
    int t0 = (wg - base) % nwg; if (t0 < 0) t0 += nwg;
    for (int t = t0; t < nt; t += nwg) {
      const int k0 = (t / tn) * 64, n0 = (t % tn) * 64;
#pragma unroll
      for (int i = 0; i < 2; ++i) { const int idx = tid + i * 512, kr = idx >> 4, nc = (idx & 15) * 4;
        const f32x4 v = *(const f32x4*)(W + (size_t)(k0 + kr) * ldw + n0 + nc);
        tile[kr * 65 + nc] = v[0]; tile[kr * 65 + nc + 1] = v[1]; tile[kr * 65 + nc + 2] = v[2]; tile[kr * 65 + nc + 3] = v[3]; }
      __syncthreads();
      { const int n = tid >> 3, kg = (tid & 7) * 8; u32x4 w;
        w.x = cvt_pk_bf16(tile[(kg + 0) * 65 + n], tile[(kg + 1) * 65 + n]); w.y = cvt_pk_bf16(tile[(kg + 2) * 65 + n], tile[(kg + 3) * 65 + n]);
        w.z = cvt_pk_bf16(tile[(kg + 4) * 65 + n], tile[(kg + 5) * 65 + n]); w.w = cvt_pk_bf16(tile[(kg + 6) * 65 + n], tile[(kg + 7) * 65 + n]);
        *(u32x4*)(Wt + (size_t)(n0 + n) * K + k0 + kg) = w; }
      __syncthreads();
    }
    base = (base + nt) % nwg;
  }
}

__device__ __forceinline__ void fold_dft(const P& p, int e, unsigned char* lds, int wg, int nwg) {
  LAS3 float* wt = (LAS3 float*)lds;
  LAS3 float* tc = wt + 16 * 129; LAS3 float* ts = tc + 128;
  const int tid = tid_();
  GA bf16_t* W1 = (GA bf16_t*)(p.ws + OFF_W1);
  const GA float* Wa = (const GA float*)(p.w_in_ab + (size_t)e * 1024 * 3072);
  __syncthreads();
  if (tid < 128) { float s, c; sincospif((float)tid * (1.f / 64.f), &s, &c); tc[tid] = c * 0.08838834764831845f; ts[tid] = s * 0.08838834764831845f; }
  for (int t = wg < 0 ? 256 : wg; t < 256; t += nwg) {
    const int kk0 = (t >> 2) * 16, g = t & 3;
    __syncthreads();
    for (int i = tid; i < 16 * 128; i += 512) { const int r = i >> 7, c = i & 127; wt[r * 129 + c] = Wa[(size_t)(kk0 + r) * 3072 + g * 128 + c]; }
    __syncthreads();
    const int kk = tid & 15, mw = tid >> 4;
    float ac[4], as[4];
#pragma unroll
    for (int i = 0; i < 4; ++i) { ac[i] = 0.f; as[i] = 0.f; }
    for (int c = 0; c < 128; ++c) { const float w = wt[kk * 129 + c];
#pragma unroll
      for (int i = 0; i < 4; ++i) { const int idx = (c * (mw + 32 * i)) & 127; ac[i] += w * tc[idx]; as[i] += w * ts[idx]; } }
#pragma unroll
    for (int i = 0; i < 4; ++i) { const int m = mw + 32 * i;
      W1[(size_t)(g * 128 + m) * 1024 + kk0 + kk] = f2bf(ac[i]); W1[(size_t)(512 + g * 128 + m) * 1024 + kk0 + kk] = f2bf(as[i]); }
  }
  __syncthreads();
}
__device__ __forceinline__ void gen_cm(const P& p, unsigned char* lds) {
  LAS3 bf16_t* tcos = (LAS3 bf16_t*)lds; LAS3 bf16_t* tsin = tcos + 4096;
  const int tid = tid_();
  __syncthreads();
  for (int j = tid; j < 4096; j += 512) { float s, c; sincospif((float)j * (1.f / 2048.f), &s, &c); tcos[j] = f2bf(c * 0.015625f); tsin[j] = f2bf(-s * 0.015625f); }
  __syncthreads();
  GA bf16_t* CM2 = (GA bf16_t*)(p.ws + OFF_CM2);
  const int gsz = gridDim.x * 512;
  for (int it = bid_() * 512 + tid; it < 4096 * 512; it += gsz) {
    const int k = it >> 9, j0 = (it & 511) * 8; unsigned w[4];
    const bool sinp = j0 >= 2048; const int jb = sinp ? j0 - 2048 : j0;
#pragma unroll
    for (int j = 0; j < 4; ++j) { const int i0 = (k * (jb + 2 * j)) & 4095, i1 = (i0 + k) & 4095;
      unsigned lo = sinp ? (unsigned)tsin[i0] : (unsigned)tcos[i0]; const unsigned hi = sinp ? (unsigned)tsin[i1] : (unsigned)tcos[i1];
      if (j == 0 && j0 == 2048) lo = (unsigned)tcos[(k * 2048) & 4095];
      w[j] = lo | (hi << 16); }
    u32x4 wv = {w[0], w[1], w[2], w[3]};
    *(GA u32x4*)(CM2 + (size_t)k * 4096 + j0) = wv;
  }
  __syncthreads();
}
__device__ __forceinline__ void ph_fold(const P& p, unsigned char* lds) {
  LAS3 bf16_t* T = (LAS3 bf16_t*)lds;
  const int tid = tid_();
  const GA bf16_t* Z = (const GA bf16_t*)(p.ws + OFF_ZT); GA bf16_t* ZF = (GA bf16_t*)(p.ws + OFF_ZF);
  const int tl = tid >> 3, mg = (tid & 7) * 8;
  const int mo = tid >> 3, tg = (tid & 7) * 8;
  for (int it = bid_(); it < 4096; it += gridDim.x) {
    const int part = it & 1, mt = (it >> 1) & 7, tt = (it >> 4) & 31, b = it >> 9;
    const int t = tt * 64 + tl, m0 = mt * 64;
    const GA bf16_t* zb = Z + (size_t)b * 4096 * 1024 + part * 512 + m0 + mg;
    u32x4 A = *(const GA u32x4*)(zb + (size_t)t * 1024);
    const u32x4 Bm = *(const GA u32x4*)(zb + (size_t)((4096 - t) & 4095) * 1024);
    if (part == 1 && t == 0) A = *(const GA u32x4*)(Z + ((size_t)b * 4096 + 2048) * 1024 + m0 + mg);
    unsigned o[4];
#pragma unroll
    for (int q = 0; q < 4; ++q) {
      float lo = bflo(A[q]), hi = bfhi(A[q]);
      if (t != 0) { if (part == 0) { lo += bflo(Bm[q]); hi += bfhi(Bm[q]); } else { lo -= bflo(Bm[q]); hi -= bfhi(Bm[q]); } }
      o[q] = cvt_pk_bf16(lo, hi);
    }
    __syncthreads();
#pragma unroll
    for (int q = 0; q < 4; ++q) *(LAS3 unsigned*)(T + tl * 66 + mg + 2 * q) = o[q];
    __syncthreads();
    unsigned w[4];
#pragma unroll
    for (int q = 0; q < 4; ++q) w[q] = (unsigned)T[(tg + 2 * q) * 66 + mo] | ((unsigned)T[(tg + 2 * q + 1) * 66 + mo] << 16);
    u32x4 wv = {w[0], w[1], w[2], w[3]};
    *(GA u32x4*)(ZF + ((size_t)b * 512 + m0 + mo) * 4096 + part * 2048 + tt * 64 + tg) = wv;
  }
  __syncthreads();
}

__device__ __forceinline__ int tcidx(int tb, int dir) { return dir ? (tb < 4 ? 3 - tb : 71 - tb) : tb; }
__device__ __forceinline__ int rowbase_of(int b, int tb) { return tb < 4 ? NLAT + b * 256 + tb * 64 : b * 4096 + (tb - 4) * 64; }
__device__ __forceinline__ void chunk_cumsum(const GA _Float16* LFc, int rowbase, int dir, int tq, int kch, LAS3 float* totl, float (&lf)[16], float (&bc)[16], float& T0, float& T1, float& T2, float& T3) {
#pragma unroll
  for (int i = 0; i < 16; ++i) { const int tau = 16 * tq + i, pp = dir ? 63 - tau : tau; lf[i] = (float)LFc[(size_t)(rowbase + pp) * 512]; }
  float run = 0.f;
#pragma unroll
  for (int i = 0; i < 16; ++i) { run += lf[i]; bc[i] = run; }
  totl[tq * 128 + kch] = run;
  __syncthreads();
  T0 = totl[kch]; T1 = totl[128 + kch]; T2 = totl[256 + kch]; T3 = totl[384 + kch];
  const float off = tq == 0 ? 0.f : (tq == 1 ? T0 : (tq == 2 ? T0 + T1 : T0 + T1 + T2));
#pragma unroll
  for (int i = 0; i < 16; ++i) bc[i] += off;
}
typedef unsigned short us2_t __attribute__((ext_vector_type(2)));
#define US2U(v) __builtin_bit_cast(unsigned, v)
__device__ __forceinline__ void ld16(unsigned& r, const bf16_t* sbase, unsigned voff) { asm volatile("global_load_ushort %0, %1, %2" : "=v"(r) : "v"(voff), "s"(sbase)); }
#define RAW_WAIT16(a) asm volatile("s_waitcnt vmcnt(0)" : "+v"(a[0]), "+v"(a[1]), "+v"(a[2]), "+v"(a[3]), "+v"(a[4]), "+v"(a[5]), "+v"(a[6]), "+v"(a[7]), \
    "+v"(a[8]), "+v"(a[9]), "+v"(a[10]), "+v"(a[11]), "+v"(a[12]), "+v"(a[13]), "+v"(a[14]), "+v"(a[15]) :: "memory")
__device__ __forceinline__ void pack2(const unsigned (&r)[16], us2_t (&pk)[8]) {
#pragma unroll
  for (int i = 0; i < 8; ++i) { pk[i].x = (unsigned short)r[2 * i]; pk[i].y = (unsigned short)r[2 * i + 1]; }
}
__device__ __forceinline__ void h1_load_raw(const P& p, int rowbase, int h, int dir, int tq, int kch, unsigned (&lfr)[16], unsigned (&vr)[16]) {
  const bf16_t* LFb = (const bf16_t*)(p.ws + (dir ? OFF_LF1 : OFF_LF0)) + (size_t)rowbase * 512 + h * 128;
  const bf16_t* Vb = (const bf16_t*)(p.ws + OFF_V) + (size_t)rowbase * 512 + h * 128;
#pragma unroll
  for (int i = 0; i < 16; ++i) { const int tau = 16 * tq + i, pp = dir ? 63 - tau : tau; const unsigned o0 = (unsigned)(pp * 1024 + kch * 2); ld16(lfr[i], LFb, o0); ld16(vr[i], Vb, o0); }
}
__device__ __forceinline__ void h3_load_raw(const P& p, int rowbase, int h, int dir, int tq, int kch, unsigned (&lfr)[16], unsigned (&qr)[16]) {
  const bf16_t* LFb = (const bf16_t*)(p.ws + (dir ? OFF_LF1 : OFF_LF0)) + (size_t)rowbase * 512 + h * 128;
  const bf16_t* Qb = (const bf16_t*)(p.ws + OFF_Q) + (size_t)rowbase * 512 + h * 128;
#pragma unroll
  for (int i = 0; i < 16; ++i) { const int tau = 16 * tq + i, pp = dir ? 63 - tau : tau; const unsigned o0 = (unsigned)(pp * 1024 + kch * 2); ld16(lfr[i], LFb, o0); ld16(qr[i], Qb, o0); }
}
__device__ __forceinline__ void h_load_raw(const P& p, int rowbase, int h, int dir, int tq, int kch, bool needq, us2_t (&lfr)[8], us2_t (&vr)[8], us2_t (&qr)[8]) {
  const GA bf16_t* LFc = (const GA bf16_t*)(p.ws + (dir ? OFF_LF1 : OFF_LF0)) + h * 128 + kch;
  const GA bf16_t* V = (const GA bf16_t*)(p.ws + OFF_V) + h * 128 + kch; const GA bf16_t* Q = (const GA bf16_t*)(p.ws + OFF_Q) + h * 128 + kch;
#pragma unroll
  for (int i = 0; i < 8; ++i) { const int tau = 16 * tq + 2 * i, p0 = dir ? 63 - tau : tau, p1 = dir ? p0 - 1 : p0 + 1; const size_t g0 = (size_t)(rowbase + p0) * 512, g1 = (size_t)(rowbase + p1) * 512;
    lfr[i].x = LFc[g0]; lfr[i].y = LFc[g1]; vr[i].x = V[g0]; vr[i].y = V[g1]; if (needq) { qr[i].x = Q[g0]; qr[i].y = Q[g1]; } }
}
__device__ __forceinline__ float h16bits(unsigned short w) { return (float)__builtin_bit_cast(_Float16, w); }
__device__ __forceinline__ void chunk_cumsum_raw(const us2_t (&lfr)[8], int tq, int kch, LAS3 float* totl, float (&lf)[16], float (&bc)[16], float& T0, float& T1, float& T2, float& T3) {
  float run = 0.f;
#pragma unroll
  for (int i = 0; i < 16; ++i) { lf[i] = h16bits((i & 1) ? lfr[i >> 1].y : lfr[i >> 1].x); run += lf[i]; bc[i] = run; }
  totl[tq * 128 + kch] = run;
  __syncthreads();
  T0 = totl[kch]; T1 = totl[128 + kch]; T2 = totl[256 + kch]; T3 = totl[384 + kch];
  const float off = tq == 0 ? 0.f : (tq == 1 ? T0 : (tq == 2 ? T0 + T1 : T0 + T1 + T2));
#pragma unroll
  for (int i = 0; i < 16; ++i) bc[i] += off;
}
__device__ __forceinline__ void ph_h1(const P& p, unsigned char* lds) {
  const int tid = tid_(), wid = tid >> 6, lane = tid & 63, r32 = lane & 31, hi = lane >> 5, kch = tid & 127, tq = tid >> 7;
  LAS3 bf16_t* KD = (LAS3 bf16_t*)lds;
  LAS3 bf16_t* VT = KD + 128 * 72;
  LAS3 float* totl = (LAS3 float*)(VT + 128 * 72);
  const GA bf16_t* V = (const GA bf16_t*)(p.ws + OFF_V);
  GA bf16_t* ST = (GA bf16_t*)(p.ws + OFF_ST); GA float* DEC = (GA float*)(p.ws + OFF_DEC);
  const int ti = wid >> 1;
  const int GS = gridDim.x;
  us2_t lfA[8], vv[8]; unsigned lfN[16], vN[16];
  { const int it0 = bid_(); if (it0 < 4352) { const int rest = it0 >> 3; h1_load_raw(p, rowbase_of(rest / 68, rest % 68), (it0 >> 1) & 3, it0 & 1, tq, kch, lfN, vN); RAW_WAIT16(lfN); RAW_WAIT16(vN); pack2(lfN, lfA); pack2(vN, vv); } }
  for (int it = bid_(); it < 4352; it += GS) {
    const int dir = it & 1, h = (it >> 1) & 3, rest = it >> 3, tb = rest % 68, b = rest / 68;
    const int tc = tcidx(tb, dir), stream = (b * 4 + h) * 2 + dir;
    { const int itn = it + GS; if (itn < 4352) { const int restn = itn >> 3; h1_load_raw(p, rowbase_of(restn / 68, restn % 68), (itn >> 1) & 3, itn & 1, tq, kch, lfN, vN); } }
    float lf[16], bc[16], T0, T1, T2, T3;
    chunk_cumsum_raw(lfA, tq, kch, totl, lf, bc, T0, T1, T2, T3);
    const float blast = T0 + T1 + T2 + T3;
    float kd[16];
#pragma unroll
    for (int i = 0; i < 16; ++i) kd[i] = (1.f - __expf(lf[i])) * __expf(blast - bc[i]);
    u32x4 w0, w1;
    w0.x = cvt_pk_bf16(kd[0], kd[1]); w0.y = cvt_pk_bf16(kd[2], kd[3]); w0.z = cvt_pk_bf16(kd[4], kd[5]); w0.w = cvt_pk_bf16(kd[6], kd[7]);
    w1.x = cvt_pk_bf16(kd[8], kd[9]); w1.y = cvt_pk_bf16(kd[10], kd[11]); w1.z = cvt_pk_bf16(kd[12], kd[13]); w1.w = cvt_pk_bf16(kd[14], kd[15]);
    *(LAS3 u32x4*)(KD + kch * 72 + 16 * tq) = w0; *(LAS3 u32x4*)(KD + kch * 72 + 16 * tq + 8) = w1;
    w0.x = US2U(vv[0]); w0.y = US2U(vv[1]); w0.z = US2U(vv[2]); w0.w = US2U(vv[3]); w1.x = US2U(vv[4]); w1.y = US2U(vv[5]); w1.z = US2U(vv[6]); w1.w = US2U(vv[7]);
    *(LAS3 u32x4*)(VT + kch * 72 + 16 * tq) = w0; *(LAS3 u32x4*)(VT + kch * 72 + 16 * tq + 8) = w1;
    if (tq == 0) DEC[(size_t)(stream * 68 + tc) * 128 + kch] = __expf(blast);
    __syncthreads();
    GA bf16_t* UT = ST + (size_t)(stream * 68 + tc) * 16384;
#pragma unroll
    for (int jj = 0; jj < 2; ++jj) {
      const int tj = (wid & 1) * 2 + jj;
      f32x16 acc = {};
#pragma unroll
      for (int ks = 0; ks < 4; ++ks) {
        const bf16x8 a = *(const LAS3 bf16x8*)(KD + (32 * ti + r32) * 72 + ks * 16 + hi * 8);
        const bf16x8 bq = *(const LAS3 bf16x8*)(VT + (32 * tj + r32) * 72 + ks * 16 + hi * 8);
        acc = __builtin_amdgcn_mfma_f32_32x32x16_bf16(a, bq, acc, 0, 0, 0);
      }
#pragma unroll
      for (int rg = 0; rg < 4; ++rg) { u32x2 w; w.x = cvt_pk_bf16(acc[4 * rg], acc[4 * rg + 1]); w.y = cvt_pk_bf16(acc[4 * rg + 2], acc[4 * rg + 3]);
        *(GA u32x2*)(UT + (size_t)(32 * tj + r32) * 128 + 32 * ti + 8 * rg + 4 * hi) = w; }
    }
    __syncthreads();
    if (it + GS < 4352) { RAW_WAIT16(lfN); RAW_WAIT16(vN); pack2(lfN, lfA); pack2(vN, vv); }
  }
}
__device__ __forceinline__ void ph_h2(const P& p) {
  GA bf16_t* ST = (GA bf16_t*)(p.ws + OFF_ST); const GA float* DEC = (const GA float*)(p.ws + OFF_DEC);
  for (int idx = bid_() * 512 + tid_(); idx < 64 * 2048; idx += gridDim.x * 512) {
    const int stream = idx >> 11, e8 = idx & 2047, k0 = (e8 & 15) * 8;
    GA bf16_t* base = ST + (size_t)stream * 68 * 16384 + e8 * 8; const GA float* dec = DEC + (size_t)stream * 68 * 128 + k0;
    float S[8];
#pragma unroll
    for (int j = 0; j < 8; ++j) S[j] = 0.f;
#pragma unroll 1
    for (int t0 = 0; t0 < 68; t0 += 4) {
      u32x4 u[4]; f32x4 d0[4], d1[4];
#pragma unroll
      for (int q = 0; q < 4; ++q) { u[q] = *(const GA u32x4*)(base + (size_t)(t0 + q) * 16384); d0[q] = *(const GA f32x4*)(dec + (t0 + q) * 128); d1[q] = *(const GA f32x4*)(dec + (t0 + q) * 128 + 4); }
#pragma unroll
      for (int q = 0; q < 4; ++q) {
        u32x4 w; w.x = cvt_pk_bf16(S[0], S[1]); w.y = cvt_pk_bf16(S[2], S[3]); w.z = cvt_pk_bf16(S[4], S[5]); w.w = cvt_pk_bf16(S[6], S[7]);
        *(GA u32x4*)(base + (size_t)(t0 + q) * 16384) = w;
        S[0] = d0[q][0] * S[0] + bflo(u[q].x); S[1] = d0[q][1] * S[1] + bfhi(u[q].x); S[2] = d0[q][2] * S[2] + bflo(u[q].y); S[3] = d0[q][3] * S[3] + bfhi(u[q].y);
        S[4] = d1[q][0] * S[4] + bflo(u[q].z); S[5] = d1[q][1] * S[5] + bfhi(u[q].z); S[6] = d1[q][2] * S[6] + bflo(u[q].w); S[7] = d1[q][3] * S[7] + bfhi(u[q].w);
      }
    }
  }
}
__device__ __forceinline__ void ph_h3(const P& p, int e, unsigned char* lds) {
  const int tid = tid_(), wid = tid >> 6, lane = tid & 63, r32 = lane & 31, hi = lane >> 5, kch = tid & 127, tq = tid >> 7;
  LAS3 bf16_t* QBt = (LAS3 bf16_t*)lds;
  LAS3 bf16_t* QXt = QBt + 64 * 136;
  LAS3 bf16_t* KXt = QXt + 64 * 136;
  LAS3 bf16_t* YTt = KXt + 64 * 136;
  LAS3 bf16_t* VTt = YTt + 64 * 136;
  LAS3 bf16_t* ATt = VTt + 128 * 72;
  LAS3 float* totl = (LAS3 float*)(ATt + 64 * 72);
  LAS3 float* OT = (LAS3 float*)lds;
  const GA bf16_t* Q = (const GA bf16_t*)(p.ws + OFF_Q); const GA bf16_t* V = (const GA bf16_t*)(p.ws + OFF_V); const GA bf16_t* G = (const GA bf16_t*)(p.ws + OFF_G);
  const GA bf16_t* ST = (const GA bf16_t*)(p.ws + OFF_ST); GA bf16_t* MIX = (GA bf16_t*)(p.ws + OFF_MIX);
  const GA float* gn = (const GA float*)(p.hg_ng + e * 512);
  const int ti = wid >> 2, tj = wid & 3;
  const int GS = gridDim.x;
  us2_t lfA[8], qraw[8]; unsigned lfN[16], qN[16];
  { const int it0 = bid_(); if (it0 < 2176) { const int rest = it0 >> 2; h3_load_raw(p, rowbase_of(rest / 68, rest % 68), it0 & 3, 0, tq, kch, lfN, qN); RAW_WAIT16(lfN); RAW_WAIT16(qN); pack2(lfN, lfA); pack2(qN, qraw); } }
  const int ppv = tid >> 3, cgv = tid & 7;
  for (int it = bid_(); it < 2176; it += GS) {
    const int h = it & 3, rest = it >> 2, tb = rest % 68, b = rest / 68;
    const int rowbase = rowbase_of(b, tb);
    f32x16 o = {};
#pragma unroll 1
    for (int dir = 0; dir < 2; ++dir) {
      const int tc = tcidx(tb, dir), stream = (b * 4 + h) * 2 + dir;
      const GA bf16_t* Sg = ST + (size_t)(stream * 68 + tc) * 16384;
      bf16x8 sfr[8];
#pragma unroll
      for (int ks = 0; ks < 8; ++ks) sfr[ks] = *(const GA bf16x8*)(Sg + (size_t)(32 * tj + r32) * 128 + ks * 16 + hi * 8);
      u32x4 vw0, vw1;
      if (dir == 0) { const GA bf16_t* vp = V + (size_t)(rowbase + ppv) * 512 + h * 128 + cgv * 16; vw0 = *(const GA u32x4*)vp; vw1 = *(const GA u32x4*)(vp + 8); }
      if (dir == 0) h3_load_raw(p, rowbase, h, 1, tq, kch, lfN, qN);
      else { const int itn = it + GS; if (itn < 2176) { const int restn = itn >> 2; h3_load_raw(p, rowbase_of(restn / 68, restn % 68), itn & 3, 0, tq, kch, lfN, qN); } }
      float lf[16], bc[16], T0, T1, T2, T3;
      chunk_cumsum_raw(lfA, tq, kch, totl, lf, bc, T0, T1, T2, T3);
      const float R31 = T0 + T1, refx = tq < 2 ? T0 : R31 + T2;
#pragma unroll 1
      for (int rep_ = 0; rep_ < REP_FILL; ++rep_)
#pragma unroll
      for (int i = 0; i < 16; ++i) {
        const int tau = 16 * tq + i, pp = dir ? 63 - tau : tau;
        const float qv = bf2f((i & 1) ? qraw[i >> 1].y : qraw[i >> 1].x), kkv = 1.f - __expf(lf[i]), bi = bc[i];
        QBt[pp * 136 + kch] = f2bf(qv * __expf(bi));
        QXt[pp * 136 + kch] = f2bf(qv * __expf(fminf(bi - refx, 80.f)));
        KXt[pp * 136 + kch] = f2bf(kkv * __expf(fminf(refx - bi, 80.f)));
        YTt[pp * 136 + kch] = tq < 2 ? f2bf(kkv * __expf(R31 - bi)) : f2bf(qv * __expf(bi - R31));
      }
      if (dir == 0) {
#pragma unroll
        for (int j = 0; j < 8; ++j) { VTt[(cgv * 16 + j) * 72 + ppv] = (bf16_t)((j & 1) ? (vw0[j >> 1] >> 16) : (vw0[j >> 1] & 0xffffu)); VTt[(cgv * 16 + 8 + j) * 72 + ppv] = (bf16_t)((j & 1) ? (vw1[j >> 1] >> 16) : (vw1[j >> 1] & 0xffffu)); }
      }
      __syncthreads();
#pragma unroll
      for (int ks = 0; ks < 8; ++ks) {
        const bf16x8 a = *(const LAS3 bf16x8*)(QBt + (32 * ti + r32) * 136 + ks * 16 + hi * 8);
        o = __builtin_amdgcn_mfma_f32_32x32x16_bf16(a, sfr[ks], o, 0, 0, 0);
      }
      if (wid < 4) {
        const int I = wid >> 1, J = wid & 1;
        const bool diag = (I == J), offd = dir ? (I == 0 && J == 1) : (I == 1 && J == 0);
        f32x16 acc = {};
        if (diag || offd) {
          const LAS3 bf16_t* Ap = diag ? QXt : YTt; const LAS3 bf16_t* Bp = diag ? KXt : YTt;
#pragma unroll
          for (int ks = 0; ks < 8; ++ks) {
            const bf16x8 a = *(const LAS3 bf16x8*)(Ap + (32 * I + r32) * 136 + ks * 16 + hi * 8);
            const bf16x8 bq = *(const LAS3 bf16x8*)(Bp + (32 * J + r32) * 136 + ks * 16 + hi * 8);
            acc = __builtin_amdgcn_mfma_f32_32x32x16_bf16(a, bq, acc, 0, 0, 0);
          }
        }
#pragma unroll
        for (int r = 0; r < 16; ++r) { const int t = (r & 3) + 8 * (r >> 2) + 4 * hi;
          const bool keep = !diag || (dir ? (r32 >= t) : (r32 <= t));
          ATt[(32 * I + t) * 72 + 32 * J + r32] = f2bf(keep ? acc[r] : 0.f); }
      }
      __syncthreads();
#pragma unroll
      for (int ks = 0; ks < 4; ++ks) {
        const bf16x8 a = *(const LAS3 bf16x8*)(ATt + (32 * ti + r32) * 72 + ks * 16 + hi * 8);
        const bf16x8 bq = *(const LAS3 bf16x8*)(VTt + (32 * tj + r32) * 72 + ks * 16 + hi * 8);
        o = __builtin_amdgcn_mfma_f32_32x32x16_bf16(a, bq, o, 0, 0, 0);
      }
      __syncthreads();
      if (dir == 0 || it + GS < 2176) { RAW_WAIT16(lfN); RAW_WAIT16(qN); pack2(lfN, lfA); pack2(qN, qraw); }
    }
#pragma unroll
    for (int r = 0; r < 16; ++r) OT[(32 * ti + (r & 3) + 8 * (r >> 2) + 4 * hi) * 132 + 32 * tj + r32] = o[r];
    __syncthreads();
    {
      const int pp = tid >> 3, seg = tid & 7, row = rowbase + pp;
      float ov[16]; float ss = 0.f;
#pragma unroll
      for (int q = 0; q < 4; ++q) { const f32x4 v4 = *(const LAS3 f32x4*)(OT + pp * 132 + seg * 16 + q * 4); ov[q * 4] = v4[0]; ov[q * 4 + 1] = v4[1]; ov[q * 4 + 2] = v4[2]; ov[q * 4 + 3] = v4[3];
        ss += v4[0] * v4[0] + v4[1] * v4[1] + v4[2] * v4[2] + v4[3] * v4[3]; }
      ss += __shfl_xor(ss, 1); ss += __shfl_xor(ss, 2); ss += __shfl_xor(ss, 4);
      const float rs = rsqrtf(ss * (1.f / 128.f) + EPS);
      const u32x4 g0 = *(const GA u32x4*)(G + (size_t)row * 512 + h * 128 + seg * 16), g1 = *(const GA u32x4*)(G + (size_t)row * 512 + h * 128 + seg * 16 + 8);
      float y[16];
#pragma unroll
      for (int j = 0; j < 8; ++j) { y[j] = ov[j] * rs * gn[h * 128 + seg * 16 + j] * silu_f(UNPK(g0, j)); y[8 + j] = ov[8 + j] * rs * gn[h * 128 + seg * 16 + 8 + j] * silu_f(UNPK(g1, j)); }
      u32x4 w0, w1;
      w0.x = cvt_pk_bf16(y[0], y[1]); w0.y = cvt_pk_bf16(y[2], y[3]); w0.z = cvt_pk_bf16(y[4], y[5]); w0.w = cvt_pk_bf16(y[6], y[7]);
      w1.x = cvt_pk_bf16(y[8], y[9]); w1.y = cvt_pk_bf16(y[10], y[11]); w1.z = cvt_pk_bf16(y[12], y[13]); w1.w = cvt_pk_bf16(y[14], y[15]);
      GA bf16_t* dst = MIX + (size_t)row * 1024 + 512 + h * 128 + seg * 16;
      *(GA u32x4*)dst = w0; *(GA u32x4*)(dst + 8) = w1;
    }
    __syncthreads();
  }
}

__device__ __forceinline__ void ph_normrope(const P& p, int o) {
  const int tid = tid_(), wave = tid >> 6, lane = tid & 63;
  GA bf16_t* QB = (GA bf16_t*)(p.ws + OFF_QB); GA bf16_t* KB = (GA bf16_t*)(p.ws + OFF_KB);
  const GA float* ROPE = (const GA float*)(p.ws + OFF_ROPE);
  const float gq0 = p.qn_g[o * 128 + lane * 2], gq1 = p.qn_g[o * 128 + lane * 2 + 1], gk0 = p.kn_g[o * 128 + lane * 2], gk1 = p.kn_g[o * 128 + lane * 2 + 1];
  for (int row = bid_() * 8 + wave; row < NTOK; row += gridDim.x * 8) {
    GA bf16_t* qp = QB + (size_t)row * 1024 + lane * 2; GA bf16_t* kp = KB + (size_t)kvrow(row) * 256 + lane * 2;
    unsigned w[10];
#pragma unroll
    for (int s_ = 0; s_ < 8; ++s_) w[s_] = *(const GA unsigned*)(qp + s_ * 128);
    w[8] = *(const GA unsigned*)kp; w[9] = *(const GA unsigned*)(kp + 128);
    float cs = 1.f, sn = 0.f;
    if (row < NLAT) { const int t = row & 4095; const int pos = lane < 32 ? (t >> 6) : (t & 63); const GA float* cs2 = ROPE + 2 * (pos * 32 + (lane & 31)); cs = cs2[0]; sn = cs2[1]; }
#pragma unroll
    for (int s_ = 0; s_ < 10; ++s_) {
      const float x0 = bflo(w[s_]), x1 = bfhi(w[s_]);
      const float ss = wave_sum(x0 * x0 + x1 * x1);
      const float rs = rsqrtf(ss * (1.f / 128.f) + EPS);
      const float y0 = x0 * rs * (s_ < 8 ? gq0 : gk0), y1 = x1 * rs * (s_ < 8 ? gq1 : gk1);
      const unsigned ow = cvt_pk_bf16(y0 * cs - y1 * sn, y0 * sn + y1 * cs);
      if (s_ < 8) *(GA unsigned*)(qp + s_ * 128) = ow; else *(GA unsigned*)(kp + (s_ - 8) * 128) = ow;
    }
  }
}

__device__ __forceinline__ void ph_attn(const P& p, bool last, unsigned char* lds) {
  const bf16_t* QB = (const bf16_t*)(p.ws + OFF_QB); const bf16_t* KB = (const bf16_t*)(p.ws + OFF_KB); const bf16_t* VB = (const bf16_t*)(p.ws + OFF_VB);
  bf16_t* MIX = (bf16_t*)(p.ws + OFF_MIX);
#pragma unroll 1
  for (int r = 0; r < (last ? 4 : 5); ++r) {
    const int w = bid_(), bb = w & 7, jj = w >> 3;
    size_t qoff, koff; int seq;
    if (r < 4) { const int idx = r * 32 + jj, h = idx >> 4, qb = idx & 15; qoff = (size_t)(bb * 4096 + qb * 256) * 1024 + h * 128; koff = (size_t)bb * 4352 * 256 + (h >> 2) * 128; seq = 4352; }
    else { if (jj >= 8) break; const int h = jj; qoff = (size_t)(NLAT + bb * 256) * 1024 + h * 128; koff = ((size_t)bb * 4352 + 4096) * 256 + (h >> 2) * 128; seq = 256; }
    att::attn_dense_body(QB + qoff, KB + koff, VB + koff, MIX + qoff, seq, (char*)lds);
    __syncthreads();
  }
}

__device__ __forceinline__ void ph_conv(const P& p, int l, bool last) {
  const bf16_t* GATE = (const bf16_t*)(p.ws + OFF_GATE); bf16_t* VAL = (bf16_t*)(p.ws + OFF_VAL);
  const float* cw = p.conv_w + (size_t)l * 9 * 2816; const float* cb = p.conv_b + (size_t)l * 2816;
  const int gsz = gridDim.x * 512, gtid = bid_() * 512 + tid_();
  const u32x4 Z4 = {0u, 0u, 0u, 0u};
  for (int it = gtid; it < 2 * 8 * 64 * 352; it += gsz) {
    const int cg8 = it % 352; int rest = it / 352; const int col = rest & 63; rest >>= 6; const int b = rest & 7, seg = rest >> 3;
    const int c0 = cg8 * 8;
    float w[9][8], bias[8];
#pragma unroll
    for (int k = 0; k < 9; ++k) { const f32x4 a = *(const f32x4*)(cw + k * 2816 + c0), bq = *(const f32x4*)(cw + k * 2816 + c0 + 4);
      w[k][0] = a[0]; w[k][1] = a[1]; w[k][2] = a[2]; w[k][3] = a[3]; w[k][4] = bq[0]; w[k][5] = bq[1]; w[k][6] = bq[2]; w[k][7] = bq[3]; }
    { const f32x4 a = *(const f32x4*)(cb + c0), bq = *(const f32x4*)(cb + c0 + 4); bias[0] = a[0]; bias[1] = a[1]; bias[2] = a[2]; bias[3] = a[3]; bias[4] = bq[0]; bias[5] = bq[1]; bias[6] = bq[2]; bias[7] = bq[3]; }
    const size_t tb = (size_t)b * 4096;
#define LD3(r, A, Mi, C) do { if ((r) < 0 || (r) > 63) { A = Z4; Mi = Z4; C = Z4; } else { const bf16_t* q_ = GATE + (tb + (r) * 64 + col) * 2816 + c0; \
      Mi = *(const u32x4*)q_; A = col > 0 ? *(const u32x4*)(q_ - 2816) : Z4; C = col < 63 ? *(const u32x4*)(q_ + 2816) : Z4; } } while (0)
    u32x4 p0, p1, p2, q0, q1, q2, n0, n1, n2;
    const int r0 = seg * 32;
    LD3(r0 - 1, p0, p1, p2); LD3(r0, q0, q1, q2);
    for (int r = r0; r < r0 + 32; ++r) {
      LD3(r + 1, n0, n1, n2);
      bf16_t* vp = VAL + (tb + r * 64 + col) * 2816 + c0;
      const u32x4 vv = *(const u32x4*)vp;
      float a[8];
#pragma unroll
      for (int j = 0; j < 8; ++j) {
        float s = bias[j];
        s += w[0][j] * UNPK(p0, j) + w[1][j] * UNPK(p1, j) + w[2][j] * UNPK(p2, j);
        s += w[3][j] * UNPK(q0, j) + w[4][j] * UNPK(q1, j) + w[5][j] * UNPK(q2, j);
        s += w[6][j] * UNPK(n0, j) + w[7][j] * UNPK(n1, j) + w[8][j] * UNPK(n2, j);
        a[j] = silu_f(s) * UNPK(vv, j);
      }
      u32x4 ow; ow.x = cvt_pk_bf16(a[0], a[1]); ow.y = cvt_pk_bf16(a[2], a[3]); ow.z = cvt_pk_bf16(a[4], a[5]); ow.w = cvt_pk_bf16(a[6], a[7]);
      *(u32x4*)vp = ow;
      p0 = q0; p1 = q1; p2 = q2; q0 = n0; q1 = n1; q2 = n2;
    }
#undef LD3
  }
  if (!last) {
    for (int it = gtid; it < 8 * 32 * 352; it += gsz) {
      const int cg8 = it % 352, rest = it / 352, seg = rest & 31, b = rest >> 5, c0 = cg8 * 8, j0 = seg * 8;
      float w3[3][8], bias[8];
#pragma unroll
      for (int k = 0; k < 3; ++k) { const f32x4 wa = *(const f32x4*)(cw + (3 + k) * 2816 + c0), wb = *(const f32x4*)(cw + (3 + k) * 2816 + c0 + 4);
        w3[k][0] = wa[0]; w3[k][1] = wa[1]; w3[k][2] = wa[2]; w3[k][3] = wa[3]; w3[k][4] = wb[0]; w3[k][5] = wb[1]; w3[k][6] = wb[2]; w3[k][7] = wb[3]; }
      { const f32x4 wa = *(const f32x4*)(cb + c0), wb = *(const f32x4*)(cb + c0 + 4); bias[0] = wa[0]; bias[1] = wa[1]; bias[2] = wa[2]; bias[3] = wa[3]; bias[4] = wb[0]; bias[5] = wb[1]; bias[6] = wb[2]; bias[7] = wb[3]; }
      const size_t row0 = (size_t)NLAT + b * 256 + j0;
      const bf16_t* gq = GATE + row0 * 2816 + c0; bf16_t* vq = VAL + row0 * 2816 + c0;
      u32x4 g[10], vv[8];
#pragma unroll
      for (int i = 0; i < 10; ++i) { const int j = j0 - 1 + i; g[i] = (j >= 0 && j <= 255) ? *(const u32x4*)(gq + (ptrdiff_t)(i - 1) * 2816) : Z4; }
#pragma unroll
      for (int i = 0; i < 8; ++i) vv[i] = *(const u32x4*)(vq + (size_t)i * 2816);
#pragma unroll
      for (int i = 0; i < 8; ++i) {
        float a[8];
#pragma unroll
        for (int j = 0; j < 8; ++j) {
          const float sacc = bias[j] + w3[0][j] * UNPK(g[i], j) + w3[1][j] * UNPK(g[i + 1], j) + w3[2][j] * UNPK(g[i + 2], j);
          a[j] = silu_f(sacc) * UNPK(vv[i], j);
        }
        u32x4 ow; ow.x = cvt_pk_bf16(a[0], a[1]); ow.y = cvt_pk_bf16(a[2], a[3]); ow.z = cvt_pk_bf16(a[4], a[5]); ow.w = cvt_pk_bf16(a[6], a[7]);
        *(u32x4*)(vq + (size_t)i * 2816) = ow;
      }
    }
  }
}

__device__ __forceinline__ void ph_final(const P& p) {
  const int tid = tid_(), wave = tid >> 6, lane = tid & 63;
  f32x4 g4[4];
#pragma unroll
  for (int j = 0; j < 4; ++j) g4[j] = *(const GA f32x4*)((const GA float*)p.fn_g + j * 256 + lane * 4);
  for (int row = bid_() * 16 + wave; row < NLAT; row += gridDim.x * 16) {
    GA float* src = (GA float*)(p.out + (size_t)row * 1024);
    f32x4 v[2][4]; float ss0 = 0.f, ss1 = 0.f;
#pragma unroll
    for (int j = 0; j < 4; ++j) { v[0][j] = *(const GA f32x4*)(src + j * 256 + lane * 4); v[1][j] = *(const GA f32x4*)(src + 8 * 1024 + j * 256 + lane * 4); }
#pragma unroll
    for (int j = 0; j < 4; ++j) { ss0 += v[0][j][0] * v[0][j][0] + v[0][j][1] * v[0][j][1] + v[0][j][2] * v[0][j][2] + v[0][j][3] * v[0][j][3];
      ss1 += v[1][j][0] * v[1][j][0] + v[1][j][1] * v[1][j][1] + v[1][j][2] * v[1][j][2] + v[1][j][3] * v[1][j][3]; }
    ss0 = wave_sum(ss0); ss1 = wave_sum(ss1);
    const float rs0 = rsqrtf(ss0 * (1.f / 1024.f) + EPS), rs1 = rsqrtf(ss1 * (1.f / 1024.f) + EPS);
#pragma unroll
    for (int j = 0; j < 4; ++j) { f32x4 o0, o1; for (int q = 0; q < 4; ++q) { o0[q] = v[0][j][q] * rs0 * g4[j][q]; o1[q] = v[1][j][q] * rs1 * g4[j][q]; }
      *(GA f32x4*)(src + j * 256 + lane * 4) = o0; *(GA f32x4*)(src + 8 * 1024 + j * 256 + lane * 4) = o1; }
  }
}

__device__ __forceinline__ void run_phase(const P& p_in, int l, int ph, unsigned char* lds) {
  const bool even = !(l & 1), last = (l == 3); const int e = l >> 1;
  P p = p_in; asm volatile("" : "+s"(p.ws), "+s"(p.out));
  unsigned char* ws = p.ws;
  const float* MOD = (const float*)(ws + OFF_MOD);
  bf16_t* HB = (bf16_t*)(ws + OFF_HB); bf16_t* MIX = (bf16_t*)(ws + OFF_MIX);
  bf16_t* W1 = (bf16_t*)(ws + OFF_W1); bf16_t* W2 = (bf16_t*)(ws + OFF_W2); bf16_t* W3 = (bf16_t*)(ws + OFF_W3); bf16_t* W4 = (bf16_t*)(ws + OFF_W4);
  const int Mres = last ? NLAT : NTOK;
  if (ph == 0) {
    modulate_rows(p, l, 0, NTOK, l == 0, l > 0 ? (const float*)(ws + OFF_GATE) : nullptr, MOD + (size_t)((l > 0 ? l - 1 : 0) * 9 + 8) * 6144 + 5120);
    if (l == 0) { convert_weights(p, 0, lds, bid_(), (int)gridDim.x); fold_dft(p, 0, lds, bid_(), (int)gridDim.x); }
    if (even) gen_cm(p, lds);
  } else if (ph == 7) {
    EpiRes E{p.out, (float*)(ws + OFF_CTXR), MOD + (size_t)l * 9 * 6144 + 2048};
    run_gemm(lds, MIX, W2, NLAT, 1024, 1024, E);
    if (!last) { EpiPart Ep{(float*)(ws + OFF_MX), 512}; run_gemm_splitk(lds, MIX + (size_t)NLAT * 1024, W2, NCTX, 1024, 1024, 2, Ep); }
  } else if (ph == 8) {
    modulate_rows(p, l, 1, Mres, false, (const float*)(ws + OFF_MX), MOD + (size_t)(l * 9 + 8) * 6144 + 2048);
  } else if (ph == 9) {
    EpiUp E{(bf16_t*)(ws + OFF_GATE), (bf16_t*)(ws + OFF_VAL)};
    run_gemm(lds, HB, W3, Mres, 5632, 1024, E);
    if (!last) {
      __syncthreads();
      convert_weights(p, l + 1, lds, (int)bid_() - 176, (int)gridDim.x - 176, 0, 2);
    }
  } else if (ph == 10) {
    ph_conv(p, l, last);
  } else if (ph == 11) {
    EpiRes E{p.out, (float*)(ws + OFF_CTXR), MOD + (size_t)l * 9 * 6144 + 5120};
    run_gemm(lds, (const bf16_t*)(ws + OFF_VAL), (const bf16_t*)(ws + ((l & 1) ? OFF_W4B : OFF_W4)), NLAT, 1024, 2816, E);
    if (!last) { EpiPart Ep{(float*)(ws + OFF_GATE), 1408}; run_gemm_splitk(lds, (const bf16_t*)(ws + OFF_VAL) + (size_t)NLAT * 2816, (const bf16_t*)(ws + ((l & 1) ? OFF_W4B : OFF_W4)), NCTX, 1024, 2816, 2, Ep); }
    if (!last) {
      const int wg = (int)bid_() - 64, nwg = (int)gridDim.x - 64;
      __syncthreads();
      convert_weights(p, l + 1, lds, wg, nwg, 2, 4);
      if (l & 1) fold_dft(p, (l + 1) >> 1, lds, wg, nwg);
    }
  } else if (even) {
    if (ph == 1) { EpiAB E{EpiZ{(bf16_t*)(ws + OFF_ZT), (bf16_t*)(ws + OFF_ZTC)},
                           EpiHG{(bf16_t*)(ws + OFF_Q), (bf16_t*)(ws + OFF_V), (bf16_t*)(ws + OFF_G), (_Float16*)(ws + OFF_LF0), (_Float16*)(ws + OFF_LF1), (const float*)(ws + OFF_LB) + e * 1024}};
      run_gemm(lds, HB, W1, NTOK, 3584, 1024, E); }
    else if (ph == 12) ph_fold(p, lds);
    else if (ph == 2) {
      { EpiDFT E{MIX, 0}; run_gemm(lds, (const bf16_t*)(ws + OFF_CM2), (const bf16_t*)(ws + OFF_ZF), 4096, 4096, 4096, E); }
      { EpiDFT E{MIX, 1}; run_gemm(lds, (const bf16_t*)(ws + OFF_CM256), (const bf16_t*)(ws + OFF_ZTC), 256, 4096, 512, E); }
    }
    else if (ph == 4) ph_h1(p, lds);
    else if (ph == 5) ph_h2(p);
    else if (ph == 6) ph_h3(p, e, lds);
  } else {
    if (ph == 1) { EpiQKV E{(bf16_t*)(ws + OFF_QB), (bf16_t*)(ws + OFF_KB), (bf16_t*)(ws + OFF_VB)}; run_gemm(lds, HB, W1, NTOK, 1536, 1024, E); }
    else if (ph == 2) ph_normrope(p, e);
    else if (ph == 3) ph_attn(p, last, lds);
  }
}

#if MULTI
__global__ void __launch_bounds__(512, 2) k_phase(P p, int l, int ph) {
  extern __shared__ __attribute__((aligned(16))) unsigned char lds[];
  if (l < 0) ph0(p, lds); else if (l >= 4) ph_final(p); else run_phase(p, l, ph, lds);
}
#else
__global__ void __launch_bounds__(512, 2) k_mega(P p) {
  extern __shared__ __attribute__((aligned(16))) unsigned char lds[];
  cg::grid_group grid = cg::this_grid();
  volatile LAS3 unsigned* st = (volatile LAS3 unsigned*)((LAS3 unsigned char*)lds + 131072);
  if (threadIdx.x == 0) { st[0] = 0u; st[1] = 0u; st[2] = 0u; st[3] = 0u; }
  __syncthreads();
  XcdBarrier bar = xcd_barrier_post((unsigned*)(p.ws + OFF_BAR), st);
  grid.sync();
  ph0(p, lds); xcd_barrier(bar);
#pragma unroll 1
  for (int l = 0; l < 4; ++l) {
#pragma unroll 1
    for (int sq = 0; sq <= 12; ++sq) {
      const int ph = sq < 2 ? sq : (sq == 2 ? 12 : sq - 1);
      if ((l & 1) ? ((ph >= 4 && ph <= 6) || ph == 12) : (ph == 3)) continue;
      run_phase(p, l, ph, lds);
      xcd_barrier(bar);
#if REP_MASK != 0
      if (((REP_MASK >> ph) & 1) && !(ph == 2 && (l & 1))) { run_phase(p, l, ph, lds); xcd_barrier(bar); }
#endif
    }
  }
  ph_final(p);
}
#endif

constexpr int LDS_BYTES = 131072 + 16;
extern "C" void kernel_launch(void* const* d_in, const int* in_sizes, int n_in, void* d_out, int out_size, void* d_ws, size_t ws_size, hipStream_t stream) {
  static int ok = 0;
  if (!ok) {
    if (n_in != 19 || ws_size < WS_END) { fprintf(stderr, "kernel_launch: unexpected n_in %d / ws %zu (need %zu)\n", n_in, ws_size, (size_t)WS_END); return; }
#if MULTI
    if (hipFuncSetAttribute((const void*)k_phase, hipFuncAttributeMaxDynamicSharedMemorySize, LDS_BYTES) != hipSuccess) { fprintf(stderr, "hipFuncSetAttribute failed\n"); return; }
#else
    if (hipFuncSetAttribute((const void*)k_mega, hipFuncAttributeMaxDynamicSharedMemorySize, LDS_BYTES) != hipSuccess) { fprintf(stderr, "hipFuncSetAttribute failed\n"); return; }
#endif
    ok = 1;
  }
  P p{};
  p.x = (const float*)d_in[0]; p.c = (const float*)d_in[1]; p.ctx = (const float*)d_in[2]; p.c_ctx = (const float*)d_in[3]; p.w_mod = (const float*)d_in[4]; p.b_mod = (const float*)d_in[5];
  p.w_in_ab = (const float*)d_in[6]; p.w_out_ab = (const float*)d_in[7]; p.hg_lb = (const float*)d_in[8]; p.hg_ng = (const float*)d_in[9]; p.w_qkv = (const float*)d_in[10];
  p.qn_g = (const float*)d_in[11]; p.kn_g = (const float*)d_in[12]; p.w_out_att = (const float*)d_in[13]; p.w_up = (const float*)d_in[14]; p.conv_w = (const float*)d_in[15];
  p.conv_b = (const float*)d_in[16]; p.w_down = (const float*)d_in[17]; p.fn_g = (const float*)d_in[18];
  p.out = (float*)d_out; p.ws = (unsigned char*)d_ws;
#if MULTI
  hipLaunchKernelGGL(k_phase, dim3(256), dim3(512), LDS_BYTES, stream, p, -1, 0);
  for (int l = 0; l < 4; ++l) for (int ph = 0; ph <= 11; ++ph) { if ((l & 1) && (ph >= 4 && ph <= 6)) continue; hipLaunchKernelGGL(k_phase, dim3(256), dim3(512), LDS_BYTES, stream, p, l, ph); }
  hipLaunchKernelGGL(k_phase, dim3(256), dim3(512), LDS_BYTES, stream, p, 4, 0);
#else
  if (hipMemsetAsync((char*)d_ws + OFF_BAR, 0, 16384, stream) != hipSuccess) { fprintf(stderr, "memset failed\n"); return; }
  void* args[] = {&p};
  hipError_t e = hipLaunchCooperativeKernel((const void*)k_mega, dim3(256), dim3(512), args, LDS_BYTES, stream);
  if (e != hipSuccess) fprintf(stderr, "cooperative launch failed: %s\n", hipGetErrorString(e));
#endif
}
```

```cpp
#include <hip/hip_runtime.h>
#include <hip/hip_bf16.h>
#include <hip/hip_cooperative_groups.h>
#include <cstdio>
namespace cg = cooperative_groups;

#ifndef REP_FILL
#define REP_FILL 1
#endif
#ifndef REP_MASK
#define REP_MASK 0
#endif
#ifndef MULTI
#define MULTI 0
#endif

typedef unsigned short bf16_t;
typedef short bf16x8 __attribute__((ext_vector_type(8)));
typedef short s16x4 __attribute__((ext_vector_type(4)));
typedef float f32x4 __attribute__((ext_vector_type(4)));
typedef float f32x16 __attribute__((ext_vector_type(16)));
typedef unsigned u32x4 __attribute__((ext_vector_type(4)));
typedef unsigned u32x2 __attribute__((ext_vector_type(2)));
typedef _Float16 h16x8 __attribute__((ext_vector_type(8)));

constexpr int NLAT = 32768, NCTX = 2048, NTOK = 34816;
constexpr float EPS = 1e-6f;

constexpr size_t OFF_CTXR = 0;
constexpr size_t OFF_MOD = OFF_CTXR + 8388608;
constexpr size_t OFF_LB = OFF_MOD + 1048576;
constexpr size_t OFF_CM256 = OFF_LB + 8192;
constexpr size_t OFF_HB = OFF_CM256 + 262144;
constexpr size_t OFF_W1 = OFF_HB + 71303168;
constexpr size_t OFF_W2 = OFF_W1 + 7340032;
constexpr size_t OFF_W3 = OFF_W2 + 2097152;
constexpr size_t OFF_W4 = OFF_W3 + 11534336;
constexpr size_t OFF_AL = OFF_W4 + 5767168;
constexpr size_t OFF_GATE = OFF_AL;
constexpr size_t OFF_VAL = OFF_GATE + 196083712;
constexpr size_t OFF_MIX = OFF_AL;
constexpr size_t OFF_MX = OFF_MIX + 71303168;
constexpr size_t OFF_Q = OFF_MX;
constexpr size_t OFF_V = OFF_Q + 35651584;
constexpr size_t OFF_G = OFF_V + 35651584;
constexpr size_t OFF_LF0 = OFF_G + 35651584;
constexpr size_t OFF_LF1 = OFF_LF0 + 35651584;
constexpr size_t OFF_O0 = OFF_LF1 + 35651584;
constexpr size_t OFF_O1 = OFF_O0 + 71303168;
constexpr size_t OFF_ZT = OFF_O0;
constexpr size_t OFF_ZTC = OFF_ZT + 67108864;
constexpr size_t OFF_ZF = OFF_ZTC + 4194304;
constexpr size_t OFF_CM2 = OFF_ZF + 33554432;
constexpr size_t OFF_CM = OFF_CM2;
constexpr size_t OFF_QB = OFF_MX;
constexpr size_t OFF_KB = OFF_QB + 71303168;
constexpr size_t OFF_VB = OFF_KB + 17825792;
constexpr size_t OFF_ST = OFF_O0;
constexpr size_t OFF_DEC = OFF_VAL + 196083712;
constexpr size_t OFF_W4B = OFF_DEC + 2228224;
constexpr size_t OFF_BAR = OFF_W4B + 5767168;
constexpr size_t OFF_ROPE = OFF_BAR + 16384;
constexpr size_t WS_END = OFF_ROPE + 16384;
static_assert(OFF_O1 + 71303168 <= OFF_DEC && OFF_CM2 + 33554432 <= OFF_DEC && OFF_VB + 17825792 <= WS_END, "alias region");

struct P {
  const float *x, *c, *ctx, *c_ctx, *w_mod, *b_mod, *w_in_ab, *w_out_ab, *hg_lb, *hg_ng, *w_qkv, *qn_g, *kn_g, *w_out_att, *w_up, *conv_w, *conv_b, *w_down, *fn_g;
  float* out; unsigned char* ws;
};

typedef __bf16 bf16v2_t __attribute__((ext_vector_type(2)));
typedef float f32v2_t __attribute__((ext_vector_type(2)));
__device__ __forceinline__ unsigned cvt_pk_bf16(float lo, float hi) { const f32v2_t v = {lo, hi}; const bf16v2_t r = __builtin_convertvector(v, bf16v2_t); return __builtin_bit_cast(unsigned, r); }
__device__ __forceinline__ bf16_t f2bf(float f) { return (bf16_t)(cvt_pk_bf16(f, 0.f) & 0xffffu); }
__device__ __forceinline__ float bflo(unsigned w) { return __uint_as_float(w << 16); }
__device__ __forceinline__ float bfhi(unsigned w) { return __uint_as_float(w & 0xffff0000u); }
__device__ __forceinline__ float bf2f(bf16_t v) { return __uint_as_float(((unsigned)v) << 16); }
#define GA __attribute__((address_space(1)))
#define LAS3 __attribute__((address_space(3)))
#define UNPK(w, j) (((j) & 1) ? bfhi((w)[(j) >> 1]) : bflo((w)[(j) >> 1]))
__device__ __forceinline__ float silu_f(float v) { return v * __builtin_amdgcn_rcpf(1.f + __expf(-v)); }
__device__ __forceinline__ float wave_sum(float v) {
#pragma unroll
  for (int o = 32; o > 0; o >>= 1) v += __shfl_xor(v, o);
  return v;
}
__device__ __forceinline__ int tid_() { int t = threadIdx.x; asm volatile("" : "+v"(t)); return t; }
__device__ __forceinline__ int bid_() { int b = blockIdx.x; asm volatile("" : "+s"(b)); return b; }
__device__ __forceinline__ int kvrow(int row) { return row < NLAT ? (row >> 12) * 4352 + (row & 4095) : ((row - NLAT) >> 8) * 4352 + 4096 + ((row - NLAT) & 255); }

#define XB_TMO      128
#define XB_XCNT(j)  (256  + 64 * (j))
#define XB_XSUB(j)  (1280 + 64 * (j))
#define XB_XGEN(j)  (2304 + 64 * (j))
#define XB_TOP      3328
#define XB_TOPGEN   3392
#define XCD_BAR_WORDS 3456
#define XB_SPIN_CAP (1u << 22)
__device__ __forceinline__ unsigned xb_ld(unsigned* p)              { return __hip_atomic_load(p, __ATOMIC_RELAXED, __HIP_MEMORY_SCOPE_AGENT); }
__device__ __forceinline__ unsigned xb_add(unsigned* p, unsigned v) { return __hip_atomic_fetch_add(p, v, __ATOMIC_RELAXED, __HIP_MEMORY_SCOPE_AGENT); }
__device__ __forceinline__ unsigned xb_xcc_id() { return (unsigned)__builtin_amdgcn_s_getreg((3 << 11) | 20) & 0xFu; }
#define XB_SPIN(cond, bar) do { unsigned _sp = 0; while (cond) { __builtin_amdgcn_s_sleep(3); \
    if ((++_sp & 255u) == 0u) { if (xb_ld(&(bar)[XB_TMO])) break; if (_sp > XB_SPIN_CAP) { atomicAdd(&(bar)[XB_TMO], 1u); break; } } } } while (0)
struct XcdBarrier { unsigned* bar; unsigned x; volatile LAS3 unsigned* st; };
__device__ __forceinline__ XcdBarrier xcd_barrier_post(unsigned* bar, volatile LAS3 unsigned* st) {
  XcdBarrier b; b.bar = bar; b.x = xb_xcc_id(); b.st = st;
  if (threadIdx.x == 0) (void)xb_add(&bar[XB_XCNT(b.x)], 1u);
  return b;
}
__device__ __forceinline__ void xcd_barrier_complete(unsigned* bar, unsigned x, unsigned& nloc, unsigned& nx) {
  const unsigned G = gridDim.x * gridDim.y * gridDim.z;
  unsigned sum, cnt, mine, sp = 0u;
  for (;;) {
    sum = 0u; cnt = 0u; mine = 0u;
#pragma unroll
    for (unsigned j = 0; j < 16; ++j) { const unsigned c = xb_ld(&bar[XB_XCNT(j)]); sum += c; cnt += (c > 0u) ? 1u : 0u; mine = (j == x) ? c : mine; }
    if (sum == G) break;
    __builtin_amdgcn_s_sleep(1);
    if ((++sp & 255u) == 0u) { if (xb_ld(&bar[XB_TMO])) break; if (sp > XB_SPIN_CAP) { atomicAdd(&bar[XB_TMO], 1u); break; } }
  }
  nloc = mine > 0u ? mine : 1u; nx = cnt > 0u ? cnt : 1u;
}
__device__ __forceinline__ void xcd_barrier(const XcdBarrier& b) {
  asm volatile("s_waitcnt vmcnt(0)" ::: "memory");
  __syncthreads();
  if (threadIdx.x == 0) {
    unsigned* bar = b.bar; unsigned bx = __builtin_amdgcn_readfirstlane(b.x);
    asm volatile("" : "+s"(bar), "+s"(bx));
    __builtin_amdgcn_s_waitcnt(0);
    unsigned nloc = b.st[0], nx = b.st[1];
    if (nloc == 0u) { xcd_barrier_complete(bar, bx, nloc, nx); b.st[0] = nloc; b.st[1] = nx; }
    const unsigned old = xb_add(&bar[XB_XSUB(bx)], 1u);
    const unsigned gen = old / nloc;
    if (old + 1u == (gen + 1u) * nloc) {
      __builtin_amdgcn_fence(__ATOMIC_RELEASE, "agent");
      asm volatile("s_waitcnt vmcnt(0)" ::: "memory");
      const unsigned og = xb_add(&bar[XB_TOP], 1u);
      const unsigned tg = og / nx;
      if (og + 1u == (tg + 1u) * nx) xb_add(&bar[XB_TOPGEN], 1u);
      else XB_SPIN(xb_ld(&bar[XB_TOPGEN]) == tg, bar);
      __builtin_amdgcn_fence(__ATOMIC_ACQUIRE, "agent");
      xb_add(&bar[XB_XGEN(bx)], 1u);
      asm volatile("s_waitcnt vmcnt(0)" ::: "memory");
    } else {
      XB_SPIN(xb_ld(&bar[XB_XGEN(bx)]) == gen, bar);
      __builtin_amdgcn_fence(__ATOMIC_ACQUIRE, "agent");
      asm volatile("s_waitcnt vmcnt(0)" ::: "memory");
    }
  }
  __syncthreads();
}

namespace pg8 {
#define PG8_LAS __attribute__((address_space(3)))
constexpr int BM = 256, BK = 64, HALF = 128, HTB = HALF * BK * 2, STAGE_BYTES = 8 * HTB, NXCD = 8, WGM = 8;
__device__ __forceinline__ int lds_byte(int r, int c) { const int st = (r >> 4) * 2 + (c >> 5), rr = r & 15, cc = c & 31, ob = rr * 64 + cc * 2; return st * 1024 + (ob ^ (((ob >> 9) & 1) << 5)); }
__device__ __forceinline__ void stage_rc(int b, int& R, int& C) { const int st = b / 1024, sb = b % 1024, swz = sb ^ (((sb >> 9) & 1) << 5); R = (st >> 1) * 16 + swz / 64; C = (st & 1) * 32 + (swz % 64) / 2; }
__device__ __forceinline__ int perm32(int rho) { const int n = rho >> 4, i = rho & 15; return 8 * (i >> 2) + 4 * n + (i & 3); }
struct Unit { int pm, pn, ko; };
struct Gemm { const bf16_t* A; const bf16_t* Bt; int M, N, K, ldk; };
struct StaticOrder {
  int nM, nN, nwg, G, c;
  __device__ void init(int M, int N, int G_, int c_) { nM = M / BM; nN = N / BM; nwg = nM * nN; G = G_; c = c_; }
  __device__ bool next(int i, Unit& u) const {
    const long L = (long)i * G + c; if (L >= nwg) return false;
    int wgid = (int)L; { const int q = nwg / NXCD, r = nwg % NXCD, xcd = wgid % NXCD, off = wgid / NXCD; wgid = (xcd < r ? xcd * (q + 1) : r * (q + 1) + (xcd - r) * q) + off; }
    const int nig = WGM * nN, gid = wgid / nig, fm = gid * WGM, gsz = (nM - fm) < WGM ? (nM - fm) : WGM;
    u.pm = fm + ((wgid % nig) % gsz); u.pn = (wgid % nig) / gsz; u.ko = 0; return true;
  }
};
struct SplitKOrder {
  int nN, ns, nwg, G, c, ksub;
  __device__ void init(int M, int N, int ns_, int ksub_, int G_, int c_) { nN = N / BM; ns = ns_; ksub = ksub_; nwg = (M / BM) * nN * ns; G = G_; c = c_; }
  __device__ bool next(int i, Unit& u) const {
    const int L = i * G + c; if (L >= nwg) return false;
    u.ko = (L % ns) * ksub; u.pn = (L / ns) % nN; u.pm = L / (ns * nN); return true;
  }
};

#ifndef GEMM_SP2
#define GEMM_SP2 1
#endif
#ifndef GEMM_ALIGN
#define GEMM_ALIGN 1
#endif
template <class Epi, class Sched>
__device__ __forceinline__ void gemm_phase(PG8_LAS unsigned char* lds, const Gemm g, const Sched& S, const Epi& E) {
  const int tid = tid_(), wid = __builtin_amdgcn_readfirstlane(tid >> 6), lane = tid & 63, wr = wid >> 2, wc = wid & 3, fr = lane & 15, fq = lane >> 4;
  const int K = g.ldk, nt = g.K / BK;
  unsigned voffA[2], voffB[2];
#pragma unroll
  for (int i = 0; i < 2; ++i) { int R, C; stage_rc(tid * 16 + i * 8192, R, C); const int Rb = Epi::PERM ? ((R & ~31) + perm32(R & 31)) : R;
    voffA[i] = (unsigned)(R * K + C) * 2u; voffB[i] = (unsigned)(Rb * K + C) * 2u; }
  const size_t kstep = (size_t)(BK * 2);
  const size_t hstep = (size_t)HALF * K * 2;
  const size_t tstep = 2 * hstep;
  const unsigned ldsw = (unsigned)wid * 1024u;
  const int aoff = lds_byte(wr * 64 + fr, fq * 8), boff = lds_byte(wc * 32 + fr, fq * 8);
#define PG8_SA(b, h) (((b) * 2 + (h)) * HTB)
#define PG8_SB(b, h) ((4 + (b) * 2 + (h)) * HTB)
#define PG8_STAGE(bufoff, gbase, voff) do { _Pragma("unroll") for (int _i = 0; _i < 2; ++_i) \
    __builtin_amdgcn_global_load_lds((const unsigned*)((const char*)(gbase) + (voff)[_i]), (PG8_LAS unsigned*)(lds + (bufoff) + ldsw + _i * 8192), 16, 0, 0); } while (0)
#define PG8_LDA(dst, b, h) do { _Pragma("unroll") for (int m = 0; m < 4; ++m) _Pragma("unroll") for (int k = 0; k < 2; ++k) dst[m][k] = *(const PG8_LAS bf16x8*)(lds + PG8_SA(b, h) + aoff + m * 2048 + k * 1024); } while (0)
#define PG8_LDB(dst, b, h) do { _Pragma("unroll") for (int n = 0; n < 2; ++n) _Pragma("unroll") for (int k = 0; k < 2; ++k) dst[n][k] = *(const PG8_LAS bf16x8*)(lds + PG8_SB(b, h) + boff + n * 2048 + k * 1024); } while (0)
#define PG8_MMA(ai, bj, At, Bt) do { __builtin_amdgcn_s_setprio(1); _Pragma("unroll") for (int m = 0; m < 4; ++m) _Pragma("unroll") for (int n = 0; n < 2; ++n) _Pragma("unroll") for (int k = 0; k < 2; ++k) \
    acc[ai][bj][m][n] = __builtin_amdgcn_mfma_f32_16x16x32_bf16(Bt[n][k], At[m][k], acc[ai][bj][m][n], 0, 0, 0); __builtin_amdgcn_s_setprio(0); } while (0)
#define PG8_WAIT_V(n) asm volatile("s_waitcnt vmcnt(" #n ")" ::: "memory")
#define PG8_WAIT_L(n) asm volatile("s_waitcnt lgkmcnt(" #n ")" ::: "memory")
#define PG8_BAR __builtin_amdgcn_s_barrier()
#define PG8_SCHED __builtin_amdgcn_sched_barrier(0)
  Unit cur, nxt; int ui = 0;
  if (!S.next(0, cur)) return;
  f32x4 acc[2][2][4][2];
#pragma unroll
  for (int a = 0; a < 2; ++a)
#pragma unroll
    for (int b = 0; b < 2; ++b)
#pragma unroll
      for (int m = 0; m < 4; ++m)
#pragma unroll
        for (int n = 0; n < 2; ++n) acc[a][b][m][n] = (f32x4){0.f, 0.f, 0.f, 0.f};
  bf16x8 At[4][2], B0[2][2], B1[2][2];
  const char* cA = (const char*)g.A + (size_t)cur.pm * tstep + (size_t)cur.ko * 2; const char* cB = (const char*)g.Bt + (size_t)cur.pn * tstep + (size_t)cur.ko * 2;
#if GEMM_SP2
  PG8_STAGE(PG8_SB(0, 0), cB, voffB); PG8_STAGE(PG8_SB(0, 1), cB + hstep, voffB); PG8_STAGE(PG8_SA(0, 0), cA, voffA); PG8_STAGE(PG8_SA(0, 1), cA + hstep, voffA);
  if (wr == 1) PG8_BAR;
  PG8_WAIT_V(2); PG8_BAR;
  PG8_STAGE(PG8_SB(1, 0), cB + kstep, voffB); PG8_STAGE(PG8_SA(1, 0), cA + kstep, voffA); PG8_STAGE(PG8_SB(1, 1), cB + hstep + kstep, voffB);
  PG8_WAIT_V(6); PG8_BAR;
#else
  PG8_STAGE(PG8_SB(0, 0), cB, voffB); PG8_STAGE(PG8_SA(0, 0), cA, voffA); PG8_STAGE(PG8_SB(0, 1), cB + hstep, voffB); PG8_STAGE(PG8_SA(0, 1), cA + hstep, voffA);
  if (wr == 1) PG8_BAR;
  PG8_WAIT_V(4); PG8_BAR;
  PG8_STAGE(PG8_SB(1, 0), cB + kstep, voffB); PG8_STAGE(PG8_SA(1, 0), cA + kstep, voffA); PG8_STAGE(PG8_SB(1, 1), cB + hstep + kstep, voffB);
  PG8_WAIT_V(6); PG8_BAR;
#endif
  for (;;) {
    const bool has_next = S.next(ui + 1, nxt);
    const char* nA = has_next ? (const char*)g.A + (size_t)nxt.pm * tstep + (size_t)nxt.ko * 2 : cA; const char* nB = has_next ? (const char*)g.Bt + (size_t)nxt.pn * tstep + (size_t)nxt.ko * 2 : cB;
    for (int t = 0; t < nt; t += 2) {
      const bool last = (t == nt - 2);
      const char* a1 = cA + (size_t)(t + 1) * kstep;
      const char* a2 = last ? nA : cA + (size_t)(t + 2) * kstep; const char* b2 = last ? nB : cB + (size_t)(t + 2) * kstep;
      const char* a3 = a2 + kstep; const char* b3 = b2 + kstep;
#if GEMM_SP2
      PG8_LDB(B0, 0, 0); PG8_LDB(B1, 0, 1); PG8_SCHED; PG8_LDA(At, 0, 0); PG8_STAGE(PG8_SA(1, 1), a1 + hstep, voffA);
      PG8_WAIT_V(8); PG8_WAIT_L(0); PG8_BAR; PG8_MMA(0, 0, At, B0); PG8_MMA(0, 1, At, B1); PG8_BAR; PG8_SCHED;
      PG8_LDA(At, 0, 1); PG8_STAGE(PG8_SB(0, 0), b2, voffB); PG8_STAGE(PG8_SB(0, 1), b2 + hstep, voffB); PG8_STAGE(PG8_SA(0, 0), a2, voffA);
      PG8_WAIT_V(8); PG8_WAIT_L(0); PG8_BAR; PG8_MMA(1, 0, At, B0); PG8_MMA(1, 1, At, B1); PG8_BAR; PG8_SCHED;
      PG8_LDB(B0, 1, 0); PG8_LDB(B1, 1, 1); PG8_SCHED; PG8_LDA(At, 1, 0); PG8_STAGE(PG8_SA(0, 1), a2 + hstep, voffA);
      PG8_WAIT_V(8); PG8_WAIT_L(0); PG8_BAR; PG8_MMA(0, 0, At, B0); PG8_MMA(0, 1, At, B1); PG8_BAR; PG8_SCHED;
      PG8_LDA(At, 1, 1); PG8_STAGE(PG8_SB(1, 0), b3, voffB); PG8_STAGE(PG8_SB(1, 1), b3 + hstep, voffB); PG8_STAGE(PG8_SA(1, 0), a3, voffA);
      PG8_WAIT_V(8); PG8_WAIT_L(0); PG8_BAR; PG8_MMA(1, 0, At, B0); PG8_MMA(1, 1, At, B1); PG8_BAR; PG8_SCHED;
#else
      PG8_LDB(B0, 0, 0); PG8_SCHED; PG8_LDA(At, 0, 0); PG8_STAGE(PG8_SA(1, 1), a1 + hstep, voffA);
      PG8_WAIT_L(8); PG8_BAR; PG8_WAIT_L(0); PG8_MMA(0, 0, At, B0); PG8_BAR; PG8_SCHED;
      PG8_LDB(B1, 0, 1); PG8_STAGE(PG8_SB(0, 0), b2, voffB);
      PG8_BAR; PG8_WAIT_L(0); PG8_MMA(0, 1, At, B1); PG8_BAR;
      PG8_LDA(At, 0, 1); PG8_STAGE(PG8_SA(0, 0), a2, voffA);
      PG8_BAR; PG8_WAIT_L(0); PG8_MMA(1, 0, At, B0); PG8_BAR; PG8_SCHED;
      PG8_STAGE(PG8_SB(0, 1), b2 + hstep, voffB);
      PG8_WAIT_V(6); PG8_BAR; PG8_MMA(1, 1, At, B1); PG8_BAR;
      PG8_LDB(B0, 1, 0); PG8_SCHED; PG8_LDA(At, 1, 0); PG8_STAGE(PG8_SA(0, 1), a2 + hstep, voffA);
      PG8_WAIT_L(8); PG8_BAR; PG8_WAIT_L(0); PG8_MMA(0, 0, At, B0); PG8_BAR; PG8_SCHED;
      PG8_LDB(B1, 1, 1); PG8_STAGE(PG8_SB(1, 0), b3, voffB);
      PG8_BAR; PG8_WAIT_L(0); PG8_MMA(0, 1, At, B1); PG8_BAR;
      PG8_LDA(At, 1, 1); PG8_STAGE(PG8_SA(1, 0), a3, voffA);
      PG8_BAR; PG8_WAIT_L(0); PG8_MMA(1, 0, At, B0); PG8_BAR; PG8_SCHED;
      PG8_STAGE(PG8_SB(1, 1), b3 + hstep, voffB);
      PG8_WAIT_V(6); PG8_BAR; PG8_MMA(1, 1, At, B1); PG8_BAR;
#endif
    }
#if GEMM_ALIGN
    if (wr == 0) PG8_BAR;
#endif
    E(acc, cur, wr, wc, fr, fq);
    if (!has_next) break;
#pragma unroll
    for (int a = 0; a < 2; ++a)
#pragma unroll
      for (int b = 0; b < 2; ++b)
#pragma unroll
        for (int m = 0; m < 4; ++m)
#pragma unroll
          for (int n = 0; n < 2; ++n) acc[a][b][m][n] = (f32x4){0.f, 0.f, 0.f, 0.f};
    cur = nxt; cA = nA; cB = nB; ++ui;
#if GEMM_ALIGN
    if (wr == 1) PG8_BAR;
#endif
  }
  PG8_WAIT_V(0);
#if !GEMM_ALIGN
  if (wr == 0) PG8_BAR;
#endif
  PG8_BAR;
#undef PG8_SA
#undef PG8_SB
#undef PG8_STAGE
#undef PG8_LDA
#undef PG8_LDB
#undef PG8_MMA
#undef PG8_WAIT_V
#undef PG8_WAIT_L
#undef PG8_BAR
#undef PG8_SCHED
}
}

typedef const f32x4 (&AccRef)[2][2][4][2];
__device__ __forceinline__ u32x4 pack8(f32x4 v0, f32x4 v1) { u32x4 w; w.x = cvt_pk_bf16(v0[0], v0[1]); w.y = cvt_pk_bf16(v0[2], v0[3]); w.z = cvt_pk_bf16(v1[0], v1[1]); w.w = cvt_pk_bf16(v1[2], v1[3]); return w; }

struct EpiZ {
  static constexpr bool PERM = true;
  bf16_t* Z; bf16_t* ZTC;
  __device__ __forceinline__ void operator()(AccRef acc, const pg8::Unit& u, int wr, int wc, int fr, int fq) const {
#pragma unroll
    for (int ai = 0; ai < 2; ++ai)
#pragma unroll
      for (int m = 0; m < 4; ++m) {
        const int row = u.pm * 256 + ai * 128 + wr * 64 + m * 16 + fr;
        if (row < NLAT) {
          bf16_t* dst = Z + (size_t)row * 1024 + u.pn * 256 + wc * 32 + fq * 8;
#pragma unroll
          for (int bj = 0; bj < 2; ++bj) *(u32x4*)(dst + bj * 128) = pack8(acc[ai][bj][m][0], acc[ai][bj][m][1]);
        } else {
          const int rr = row - NLAT; bf16_t* base = ZTC + (size_t)(rr >> 8) * 512 * 512 + (rr & 255);
#pragma unroll
          for (int bj = 0; bj < 2; ++bj)
#pragma unroll
            for (int n = 0; n < 2; ++n)
#pragma unroll
              for (int j = 0; j < 4; ++j) { const int col = u.pn * 256 + bj * 128 + wc * 32 + fq * 8 + n * 4 + j;
                base[(size_t)(col & 511) * 512 + (col >> 9) * 256] = f2bf(acc[ai][bj][m][n][j]); }
        }
      }
  }
};
struct EpiHG {
  static constexpr bool PERM = true;
  bf16_t *Q, *V, *G; _Float16 *LF0, *LF1; const float* LB;
  __device__ __forceinline__ void operator()(AccRef acc, const pg8::Unit& u, int wr, int wc, int fr, int fq) const {
    const int region = u.pn >> 1;
#pragma unroll
    for (int bj = 0; bj < 2; ++bj) {
      const int cl = (u.pn & 1) * 256 + bj * 128 + wc * 32 + fq * 8;
      float lb[8];
      if (region == 1 || region == 2) {
        const f32x4 a = *(const f32x4*)(LB + (region - 1) * 512 + cl), b = *(const f32x4*)(LB + (region - 1) * 512 + cl + 4);
        lb[0] = a[0]; lb[1] = a[1]; lb[2] = a[2]; lb[3] = a[3]; lb[4] = b[0]; lb[5] = b[1]; lb[6] = b[2]; lb[7] = b[3];
      } else {
#pragma unroll
        for (int j = 0; j < 8; ++j) lb[j] = 0.f;
      }
#pragma unroll
      for (int ai = 0; ai < 2; ++ai)
#pragma unroll
        for (int m = 0; m < 4; ++m) {
          const size_t off = (size_t)(u.pm * 256 + ai * 128 + wr * 64 + m * 16 + fr) * 512 + cl;
          f32x4 v0 = acc[ai][bj][m][0], v1 = acc[ai][bj][m][1];
          if (region == 0) {
#pragma unroll
            for (int j = 0; j < 4; ++j) { v0[j] = silu_f(v0[j]); v1[j] = silu_f(v1[j]); }
            *(u32x4*)(Q + off) = pack8(v0, v1);
          } else if (region == 1 || region == 2) {
            h16x8 hv;
#pragma unroll
            for (int j = 0; j < 4; ++j) {
              const float f0 = lb[j] + (1.f - lb[j]) * __builtin_amdgcn_rcpf(1.f + __expf(-v0[j])), f1 = lb[4 + j] + (1.f - lb[4 + j]) * __builtin_amdgcn_rcpf(1.f + __expf(-v1[j]));
              hv[j] = (_Float16)__logf(fmaxf(f0, 1e-30f)); hv[4 + j] = (_Float16)__logf(fmaxf(f1, 1e-30f));
            }
            *(h16x8*)((region == 1 ? LF0 : LF1) + off) = hv;
          } else if (region == 3) { *(u32x4*)(V + off) = pack8(v0, v1); }
          else { *(u32x4*)(G + off) = pack8(v0, v1); }
        }
    }
  }
};
struct EpiAB {
  static constexpr bool PERM = true;
  EpiZ z; EpiHG hg;
  __device__ __forceinline__ void operator()(AccRef acc, const pg8::Unit& u, int wr, int wc, int fr, int fq) const {
    if (u.pn < 4) z(acc, u, wr, wc, fr, fq);
    else { pg8::Unit v = u; v.pn = u.pn - 4; hg(acc, v, wr, wc, fr, fq); }
  }
};
struct EpiQKV {
  static constexpr bool PERM = true;
  bf16_t *QB, *KB, *VB;
  __device__ __forceinline__ void operator()(AccRef acc, const pg8::Unit& u, int wr, int wc, int fr, int fq) const {
#pragma unroll
    for (int ai = 0; ai < 2; ++ai)
#pragma unroll
      for (int m = 0; m < 4; ++m) {
        const int row = u.pm * 256 + ai * 128 + wr * 64 + m * 16 + fr;
        bf16_t* dst;
        if (u.pn < 4) dst = QB + (size_t)row * 1024 + u.pn * 256;
        else dst = (u.pn == 4 ? KB : VB) + (size_t)kvrow(row) * 256;
#pragma unroll
        for (int bj = 0; bj < 2; ++bj) *(u32x4*)(dst + bj * 128 + wc * 32 + fq * 8) = pack8(acc[ai][bj][m][0], acc[ai][bj][m][1]);
      }
  }
};
struct EpiRes {
  static constexpr bool PERM = false;
  float* X; float* CX; const float* gate; const float* Xsrc;
  __device__ __forceinline__ void operator()(AccRef acc, const pg8::Unit& u, int wr, int wc, int fr, int fq) const {
    const int row0 = u.pm * 256;
    const int mr = row0 < NLAT ? (row0 >> 12) : 8;
    const int colb = u.pn * 256 + wc * 32 + fq * 4;
    f32x4 gv[2][2];
#pragma unroll
    for (int bj = 0; bj < 2; ++bj)
#pragma unroll
      for (int n = 0; n < 2; ++n) gv[bj][n] = *(const f32x4*)(gate + (size_t)mr * 6144 + colb + bj * 128 + n * 16);
#pragma unroll
    for (int ai = 0; ai < 2; ++ai)
#pragma unroll
      for (int m = 0; m < 4; ++m) {
        const int row = row0 + ai * 128 + wr * 64 + m * 16 + fr;
        float* dst = (row < NLAT ? X + (size_t)row * 1024 : CX + (size_t)(row - NLAT) * 1024) + colb;
        const float* srcp = (row < NLAT ? Xsrc + (size_t)row * 1024 : CX + (size_t)(row - NLAT) * 1024) + colb;
#pragma unroll
        for (int bj = 0; bj < 2; ++bj)
#pragma unroll
          for (int n = 0; n < 2; ++n) { f32x4 xv = *(const f32x4*)(srcp + bj * 128 + n * 16); xv += gv[bj][n] * acc[ai][bj][m][n]; *(f32x4*)(dst + bj * 128 + n * 16) = xv; }
      }
  }
};
struct EpiPart {
  static constexpr bool PERM = false;
  float* PART; int ksub;
  __device__ __forceinline__ void operator()(AccRef acc, const pg8::Unit& u, int wr, int wc, int fr, int fq) const {
    float* base = PART + (size_t)(u.ko / ksub) * NCTX * 1024 + u.pn * 256 + wc * 32 + fq * 4;
#pragma unroll
    for (int ai = 0; ai < 2; ++ai)
#pragma unroll
      for (int m = 0; m < 4; ++m) {
        float* dst = base + (size_t)(u.pm * 256 + ai * 128 + wr * 64 + m * 16 + fr) * 1024;
#pragma unroll
        for (int bj = 0; bj < 2; ++bj)
#pragma unroll
          for (int n = 0; n < 2; ++n) *(f32x4*)(dst + bj * 128 + n * 16) = acc[ai][bj][m][n];
      }
  }
};
struct EpiUp {
  static constexpr bool PERM = true;
  bf16_t *GATE, *VAL;
  __device__ __forceinline__ void operator()(AccRef acc, const pg8::Unit& u, int wr, int wc, int fr, int fq) const {
    bf16_t* base = (u.pn < 11 ? GATE + u.pn * 256 : VAL + (u.pn - 11) * 256) + wc * 32 + fq * 8;
#pragma unroll
    for (int ai = 0; ai < 2; ++ai)
#pragma unroll
      for (int m = 0; m < 4; ++m) {
        bf16_t* dst = base + (size_t)(u.pm * 256 + ai * 128 + wr * 64 + m * 16 + fr) * 2816;
#pragma unroll
        for (int bj = 0; bj < 2; ++bj) *(u32x4*)(dst + bj * 128) = pack8(acc[ai][bj][m][0], acc[ai][bj][m][1]);
      }
  }
};
struct EpiDFT {
  static constexpr bool PERM = true;
  bf16_t* MIX; int ctxmode;
  __device__ __forceinline__ void operator()(AccRef acc, const pg8::Unit& u, int wr, int wc, int fr, int fq) const {
    const int b = u.pn >> 1;
    const int tok0 = ctxmode ? NLAT + b * 256 : b * 4096 + u.pm * 256;
    bf16_t* base = MIX + (u.pn & 1) * 256 + wc * 32 + fq * 8;
#pragma unroll
    for (int ai = 0; ai < 2; ++ai)
#pragma unroll
      for (int m = 0; m < 4; ++m) {
        bf16_t* dst = base + (size_t)(tok0 + ai * 128 + wr * 64 + m * 16 + fr) * 1024;
#pragma unroll
        for (int bj = 0; bj < 2; ++bj) *(u32x4*)(dst + bj * 128) = pack8(acc[ai][bj][m][0], acc[ai][bj][m][1]);
      }
  }
};
template <class Epi> __device__ __forceinline__ void run_gemm(unsigned char* lds, const bf16_t* A, const bf16_t* Bt, int M, int N, int K, const Epi& E) {
  pg8::Gemm g{A, Bt, M, N, K, K}; pg8::StaticOrder S; S.init(M, N, (int)gridDim.x, bid_());
  pg8::gemm_phase<Epi, pg8::StaticOrder>((PG8_LAS unsigned char*)lds, g, S, E);
}
template <class Epi> __device__ __forceinline__ void run_gemm_splitk(unsigned char* lds, const bf16_t* A, const bf16_t* Bt, int M, int N, int K, int ns, const Epi& E) {
  pg8::Gemm g{A, Bt, M, N, K / ns, K}; pg8::SplitKOrder S; S.init(M, N, ns, K / ns, (int)gridDim.x, bid_());
  pg8::gemm_phase<Epi, pg8::SplitKOrder>((PG8_LAS unsigned char*)lds, g, S, E);
}

namespace att {
constexpr int D = 128, NW = 8, QBLK = 32, KVBLK = 64;
constexpr float SCALE = 0.088388347648318440f;
constexpr float THR = 8.f;
constexpr int LDQ = 1024, LDK = 256, LDO = 1024;
constexpr size_t SHM_V = KVBLK * D * 2, SHM_K = KVBLK * D * 2;
#define KSWZ(row, colB) ((row) * 256 + ((colB) ^ (((row) & 7) << 4)))
#define SBAR() __builtin_amdgcn_sched_barrier(0)
__device__ __forceinline__ int crow(int r, int hi) { return (r & 3) + 8 * (r >> 2) + 4 * hi; }
__device__ __forceinline__ unsigned cvtpk(float lo, float hi) { return cvt_pk_bf16(lo, hi); }
__device__ __forceinline__ void partialSM(f32x16& p0, f32x16& p1, float& m_reg, float& mn, float& alpha) {
  constexpr float C = SCALE * 1.4426950408889634f;
  float pmax = p0[0]; _Pragma("unroll") for (int r = 1; r < 16; ++r) pmax = fmaxf(pmax, p0[r]); _Pragma("unroll") for (int r = 0; r < 16; ++r) pmax = fmaxf(pmax, p1[r]);
  { auto rr = __builtin_amdgcn_permlane32_swap(__float_as_uint(pmax), __float_as_uint(pmax), false, false);
    pmax = fmaxf(__uint_as_float(rr[0]), __uint_as_float(rr[1])); }
  if (__builtin_expect(__all(pmax - m_reg <= THR / SCALE), 1)) { mn = m_reg; alpha = 1.f; }
  else { mn = fmaxf(m_reg, pmax); alpha = __builtin_amdgcn_exp2f((m_reg - mn) * C); m_reg = mn; }
  float mnC = -mn * C;
  _Pragma("unroll") for (int r = 0; r < 16; ++r) p0[r] = fmaf(p0[r], C, mnC); _Pragma("unroll") for (int r = 0; r < 16; ++r) p1[r] = fmaf(p1[r], C, mnC);
  _Pragma("unroll") for (int r = 0; r < 16; ++r) p0[r] = __builtin_amdgcn_exp2f(p0[r]);
}
__device__ __forceinline__ void finishSM(f32x16& p0, f32x16& p1, float alpha, float& l_reg, bf16x8& pa0, bf16x8& pa1, bf16x8& pa2, bf16x8& pa3) {
  _Pragma("unroll") for (int r = 0; r < 16; ++r) p1[r] = __builtin_amdgcn_exp2f(p1[r]);
  float ps = 0; _Pragma("unroll") for (int r = 0; r < 16; ++r) ps += p0[r]; _Pragma("unroll") for (int r = 0; r < 16; ++r) ps += p1[r];
  { auto rr = __builtin_amdgcn_permlane32_swap(__float_as_uint(ps), __float_as_uint(ps), false, false);
    ps = __uint_as_float(rr[0]) + __uint_as_float(rr[1]); }
  l_reg = l_reg * alpha + ps;
#define PK4(Pv, BASE, OUT) do { unsigned a0 = cvtpk(Pv[BASE + 0], Pv[BASE + 1]), a1 = cvtpk(Pv[BASE + 2], Pv[BASE + 3]);   \
    unsigned b0 = cvtpk(Pv[BASE + 4], Pv[BASE + 5]), b1 = cvtpk(Pv[BASE + 6], Pv[BASE + 7]);                              \
    auto r0 = __builtin_amdgcn_permlane32_swap(a0, b0, false, false); auto r1 = __builtin_amdgcn_permlane32_swap(a1, b1, false, false); \
    u32x4 w = {r0[0], r1[0], r0[1], r1[1]}; OUT = *reinterpret_cast<bf16x8*>(&w); } while (0)
  PK4(p0, 0, pa0); PK4(p0, 8, pa1); PK4(p1, 0, pa2); PK4(p1, 8, pa3);
#undef PK4
}
__device__ __forceinline__ void qkt(f32x16& p0, f32x16& p1, const bf16_t* Ks, const bf16x8* qr, int r32, int hi) {
  p0 = f32x16{}; p1 = f32x16{};
  _Pragma("unroll") for (int d0 = 0; d0 < 8; ++d0) { int cb = (d0 * 16 + hi * 8) * 2;
    bf16x8 b0 = *reinterpret_cast<const bf16x8*>((const char*)Ks + KSWZ(r32, cb));
    bf16x8 b1 = *reinterpret_cast<const bf16x8*>((const char*)Ks + KSWZ(32 + r32, cb));
    p0 = __builtin_amdgcn_mfma_f32_32x32x16_bf16(b0, qr[d0], p0, 0, 0, 0);
    p1 = __builtin_amdgcn_mfma_f32_32x32x16_bf16(b1, qr[d0], p1, 0, 0, 0); }
}
__device__ __forceinline__ int v_st(int k, int c) { const int kk = (k & ~0xC) | ((k & 4) << 1) | ((k & 8) >> 1); return ((kk >> 3) * 4 + (c >> 5)) * 512 + ((kk & 7) * 32 + (c & 31)) * 2; }
__device__ __forceinline__ int v_rd_base(int lane) { return ((lane & 3) << 3) | (((lane >> 2) & 3) << 6) | (((lane >> 4) & 1) << 5) | (((lane >> 5) & 1) << 8); }
constexpr int v_rd_off(int d0, int ks, int half) { return d0 * 512 + ks * 4096 + half * 2048; }
template <int OFF> __device__ __forceinline__ s16x4 tr_read(int vb) {
  s16x4 r; asm volatile("ds_read_b64_tr_b16 %0, %1 offset:%2" : "=&v"(r) : "v"(vb), "i"(OFF) : "memory"); return r;
}
template <int D0> __device__ __forceinline__ void pv_one(f32x16& od, int vb, bf16x8 pa0, bf16x8 pa1, bf16x8 pa2, bf16x8 pa3) {
  const s16x4 l0 = tr_read<v_rd_off(D0, 0, 0)>(vb), h0 = tr_read<v_rd_off(D0, 0, 1)>(vb), l1 = tr_read<v_rd_off(D0, 1, 0)>(vb), h1 = tr_read<v_rd_off(D0, 1, 1)>(vb);
  const s16x4 l2 = tr_read<v_rd_off(D0, 2, 0)>(vb), h2 = tr_read<v_rd_off(D0, 2, 1)>(vb), l3 = tr_read<v_rd_off(D0, 3, 0)>(vb), h3 = tr_read<v_rd_off(D0, 3, 1)>(vb);
  asm volatile("s_waitcnt lgkmcnt(0)" ::: "memory"); SBAR();
#define PK(L, H) (bf16x8){L[0], L[1], L[2], L[3], H[0], H[1], H[2], H[3]}
  od = __builtin_amdgcn_mfma_f32_32x32x16_bf16(pa0, PK(l0, h0), od, 0, 0, 0);
  od = __builtin_amdgcn_mfma_f32_32x32x16_bf16(pa1, PK(l1, h1), od, 0, 0, 0);
  od = __builtin_amdgcn_mfma_f32_32x32x16_bf16(pa2, PK(l2, h2), od, 0, 0, 0);
  od = __builtin_amdgcn_mfma_f32_32x32x16_bf16(pa3, PK(l3, h3), od, 0, 0, 0);
#undef PK
}
__device__ __forceinline__ void pv_d0(f32x16* o, int vb, bf16x8 pa0, bf16x8 pa1, bf16x8 pa2, bf16x8 pa3) {
  pv_one<0>(o[0], vb, pa0, pa1, pa2, pa3); pv_one<1>(o[1], vb, pa0, pa1, pa2, pa3); pv_one<2>(o[2], vb, pa0, pa1, pa2, pa3); pv_one<3>(o[3], vb, pa0, pa1, pa2, pa3);
}
__device__ __forceinline__ void attn_dense_body(const bf16_t* __restrict__ Qb, const bf16_t* __restrict__ Kh, const bf16_t* __restrict__ Vh,
                                                bf16_t* __restrict__ Ob, int seq, char* lds) {
  const int tid = tid_(), wid = tid >> 6, lane = tid & 63, r32 = lane & 31, hi = lane >> 5;
  bf16_t* V_lds = (bf16_t*)lds; bf16_t* K_lds = (bf16_t*)(lds + 2 * SHM_V);
  float* ws = (float*)(lds + 2 * SHM_V + 2 * SHM_K) + wid * 64; float* li_l = ws; float* al_l = ws + 32;
  float m_reg = -1e30f, l_reg = 0; f32x16 o[4] = {}; bf16x8 qr[8];
  const bf16_t* Qw = Qb + (long)(wid * QBLK + r32) * LDQ + hi * 8;
_Pragma("unroll") for (int d0 = 0; d0 < 8; ++d0) qr[d0] = *reinterpret_cast<const bf16x8*>(Qw + d0 * 16);
  const int sr = tid >> 4, sc = (tid & 15) * 8, vst0 = v_st(sr, sc), vst1 = v_st(32 + sr, sc);
  const int vb0 = (int)(uintptr_t)V_lds + v_rd_base(lane);
  struct { bf16x8 vs0, vs1, ks0, ks1; } sr_[2];
#define SLOAD(i, k0) do { sr_[i].vs0 = *(const bf16x8*)(&Vh[(long)((k0) + sr) * LDK + sc]); sr_[i].vs1 = *(const bf16x8*)(&Vh[(long)((k0) + 32 + sr) * LDK + sc]); \
    sr_[i].ks0 = *(const bf16x8*)(&Kh[(long)((k0) + sr) * LDK + sc]); sr_[i].ks1 = *(const bf16x8*)(&Kh[(long)((k0) + 32 + sr) * LDK + sc]); } while (0)
#define SWRITE(b, i) do { *(bf16x8*)((char*)V_lds + (b) * SHM_V + vst0) = sr_[i].vs0;          \
    *(bf16x8*)((char*)V_lds + (b) * SHM_V + vst1) = sr_[i].vs1; int kc = sc * 2;               \
    *(bf16x8*)((char*)K_lds + (b) * SHM_K + KSWZ(sr, kc)) = sr_[i].ks0;                       \
    *(bf16x8*)((char*)K_lds + (b) * SHM_K + KSWZ(32 + sr, kc)) = sr_[i].ks1; } while (0)
#define SWAIT() asm volatile("s_waitcnt vmcnt(4)" ::: "memory")
#define RESC(a) do { if (__any((a) < 1.f)) { if (hi == 0) al_l[r32] = (a); asm volatile("s_waitcnt lgkmcnt(0)" ::: "memory"); \
    _Pragma("unroll") for (int d = 0; d < 4; ++d) _Pragma("unroll") for (int r = 0; r < 16; ++r) o[d][r] *= al_l[crow(r, hi)]; } } while (0)
  f32x16 pA0, pA1, pB0, pB1; float mnA, mnB, alA, alB; bf16x8 pa0, pa1, pa2, pa3; const int NT = seq / KVBLK;
  constexpr int SE = 0, SO = 1;
  SLOAD(SE, 0); asm volatile("s_waitcnt vmcnt(0)" ::: "memory"); SWRITE(0, SE); __syncthreads();
  qkt(pA0, pA1, K_lds, qr, r32, hi); partialSM(pA0, pA1, m_reg, mnA, alA);
  SLOAD(SO, KVBLK); if (2 < NT) SLOAD(SE, 2 * KVBLK);
  SWAIT(); SWRITE(1, SO); __syncthreads();
  for (int j = 1; j + 1 < NT; j += 2) {
    SBAR(); qkt(pB0, pB1, (bf16_t*)((char*)K_lds + SHM_K), qr, r32, hi);
    finishSM(pA0, pA1, alA, l_reg, pa0, pa1, pa2, pa3); SBAR();
    SLOAD(SO, (j + 2) * KVBLK); SBAR();
    pv_d0(o, vb0, pa0, pa1, pa2, pa3); partialSM(pB0, pB1, m_reg, mnB, alB);
    __syncthreads(); SWAIT(); SWRITE(0, SE);
    RESC(alB); __syncthreads();
    SBAR(); qkt(pA0, pA1, K_lds, qr, r32, hi);
    finishSM(pB0, pB1, alB, l_reg, pa0, pa1, pa2, pa3); SBAR();
    if (j + 3 < NT) SLOAD(SE, (j + 3) * KVBLK); SBAR();
    pv_d0(o, vb0 + (int)SHM_V, pa0, pa1, pa2, pa3); partialSM(pA0, pA1, m_reg, mnA, alA);
    __syncthreads(); SWAIT(); SWRITE(1, SO);
    RESC(alA); __syncthreads();
  }
  SBAR(); qkt(pB0, pB1, (bf16_t*)((char*)K_lds + SHM_K), qr, r32, hi);
  finishSM(pA0, pA1, alA, l_reg, pa0, pa1, pa2, pa3); SBAR();
  pv_d0(o, vb0, pa0, pa1, pa2, pa3); partialSM(pB0, pB1, m_reg, mnB, alB);
  __syncthreads(); RESC(alB);
  finishSM(pB0, pB1, alB, l_reg, pa0, pa1, pa2, pa3); SBAR();
  pv_d0(o, vb0 + (int)SHM_V, pa0, pa1, pa2, pa3);
  if (hi == 0) li_l[r32] = l_reg; asm volatile("s_waitcnt lgkmcnt(0)" ::: "memory");
  float rli[16];
_Pragma("unroll") for (int r = 0; r < 16; ++r) rli[r] = __builtin_amdgcn_rcpf(li_l[crow(r, hi)]);
  bf16_t* Ow = Ob + (long)(wid * QBLK) * LDO;
_Pragma("unroll") for (int r = 0; r < 16; ++r) { int orow = crow(r, hi);
    _Pragma("unroll") for (int d0 = 0; d0 < 4; ++d0) Ow[(long)orow * LDO + d0 * 32 + r32] = f2bf(o[d0][r] * rli[r]); }
#undef SLOAD
#undef SWRITE
#undef SWAIT
#undef RESC
}
}

__device__ __forceinline__ void mod_gemv(const P& p, unsigned char* lds, int l_lo, int l_hi, int wg, int nwg) {
  const int tid = tid_();
  float* MOD = (float*)(p.ws + OFF_MOD);
  float* sc = (float*)lds;
  float* red = sc + 9 * 1024;
  for (int i = tid; i < 9 * 1024; i += 512) { const int r = i >> 10, k = i & 1023; const float v = r < 8 ? p.c[r * 1024 + k] : p.c_ctx[k]; sc[i] = v / (1.f + expf(-v)); }
  __syncthreads();
  const int ng = tid & 31, kg = tid >> 5;
  for (int it = wg < 0 ? l_hi * 48 : l_lo * 48 + wg; it < l_hi * 48; it += nwg) {
    const int l = it / 48, nb = (it % 48) * 128;
    const float* w = p.w_mod + ((size_t)l * 1024 + kg * 64) * 6144 + nb + ng * 4;
    float acc[9][4];
#pragma unroll
    for (int r = 0; r < 9; ++r) { acc[r][0] = 0.f; acc[r][1] = 0.f; acc[r][2] = 0.f; acc[r][3] = 0.f; }
#pragma unroll 4
    for (int k = 0; k < 64; ++k) {
      const f32x4 wv = *(const f32x4*)(w + (size_t)k * 6144);
#pragma unroll
      for (int r = 0; r < 9; ++r) { const float s = sc[r * 1024 + kg * 64 + k]; acc[r][0] += s * wv[0]; acc[r][1] += s * wv[1]; acc[r][2] += s * wv[2]; acc[r][3] += s * wv[3]; }
    }
#pragma unroll
    for (int r = 0; r < 9; ++r) { float* d = red + (kg * 9 + r) * 128 + ng * 4; d[0] = acc[r][0]; d[1] = acc[r][1]; d[2] = acc[r][2]; d[3] = acc[r][3]; }
    __syncthreads();
    for (int o = tid; o < 9 * 128; o += 512) { const int r = o >> 7, n = o & 127; float s = 0.f;
      for (int g = 0; g < 16; ++g) s += red[(g * 9 + r) * 128 + n];
      MOD[(size_t)(l * 9 + r) * 6144 + nb + n] = s + p.b_mod[l * 6144 + nb + n]; }
    __syncthreads();
  }
}
__device__ __forceinline__ void ph0(const P& p, unsigned char* lds) {
  mod_gemv(p, lds, 0, 1, bid_(), (int)gridDim.x);
  const int tid = tid_();
  const int gtid = bid_() * 512 + tid, gsz = gridDim.x * 512;
  float* LB = (float*)(p.ws + OFF_LB);
  for (int i = gtid; i < 1024; i += gsz) { const float a0 = p.hg_lb[i], a1 = p.hg_lb[1024 + i]; LB[i] = 0.f; LB[1024 + i] = 1.f / (1.f + expf(a0 - a1)); }
  { float* ROPE = (float*)(p.ws + OFF_ROPE);
    for (int i = gtid; i < 64 * 32; i += gsz) { const int pos = i >> 5, j = i & 31; const float fr = exp2f(-(float)j * (13.287712379549449f / 32.f)); float sn, cs; sincosf((float)pos * fr, &sn, &cs); ROPE[2 * i] = cs; ROPE[2 * i + 1] = sn; } }
  bf16_t* CM256 = (bf16_t*)(p.ws + OFF_CM256);
  for (int i = gtid; i < 256 * 256; i += gsz) { const int k = i >> 8, j = i & 255; float s, c; sincospif((float)((k * j) & 255) * (1.f / 128.f), &s, &c);
    CM256[k * 512 + j] = f2bf(c * 0.0625f); CM256[k * 512 + 256 + j] = f2bf(-s * 0.0625f); }
}

__device__ __forceinline__ void modulate_rows(const P& p, int l, int which, int nrows, bool first, const float* fixP, const float* fixG) {
  const int tid = tid_(), wave = tid >> 6, lane = tid & 63;
  const GA float* MOD = (const GA float*)(p.ws + OFF_MOD);
  GA float* CX = (GA float*)(p.ws + OFF_CTXR);
  GA bf16_t* HB = (GA bf16_t*)(p.ws + OFF_HB);
  for (int row0 = bid_() * 16 + wave; row0 < nrows; row0 += gridDim.x * 16) {
    const bool lat = row0 < NLAT;
    const GA float* src = (const GA float*)(first ? (lat ? p.x + (size_t)row0 * 1024 : p.ctx + (size_t)(row0 - NLAT) * 1024) : (lat ? p.out + (size_t)row0 * 1024 : (float*)CX + (size_t)(row0 - NLAT) * 1024));
    f32x4 v[2][4]; float ss0 = 0.f, ss1 = 0.f;
#pragma unroll
    for (int j = 0; j < 4; ++j) { v[0][j] = *(const GA f32x4*)(src + j * 256 + lane * 4); v[1][j] = *(const GA f32x4*)(src + 8 * 1024 + j * 256 + lane * 4); }
    if (!lat && fixP) {
      const GA float* P0 = (const GA float*)fixP + (size_t)(row0 - NLAT) * 1024; const GA float* G0 = (const GA float*)fixG; GA float* xw = CX + (size_t)(row0 - NLAT) * 1024;
#pragma unroll
      for (int j = 0; j < 4; ++j) { const int col = j * 256 + lane * 4; const f32x4 g4 = *(const GA f32x4*)(G0 + col);
        v[0][j] += g4 * (*(const GA f32x4*)(P0 + col) + *(const GA f32x4*)(P0 + (size_t)NCTX * 1024 + col));
        v[1][j] += g4 * (*(const GA f32x4*)(P0 + 8 * 1024 + col) + *(const GA f32x4*)(P0 + (size_t)NCTX * 1024 + 8 * 1024 + col));
        *(GA f32x4*)(xw + col) = v[0][j]; *(GA f32x4*)(xw + 8 * 1024 + col) = v[1][j]; }
    }
    const GA float* sh = MOD + (size_t)(l * 9 + (lat ? (row0 >> 12) : 8)) * 6144 + (which ? 3072 : 0);
    f32x4 s4[4], c4[4];
#pragma unroll
    for (int j = 0; j < 4; ++j) { s4[j] = *(const GA f32x4*)(sh + j * 256 + lane * 4); c4[j] = *(const GA f32x4*)(sh + 1024 + j * 256 + lane * 4); }
#pragma unroll
    for (int j = 0; j < 4; ++j) { ss0 += v[0][j][0] * v[0][j][0] + v[0][j][1] * v[0][j][1] + v[0][j][2] * v[0][j][2] + v[0][j][3] * v[0][j][3];
      ss1 += v[1][j][0] * v[1][j][0] + v[1][j][1] * v[1][j][1] + v[1][j][2] * v[1][j][2] + v[1][j][3] * v[1][j][3]; }
    ss0 = wave_sum(ss0); ss1 = wave_sum(ss1);
    const float rs0 = rsqrtf(ss0 * (1.f / 1024.f) + EPS), rs1 = rsqrtf(ss1 * (1.f / 1024.f) + EPS);
    if (first && !lat) { GA float* dst = (GA float*)((float*)CX + (size_t)(row0 - NLAT) * 1024);
#pragma unroll
      for (int j = 0; j < 4; ++j) { *(GA f32x4*)(dst + j * 256 + lane * 4) = v[0][j]; *(GA f32x4*)(dst + 8 * 1024 + j * 256 + lane * 4) = v[1][j]; } }
#pragma unroll
    for (int j = 0; j < 4; ++j) { const int col = j * 256 + lane * 4;
      f32x4 h0, h1; for (int q = 0; q < 4; ++q) { h0[q] = v[0][j][q] * rs0 * (1.f + c4[j][q]) + s4[j][q]; h1[q] = v[1][j][q] * rs1 * (1.f + c4[j][q]) + s4[j][q]; }
      u32x2 w0, w1; w0.x = cvt_pk_bf16(h0[0], h0[1]); w0.y = cvt_pk_bf16(h0[2], h0[3]); w1.x = cvt_pk_bf16(h1[0], h1[1]); w1.y = cvt_pk_bf16(h1[2], h1[3]);
      *(GA u32x2*)(HB + (size_t)row0 * 1024 + col) = w0; *(GA u32x2*)(HB + (size_t)(row0 + 8) * 1024 + col) = w1; }
  }
}

__device__ __forceinline__ void convert_weights(const P& p, int l, unsigned char* lds, int wg, int nwg, int jlo = 0, int jhi = 4) {
  float* tile = (float*)lds;
  const int tid = tid_(), e = l >> 1; const bool even = !(l & 1);
  bf16_t* W1 = (bf16_t*)(p.ws + OFF_W1); bf16_t* W2 = (bf16_t*)(p.ws + OFF_W2); bf16_t* W3 = (bf16_t*)(p.ws + OFF_W3); bf16_t* W4 = (bf16_t*)(p.ws + ((l & 1) ? OFF_W4B : OFF_W4));
  if (wg < 0) return;
  int base = 0;
#pragma unroll 1
  for (int j = jlo; j < jhi; ++j) {
    const float* W; int K, N, ldw; bf16_t* Wt;
    if (j == 0) { if (even) { W = p.w_in_ab + (size_t)e * 1024 * 3072 + 512; K = 1024; N = 2560; ldw = 3072; Wt = W1 + 1024 * 1024; } else { W = p.w_qkv + (size_t)e * 1024 * 1536; K = 1024; N = 1536; ldw = 1536; Wt = W1; } }
    else if (j == 1) { W = (even ? p.w_out_ab : p.w_out_att) + (size_t)e * 1024 * 1024; K = 1024; N = 1024; ldw = 1024; Wt = W2; }
    else if (j == 2) { W = p.w_up + (size_t)l * 1024 * 5632; K = 1024; N = 5632; ldw = 5632; Wt = W3; }
    else { W = p.w_down + (size_t)l * 2816 * 1024; K = 2816; N = 1024; ldw = 1024; Wt = W4; }
    const int tn = N / 64, nt = (K / 64) * tn;
    int t0 = (wg - base) % nwg; if (t0 < 0) t0 += nwg;
    for (int t = t0; t < nt; t += nwg) {
      const int k0 = (t / tn) * 64, n0 = (t % tn) * 64;
#pragma unroll
      for (int i = 0; i < 2; ++i) { const int idx = tid + i * 512, kr = idx >> 4, nc = (idx & 15) * 4;
        const f32x4 v = *(const f32x4*)(W + (size_t)(k0 + kr) * ldw + n0 + nc);
        tile[kr * 65 + nc] = v[0]; tile[kr * 65 + nc + 1] = v[1]; tile[kr * 65 + nc + 2] = v[2]; tile[kr * 65 + nc + 3] = v[3]; }
      __syncthreads();
      { const int n = tid >> 3, kg = (tid & 7) * 8; u32x4 w;
        w.x = cvt_pk_bf16(tile[(kg + 0) * 65 + n], tile[(kg + 1) * 65 + n]); w.y = cvt_pk_bf16(tile[(kg + 2) * 65 + n], tile[(kg + 3) * 65 + n]);
        w.z = cvt_pk_bf16(tile[(kg + 4) * 65 + n], tile[(kg + 5) * 65 + n]); w.w = cvt_pk_bf16(tile[(kg + 6) * 65 + n], tile[(kg + 7) * 65 + n]);
        *(u32x4*)(Wt + (size_t)(n0 + n) * K + k0 + kg) = w; }
      __syncthreads();
    }
    base = (base + nt) % nwg;
  }
}

__device__ __forceinline__ void fold_dft(const P& p, int e, unsigned char* lds, int wg, int nwg) {
  LAS3 float* wt = (LAS3 float*)lds;
  LAS3 float* tc = wt + 16 * 129; LAS3 float* ts = tc + 128;
  const int tid = tid_();
  GA bf16_t* W1 = (GA bf16_t*)(p.ws + OFF_W1);
  const GA float* Wa = (const GA float*)(p.w_in_ab + (size_t)e * 1024 * 3072);
  __syncthreads();
  if (tid < 128) { float s, c; sincospif((float)tid * (1.f / 64.f), &s, &c); tc[tid] = c * 0.08838834764831845f; ts[tid] = s * 0.08838834764831845f; }
  for (int t = wg < 0 ? 256 : wg; t < 256; t += nwg) {
    const int kk0 = (t >> 2) * 16, g = t & 3;
    __syncthreads();
    for (int i = tid; i < 16 * 128; i += 512) { const int r = i >> 7, c = i & 127; wt[r * 129 + c] = Wa[(size_t)(kk0 + r) * 3072 + g * 128 + c]; }
    __syncthreads();
    const int kk = tid & 15, mw = tid >> 4;
    float ac[4], as[4];
#pragma unroll
    for (int i = 0; i < 4; ++i) { ac[i] = 0.f; as[i] = 0.f; }
    for (int c = 0; c < 128; ++c) { const float w = wt[kk * 129 + c];
#pragma unroll
      for (int i = 0; i < 4; ++i) { const int idx = (c * (mw + 32 * i)) & 127; ac[i] += w * tc[idx]; as[i] += w * ts[idx]; } }
#pragma unroll
    for (int i = 0; i < 4; ++i) { const int m = mw + 32 * i;
      W1[(size_t)(g * 128 + m) * 1024 + kk0 + kk] = f2bf(ac[i]); W1[(size_t)(512 + g * 128 + m) * 1024 + kk0 + kk] = f2bf(as[i]); }
  }
  __syncthreads();
}
__device__ __forceinline__ void gen_cm(const P& p, unsigned char* lds) {
  LAS3 bf16_t* tcos = (LAS3 bf16_t*)lds; LAS3 bf16_t* tsin = tcos + 4096;
  const int tid = tid_();
  __syncthreads();
  for (int j = tid; j < 4096; j += 512) { float s, c; sincospif((float)j * (1.f / 2048.f), &s, &c); tcos[j] = f2bf(c * 0.015625f); tsin[j] = f2bf(-s * 0.015625f); }
  __syncthreads();
  GA bf16_t* CM2 = (GA bf16_t*)(p.ws + OFF_CM2);
  const int gsz = gridDim.x * 512;
  for (int it = bid_() * 512 + tid; it < 4096 * 512; it += gsz) {
    const int k = it >> 9, j0 = (it & 511) * 8; unsigned w[4];
    const bool sinp = j0 >= 2048; const int jb = sinp ? j0 - 2048 : j0;
#pragma unroll
    for (int j = 0; j < 4; ++j) { const int i0 = (k * (jb + 2 * j)) & 4095, i1 = (i0 + k) & 4095;
      unsigned lo = sinp ? (unsigned)tsin[i0] : (unsigned)tcos[i0]; const unsigned hi = sinp ? (unsigned)tsin[i1] : (unsigned)tcos[i1];
      if (j == 0 && j0 == 2048) lo = (unsigned)tcos[(k * 2048) & 4095];
      w[j] = lo | (hi << 16); }
    u32x4 wv = {w[0], w[1], w[2], w[3]};
    *(GA u32x4*)(CM2 + (size_t)k * 4096 + j0) = wv;
  }
  __syncthreads();
}
__device__ __forceinline__ void ph_fold(const P& p, unsigned char* lds) {
  LAS3 bf16_t* T = (LAS3 bf16_t*)lds;
  const int tid = tid_();
  const GA bf16_t* Z = (const GA bf16_t*)(p.ws + OFF_ZT); GA bf16_t* ZF = (GA bf16_t*)(p.ws + OFF_ZF);
  const int tl = tid >> 3, mg = (tid & 7) * 8;
  const int mo = tid >> 3, tg = (tid & 7) * 8;
  for (int it = bid_(); it < 4096; it += gridDim.x) {
    const int part = it & 1, mt = (it >> 1) & 7, tt = (it >> 4) & 31, b = it >> 9;
    const int t = tt * 64 + tl, m0 = mt * 64;
    const GA bf16_t* zb = Z + (size_t)b * 4096 * 1024 + part * 512 + m0 + mg;
    u32x4 A = *(const GA u32x4*)(zb + (size_t)t * 1024);
    const u32x4 Bm = *(const GA u32x4*)(zb + (size_t)((4096 - t) & 4095) * 1024);
    if (part == 1 && t == 0) A = *(const GA u32x4*)(Z + ((size_t)b * 4096 + 2048) * 1024 + m0 + mg);
    unsigned o[4];
#pragma unroll
    for (int q = 0; q < 4; ++q) {
      float lo = bflo(A[q]), hi = bfhi(A[q]);
      if (t != 0) { if (part == 0) { lo += bflo(Bm[q]); hi += bfhi(Bm[q]); } else { lo -= bflo(Bm[q]); hi -= bfhi(Bm[q]); } }
      o[q] = cvt_pk_bf16(lo, hi);
    }
    __syncthreads();
#pragma unroll
    for (int q = 0; q < 4; ++q) *(LAS3 unsigned*)(T + tl * 66 + mg + 2 * q) = o[q];
    __syncthreads();
    unsigned w[4];
#pragma unroll
    for (int q = 0; q < 4; ++q) w[q] = (unsigned)T[(tg + 2 * q) * 66 + mo] | ((unsigned)T[(tg + 2 * q + 1) * 66 + mo] << 16);
    u32x4 wv = {w[0], w[1], w[2], w[3]};
    *(GA u32x4*)(ZF + ((size_t)b * 512 + m0 + mo) * 4096 + part * 2048 + tt * 64 + tg) = wv;
  }
  __syncthreads();
}

__device__ __forceinline__ int tcidx(int tb, int dir) { return dir ? (tb < 4 ? 3 - tb : 71 - tb) : tb; }
__device__ __forceinline__ int rowbase_of(int b, int tb) { return tb < 4 ? NLAT + b * 256 + tb * 64 : b * 4096 + (tb - 4) * 64; }
__device__ __forceinline__ void chunk_cumsum(const GA _Float16* LFc, int rowbase, int dir, int tq, int kch, LAS3 float* totl, float (&lf)[16], float (&bc)[16], float& T0, float& T1, float& T2, float& T3) {
#pragma unroll
  for (int i = 0; i < 16; ++i) { const int tau = 16 * tq + i, pp = dir ? 63 - tau : tau; lf[i] = (float)LFc[(size_t)(rowbase + pp) * 512]; }
  float run = 0.f;
#pragma unroll
  for (int i = 0; i < 16; ++i) { run += lf[i]; bc[i] = run; }
  totl[tq * 128 + kch] = run;
  __syncthreads();
  T0 = totl[kch]; T1 = totl[128 + kch]; T2 = totl[256 + kch]; T3 = totl[384 + kch];
  const float off = tq == 0 ? 0.f : (tq == 1 ? T0 : (tq == 2 ? T0 + T1 : T0 + T1 + T2));
#pragma unroll
  for (int i = 0; i < 16; ++i) bc[i] += off;
}
typedef unsigned short us2_t __attribute__((ext_vector_type(2)));
#define US2U(v) __builtin_bit_cast(unsigned, v)
__device__ __forceinline__ void ld16(unsigned& r, const bf16_t* sbase, unsigned voff) { asm volatile("global_load_ushort %0, %1, %2" : "=v"(r) : "v"(voff), "s"(sbase)); }
#define RAW_WAIT16(a) asm volatile("s_waitcnt vmcnt(0)" : "+v"(a[0]), "+v"(a[1]), "+v"(a[2]), "+v"(a[3]), "+v"(a[4]), "+v"(a[5]), "+v"(a[6]), "+v"(a[7]), \
    "+v"(a[8]), "+v"(a[9]), "+v"(a[10]), "+v"(a[11]), "+v"(a[12]), "+v"(a[13]), "+v"(a[14]), "+v"(a[15]) :: "memory")
__device__ __forceinline__ void pack2(const unsigned (&r)[16], us2_t (&pk)[8]) {
#pragma unroll
  for (int i = 0; i < 8; ++i) { pk[i].x = (unsigned short)r[2 * i]; pk[i].y = (unsigned short)r[2 * i + 1]; }
}
__device__ __forceinline__ void h1_load_raw(const P& p, int rowbase, int h, int dir, int tq, int kch, unsigned (&lfr)[16], unsigned (&vr)[16]) {
  const bf16_t* LFb = (const bf16_t*)(p.ws + (dir ? OFF_LF1 : OFF_LF0)) + (size_t)rowbase * 512 + h * 128;
  const bf16_t* Vb = (const bf16_t*)(p.ws + OFF_V) + (size_t)rowbase * 512 + h * 128;
#pragma unroll
  for (int i = 0; i < 16; ++i) { const int tau = 16 * tq + i, pp = dir ? 63 - tau : tau; const unsigned o0 = (unsigned)(pp * 1024 + kch * 2); ld16(lfr[i], LFb, o0); ld16(vr[i], Vb, o0); }
}
__device__ __forceinline__ void h3_load_raw(const P& p, int rowbase, int h, int dir, int tq, int kch, unsigned (&lfr)[16], unsigned (&qr)[16]) {
  const bf16_t* LFb = (const bf16_t*)(p.ws + (dir ? OFF_LF1 : OFF_LF0)) + (size_t)rowbase * 512 + h * 128;
  const bf16_t* Qb = (const bf16_t*)(p.ws + OFF_Q) + (size_t)rowbase * 512 + h * 128;
#pragma unroll
  for (int i = 0; i < 16; ++i) { const int tau = 16 * tq + i, pp = dir ? 63 - tau : tau; const unsigned o0 = (unsigned)(pp * 1024 + kch * 2); ld16(lfr[i], LFb, o0); ld16(qr[i], Qb, o0); }
}
__device__ __forceinline__ void h_load_raw(const P& p, int rowbase, int h, int dir, int tq, int kch, bool needq, us2_t (&lfr)[8], us2_t (&vr)[8], us2_t (&qr)[8]) {
  const GA bf16_t* LFc = (const GA bf16_t*)(p.ws + (dir ? OFF_LF1 : OFF_LF0)) + h * 128 + kch;
  const GA bf16_t* V = (const GA bf16_t*)(p.ws + OFF_V) + h * 128 + kch; const GA bf16_t* Q = (const GA bf16_t*)(p.ws + OFF_Q) + h * 128 + kch;
#pragma unroll
  for (int i = 0; i < 8; ++i) { const int tau = 16 * tq + 2 * i, p0 = dir ? 63 - tau : tau, p1 = dir ? p0 - 1 : p0 + 1; const size_t g0 = (size_t)(rowbase + p0) * 512, g1 = (size_t)(rowbase + p1) * 512;
    lfr[i].x = LFc[g0]; lfr[i].y = LFc[g1]; vr[i].x = V[g0]; vr[i].y = V[g1]; if (needq) { qr[i].x = Q[g0]; qr[i].y = Q[g1]; } }
}
__device__ __forceinline__ float h16bits(unsigned short w) { return (float)__builtin_bit_cast(_Float16, w); }
__device__ __forceinline__ void chunk_cumsum_raw(const us2_t (&lfr)[8], int tq, int kch, LAS3 float* totl, float (&lf)[16], float (&bc)[16], float& T0, float& T1, float& T2, float& T3) {
  float run = 0.f;
#pragma unroll
  for (int i = 0; i < 16; ++i) { lf[i] = h16bits((i & 1) ? lfr[i >> 1].y : lfr[i >> 1].x); run += lf[i]; bc[i] = run; }
  totl[tq * 128 + kch] = run;
  __syncthreads();
  T0 = totl[kch]; T1 = totl[128 + kch]; T2 = totl[256 + kch]; T3 = totl[384 + kch];
  const float off = tq == 0 ? 0.f : (tq == 1 ? T0 : (tq == 2 ? T0 + T1 : T0 + T1 + T2));
#pragma unroll
  for (int i = 0; i < 16; ++i) bc[i] += off;
}
__device__ __forceinline__ void ph_h1(const P& p, unsigned char* lds) {
  const int tid = tid_(), wid = tid >> 6, lane = tid & 63, r32 = lane & 31, hi = lane >> 5, kch = tid & 127, tq = tid >> 7;
  LAS3 bf16_t* KD = (LAS3 bf16_t*)lds;
  LAS3 bf16_t* VT = KD + 128 * 72;
  LAS3 float* totl = (LAS3 float*)(VT + 128 * 72);
  const GA bf16_t* V = (const GA bf16_t*)(p.ws + OFF_V);
  GA bf16_t* ST = (GA bf16_t*)(p.ws + OFF_ST); GA float* DEC = (GA float*)(p.ws + OFF_DEC);
  const int ti = wid >> 1;
  const int GS = gridDim.x;
  us2_t lfA[8], vv[8]; unsigned lfN[16], vN[16];
  { const int it0 = bid_(); if (it0 < 4352) { const int rest = it0 >> 3; h1_load_raw(p, rowbase_of(rest / 68, rest % 68), (it0 >> 1) & 3, it0 & 1, tq, kch, lfN, vN); RAW_WAIT16(lfN); RAW_WAIT16(vN); pack2(lfN, lfA); pack2(vN, vv); } }
  for (int it = bid_(); it < 4352; it += GS) {
    const int dir = it & 1, h = (it >> 1) & 3, rest = it >> 3, tb = rest % 68, b = rest / 68;
    const int tc = tcidx(tb, dir), stream = (b * 4 + h) * 2 + dir;
    { const int itn = it + GS; if (itn < 4352) { const int restn = itn >> 3; h1_load_raw(p, rowbase_of(restn / 68, restn % 68), (itn >> 1) & 3, itn & 1, tq, kch, lfN, vN); } }
    float lf[16], bc[16], T0, T1, T2, T3;
    chunk_cumsum_raw(lfA, tq, kch, totl, lf, bc, T0, T1, T2, T3);
    const float blast = T0 + T1 + T2 + T3;
    float kd[16];
#pragma unroll
    for (int i = 0; i < 16; ++i) kd[i] = (1.f - __expf(lf[i])) * __expf(blast - bc[i]);
    u32x4 w0, w1;
    w0.x = cvt_pk_bf16(kd[0], kd[1]); w0.y = cvt_pk_bf16(kd[2], kd[3]); w0.z = cvt_pk_bf16(kd[4], kd[5]); w0.w = cvt_pk_bf16(kd[6], kd[7]);
    w1.x = cvt_pk_bf16(kd[8], kd[9]); w1.y = cvt_pk_bf16(kd[10], kd[11]); w1.z = cvt_pk_bf16(kd[12], kd[13]); w1.w = cvt_pk_bf16(kd[14], kd[15]);
    *(LAS3 u32x4*)(KD + kch * 72 + 16 * tq) = w0; *(LAS3 u32x4*)(KD + kch * 72 + 16 * tq + 8) = w1;
    w0.x = US2U(vv[0]); w0.y = US2U(vv[1]); w0.z = US2U(vv[2]); w0.w = US2U(vv[3]); w1.x = US2U(vv[4]); w1.y = US2U(vv[5]); w1.z = US2U(vv[6]); w1.w = US2U(vv[7]);
    *(LAS3 u32x4*)(VT + kch * 72 + 16 * tq) = w0; *(LAS3 u32x4*)(VT + kch * 72 + 16 * tq + 8) = w1;
    if (tq == 0) DEC[(size_t)(stream * 68 + tc) * 128 + kch] = __expf(blast);
    __syncthreads();
    GA bf16_t* UT = ST + (size_t)(stream * 68 + tc) * 16384;
#pragma unroll
    for (int jj = 0; jj < 2; ++jj) {
      const int tj = (wid & 1) * 2 + jj;
      f32x16 acc = {};
#pragma unroll
      for (int ks = 0; ks < 4; ++ks) {
        const bf16x8 a = *(const LAS3 bf16x8*)(KD + (32 * ti + r32) * 72 + ks * 16 + hi * 8);
        const bf16x8 bq = *(const LAS3 bf16x8*)(VT + (32 * tj + r32) * 72 + ks * 16 + hi * 8);
        acc = __builtin_amdgcn_mfma_f32_32x32x16_bf16(a, bq, acc, 0, 0, 0);
      }
#pragma unroll
      for (int rg = 0; rg < 4; ++rg) { u32x2 w; w.x = cvt_pk_bf16(acc[4 * rg], acc[4 * rg + 1]); w.y = cvt_pk_bf16(acc[4 * rg + 2], acc[4 * rg + 3]);
        *(GA u32x2*)(UT + (size_t)(32 * tj + r32) * 128 + 32 * ti + 8 * rg + 4 * hi) = w; }
    }
    if (it + GS < 4352) { RAW_WAIT16(lfN); RAW_WAIT16(vN); pack2(lfN, lfA); pack2(vN, vv); }
  }
}
__device__ __forceinline__ void ph_h2(const P& p) {
  GA bf16_t* ST = (GA bf16_t*)(p.ws + OFF_ST); const GA float* DEC = (const GA float*)(p.ws + OFF_DEC);
  for (int idx = bid_() * 512 + tid_(); idx < 64 * 2048; idx += gridDim.x * 512) {
    const int stream = idx >> 11, e8 = idx & 2047, k0 = (e8 & 15) * 8;
    GA bf16_t* base = ST + (size_t)stream * 68 * 16384 + e8 * 8; const GA float* dec = DEC + (size_t)stream * 68 * 128 + k0;
    float S[8];
#pragma unroll
    for (int j = 0; j < 8; ++j) S[j] = 0.f;
#pragma unroll 1
    for (int t0 = 0; t0 < 68; t0 += 4) {
      u32x4 u[4]; f32x4 d0[4], d1[4];
#pragma unroll
      for (int q = 0; q < 4; ++q) { u[q] = *(const GA u32x4*)(base + (size_t)(t0 + q) * 16384); d0[q] = *(const GA f32x4*)(dec + (t0 + q) * 128); d1[q] = *(const GA f32x4*)(dec + (t0 + q) * 128 + 4); }
#pragma unroll
      for (int q = 0; q < 4; ++q) {
        u32x4 w; w.x = cvt_pk_bf16(S[0], S[1]); w.y = cvt_pk_bf16(S[2], S[3]); w.z = cvt_pk_bf16(S[4], S[5]); w.w = cvt_pk_bf16(S[6], S[7]);
        *(GA u32x4*)(base + (size_t)(t0 + q) * 16384) = w;
        S[0] = d0[q][0] * S[0] + bflo(u[q].x); S[1] = d0[q][1] * S[1] + bfhi(u[q].x); S[2] = d0[q][2] * S[2] + bflo(u[q].y); S[3] = d0[q][3] * S[3] + bfhi(u[q].y);
        S[4] = d1[q][0] * S[4] + bflo(u[q].z); S[5] = d1[q][1] * S[5] + bfhi(u[q].z); S[6] = d1[q][2] * S[6] + bflo(u[q].w); S[7] = d1[q][3] * S[7] + bfhi(u[q].w);
      }
    }
  }
}
__device__ __forceinline__ void ph_h3(const P& p, int e, unsigned char* lds) {
  const int tid = tid_(), wid = tid >> 6, lane = tid & 63, r32 = lane & 31, hi = lane >> 5, kch = tid & 127, tq = tid >> 7;
  LAS3 bf16_t* QBt = (LAS3 bf16_t*)lds;
  LAS3 bf16_t* QXt = QBt + 64 * 136;
  LAS3 bf16_t* KXt = QXt + 64 * 136;
  LAS3 bf16_t* YTt = KXt + 64 * 136;
  LAS3 bf16_t* VTt = YTt + 64 * 136;
  LAS3 bf16_t* ATt = VTt + 128 * 72;
  LAS3 float* totl = (LAS3 float*)(ATt + 64 * 72);
  LAS3 float* OT = (LAS3 float*)lds;
  const GA bf16_t* Q = (const GA bf16_t*)(p.ws + OFF_Q); const GA bf16_t* V = (const GA bf16_t*)(p.ws + OFF_V); const GA bf16_t* G = (const GA bf16_t*)(p.ws + OFF_G);
  const GA bf16_t* ST = (const GA bf16_t*)(p.ws + OFF_ST); GA bf16_t* MIX = (GA bf16_t*)(p.ws + OFF_MIX);
  const GA float* gn = (const GA float*)(p.hg_ng + e * 512);
  const int ti = wid >> 2, tj = wid & 3;
  const int GS = gridDim.x;
  us2_t lfA[8], qraw[8]; unsigned lfN[16], qN[16];
  { const int it0 = bid_(); if (it0 < 2176) { const int rest = it0 >> 2; h3_load_raw(p, rowbase_of(rest / 68, rest % 68), it0 & 3, 0, tq, kch, lfN, qN); RAW_WAIT16(lfN); RAW_WAIT16(qN); pack2(lfN, lfA); pack2(qN, qraw); } }
  const int ppv = tid >> 3, cgv = tid & 7;
  for (int it = bid_(); it < 2176; it += GS) {
    const int h = it & 3, rest = it >> 2, tb = rest % 68, b = rest / 68;
    const int rowbase = rowbase_of(b, tb);
    f32x16 o = {};
#pragma unroll 1
    for (int dir = 0; dir < 2; ++dir) {
      const int tc = tcidx(tb, dir), stream = (b * 4 + h) * 2 + dir;
      const GA bf16_t* Sg = ST + (size_t)(stream * 68 + tc) * 16384;
      bf16x8 sfr[8];
#pragma unroll
      for (int ks = 0; ks < 8; ++ks) sfr[ks] = *(const GA bf16x8*)(Sg + (size_t)(32 * tj + r32) * 128 + ks * 16 + hi * 8);
      u32x4 vw0, vw1;
      if (dir == 0) { const GA bf16_t* vp = V + (size_t)(rowbase + ppv) * 512 + h * 128 + cgv * 16; vw0 = *(const GA u32x4*)vp; vw1 = *(const GA u32x4*)(vp + 8); }
      if (dir == 0) h3_load_raw(p, rowbase, h, 1, tq, kch, lfN, qN);
      else { const int itn = it + GS; if (itn < 2176) { const int restn = itn >> 2; h3_load_raw(p, rowbase_of(restn / 68, restn % 68), itn & 3, 0, tq, kch, lfN, qN); } }
      float lf[16], bc[16], T0, T1, T2, T3;
      chunk_cumsum_raw(lfA, tq, kch, totl, lf, bc, T0, T1, T2, T3);
      const float R31 = T0 + T1, refx = tq < 2 ? T0 : R31 + T2;
#pragma unroll 1
      for (int rep_ = 0; rep_ < REP_FILL; ++rep_)
#pragma unroll
      for (int i = 0; i < 16; ++i) {
        const int tau = 16 * tq + i, pp = dir ? 63 - tau : tau;
        const float qv = bf2f((i & 1) ? qraw[i >> 1].y : qraw[i >> 1].x), kkv = 1.f - __expf(lf[i]), bi = bc[i];
        QBt[pp * 136 + kch] = f2bf(qv * __expf(bi));
        QXt[pp * 136 + kch] = f2bf(qv * __expf(fminf(bi - refx, 80.f)));
        KXt[pp * 136 + kch] = f2bf(kkv * __expf(fminf(refx - bi, 80.f)));
        YTt[pp * 136 + kch] = tq < 2 ? f2bf(kkv * __expf(R31 - bi)) : f2bf(qv * __expf(bi - R31));
      }
      if (dir == 0) {
#pragma unroll
        for (int j = 0; j < 8; ++j) { VTt[(cgv * 16 + j) * 72 + ppv] = (bf16_t)((j & 1) ? (vw0[j >> 1] >> 16) : (vw0[j >> 1] & 0xffffu)); VTt[(cgv * 16 + 8 + j) * 72 + ppv] = (bf16_t)((j & 1) ? (vw1[j >> 1] >> 16) : (vw1[j >> 1] & 0xffffu)); }
      }
      __syncthreads();
#pragma unroll
      for (int ks = 0; ks < 8; ++ks) {
        const bf16x8 a = *(const LAS3 bf16x8*)(QBt + (32 * ti + r32) * 136 + ks * 16 + hi * 8);
        o = __builtin_amdgcn_mfma_f32_32x32x16_bf16(a, sfr[ks], o, 0, 0, 0);
      }
      if (wid < 4) {
        const int I = wid >> 1, J = wid & 1;
        const bool diag = (I == J), offd = dir ? (I == 0 && J == 1) : (I == 1 && J == 0);
        f32x16 acc = {};
        if (diag || offd) {
          const LAS3 bf16_t* Ap = diag ? QXt : YTt; const LAS3 bf16_t* Bp = diag ? KXt : YTt;
#pragma unroll
          for (int ks = 0; ks < 8; ++ks) {
            const bf16x8 a = *(const LAS3 bf16x8*)(Ap + (32 * I + r32) * 136 + ks * 16 + hi * 8);
            const bf16x8 bq = *(const LAS3 bf16x8*)(Bp + (32 * J + r32) * 136 + ks * 16 + hi * 8);
            acc = __builtin_amdgcn_mfma_f32_32x32x16_bf16(a, bq, acc, 0, 0, 0);
          }
        }
#pragma unroll
        for (int r = 0; r < 16; ++r) { const int t = (r & 3) + 8 * (r >> 2) + 4 * hi;
          const bool keep = !diag || (dir ? (r32 >= t) : (r32 <= t));
          ATt[(32 * I + t) * 72 + 32 * J + r32] = f2bf(keep ? acc[r] : 0.f); }
      }
      __syncthreads();
#pragma unroll
      for (int ks = 0; ks < 4; ++ks) {
        const bf16x8 a = *(const LAS3 bf16x8*)(ATt + (32 * ti + r32) * 72 + ks * 16 + hi * 8);
        const bf16x8 bq = *(const LAS3 bf16x8*)(VTt + (32 * tj + r32) * 72 + ks * 16 + hi * 8);
        o = __builtin_amdgcn_mfma_f32_32x32x16_bf16(a, bq, o, 0, 0, 0);
      }
      if (dir == 0 || it + GS < 2176) { RAW_WAIT16(lfN); RAW_WAIT16(qN); pack2(lfN, lfA); pack2(qN, qraw); }
    }
#pragma unroll
    for (int r = 0; r < 16; ++r) OT[(32 * ti + (r & 3) + 8 * (r >> 2) + 4 * hi) * 132 + 32 * tj + r32] = o[r];
    __syncthreads();
    {
      const int pp = tid >> 3, seg = tid & 7, row = rowbase + pp;
      float ov[16]; float ss = 0.f;
#pragma unroll
      for (int q = 0; q < 4; ++q) { const f32x4 v4 = *(const LAS3 f32x4*)(OT + pp * 132 + seg * 16 + q * 4); ov[q * 4] = v4[0]; ov[q * 4 + 1] = v4[1]; ov[q * 4 + 2] = v4[2]; ov[q * 4 + 3] = v4[3];
        ss += v4[0] * v4[0] + v4[1] * v4[1] + v4[2] * v4[2] + v4[3] * v4[3]; }
      ss += __shfl_xor(ss, 1); ss += __shfl_xor(ss, 2); ss += __shfl_xor(ss, 4);
      const float rs = rsqrtf(ss * (1.f / 128.f) + EPS);
      const u32x4 g0 = *(const GA u32x4*)(G + (size_t)row * 512 + h * 128 + seg * 16), g1 = *(const GA u32x4*)(G + (size_t)row * 512 + h * 128 + seg * 16 + 8);
      float y[16];
#pragma unroll
      for (int j = 0; j < 8; ++j) { y[j] = ov[j] * rs * gn[h * 128 + seg * 16 + j] * silu_f(UNPK(g0, j)); y[8 + j] = ov[8 + j] * rs * gn[h * 128 + seg * 16 + 8 + j] * silu_f(UNPK(g1, j)); }
      u32x4 w0, w1;
      w0.x = cvt_pk_bf16(y[0], y[1]); w0.y = cvt_pk_bf16(y[2], y[3]); w0.z = cvt_pk_bf16(y[4], y[5]); w0.w = cvt_pk_bf16(y[6], y[7]);
      w1.x = cvt_pk_bf16(y[8], y[9]); w1.y = cvt_pk_bf16(y[10], y[11]); w1.z = cvt_pk_bf16(y[12], y[13]); w1.w = cvt_pk_bf16(y[14], y[15]);
      GA bf16_t* dst = MIX + (size_t)row * 1024 + 512 + h * 128 + seg * 16;
      *(GA u32x4*)dst = w0; *(GA u32x4*)(dst + 8) = w1;
    }
    __syncthreads();
  }
}

__device__ __forceinline__ void ph_normrope(const P& p, int o) {
  const int tid = tid_(), wave = tid >> 6, lane = tid & 63;
  GA bf16_t* QB = (GA bf16_t*)(p.ws + OFF_QB); GA bf16_t* KB = (GA bf16_t*)(p.ws + OFF_KB);
  const GA float* ROPE = (const GA float*)(p.ws + OFF_ROPE);
  const float gq0 = p.qn_g[o * 128 + lane * 2], gq1 = p.qn_g[o * 128 + lane * 2 + 1], gk0 = p.kn_g[o * 128 + lane * 2], gk1 = p.kn_g[o * 128 + lane * 2 + 1];
  for (int row = bid_() * 8 + wave; row < NTOK; row += gridDim.x * 8) {
    GA bf16_t* qp = QB + (size_t)row * 1024 + lane * 2; GA bf16_t* kp = KB + (size_t)kvrow(row) * 256 + lane * 2;
    unsigned w[10];
#pragma unroll
    for (int s_ = 0; s_ < 8; ++s_) w[s_] = *(const GA unsigned*)(qp + s_ * 128);
    w[8] = *(const GA unsigned*)kp; w[9] = *(const GA unsigned*)(kp + 128);
    float cs = 1.f, sn = 0.f;
    if (row < NLAT) { const int t = row & 4095; const int pos = lane < 32 ? (t >> 6) : (t & 63); const GA float* cs2 = ROPE + 2 * (pos * 32 + (lane & 31)); cs = cs2[0]; sn = cs2[1]; }
#pragma unroll
    for (int s_ = 0; s_ < 10; ++s_) {
      const float x0 = bflo(w[s_]), x1 = bfhi(w[s_]);
      const float ss = wave_sum(x0 * x0 + x1 * x1);
      const float rs = rsqrtf(ss * (1.f / 128.f) + EPS);
      const float y0 = x0 * rs * (s_ < 8 ? gq0 : gk0), y1 = x1 * rs * (s_ < 8 ? gq1 : gk1);
      const unsigned ow = cvt_pk_bf16(y0 * cs - y1 * sn, y0 * sn + y1 * cs);
      if (s_ < 8) *(GA unsigned*)(qp + s_ * 128) = ow; else *(GA unsigned*)(kp + (s_ - 8) * 128) = ow;
    }
  }
}

__device__ __forceinline__ void ph_attn(const P& p, bool last, unsigned char* lds) {
  const bf16_t* QB = (const bf16_t*)(p.ws + OFF_QB); const bf16_t* KB = (const bf16_t*)(p.ws + OFF_KB); const bf16_t* VB = (const bf16_t*)(p.ws + OFF_VB);
  bf16_t* MIX = (bf16_t*)(p.ws + OFF_MIX);
#pragma unroll 1
  for (int r = 0; r < (last ? 4 : 5); ++r) {
    const int w = bid_(), bb = w & 7, jj = w >> 3;
    size_t qoff, koff; int seq;
    if (r < 4) { const int idx = r * 32 + jj, h = idx >> 4, qb = idx & 15; qoff = (size_t)(bb * 4096 + qb * 256) * 1024 + h * 128; koff = (size_t)bb * 4352 * 256 + (h >> 2) * 128; seq = 4352; }
    else { if (jj >= 8) break; const int h = jj; qoff = (size_t)(NLAT + bb * 256) * 1024 + h * 128; koff = ((size_t)bb * 4352 + 4096) * 256 + (h >> 2) * 128; seq = 256; }
    att::attn_dense_body(QB + qoff, KB + koff, VB + koff, MIX + qoff, seq, (char*)lds);
    __syncthreads();
  }
}

__device__ __forceinline__ void ph_conv(const P& p, int l, bool last) {
  const bf16_t* GATE = (const bf16_t*)(p.ws + OFF_GATE); bf16_t* VAL = (bf16_t*)(p.ws + OFF_VAL);
  const float* cw = p.conv_w + (size_t)l * 9 * 2816; const float* cb = p.conv_b + (size_t)l * 2816;
  const int gsz = gridDim.x * 512, gtid = bid_() * 512 + tid_();
  const u32x4 Z4 = {0u, 0u, 0u, 0u};
  for (int it = gtid; it < 2 * 8 * 64 * 352; it += gsz) {
    const int cg8 = it % 352; int rest = it / 352; const int col = rest & 63; rest >>= 6; const int b = rest & 7, seg = rest >> 3;
    const int c0 = cg8 * 8;
    float w[9][8], bias[8];
#pragma unroll
    for (int k = 0; k < 9; ++k) { const f32x4 a = *(const f32x4*)(cw + k * 2816 + c0), bq = *(const f32x4*)(cw + k * 2816 + c0 + 4);
      w[k][0] = a[0]; w[k][1] = a[1]; w[k][2] = a[2]; w[k][3] = a[3]; w[k][4] = bq[0]; w[k][5] = bq[1]; w[k][6] = bq[2]; w[k][7] = bq[3]; }
    { const f32x4 a = *(const f32x4*)(cb + c0), bq = *(const f32x4*)(cb + c0 + 4); bias[0] = a[0]; bias[1] = a[1]; bias[2] = a[2]; bias[3] = a[3]; bias[4] = bq[0]; bias[5] = bq[1]; bias[6] = bq[2]; bias[7] = bq[3]; }
    const size_t tb = (size_t)b * 4096;
#define LD3(r, A, Mi, C) do { if ((r) < 0 || (r) > 63) { A = Z4; Mi = Z4; C = Z4; } else { const bf16_t* q_ = GATE + (tb + (r) * 64 + col) * 2816 + c0; \
      Mi = *(const u32x4*)q_; A = col > 0 ? *(const u32x4*)(q_ - 2816) : Z4; C = col < 63 ? *(const u32x4*)(q_ + 2816) : Z4; } } while (0)
    u32x4 p0, p1, p2, q0, q1, q2, n0, n1, n2;
    const int r0 = seg * 32;
    LD3(r0 - 1, p0, p1, p2); LD3(r0, q0, q1, q2);
    for (int r = r0; r < r0 + 32; ++r) {
      LD3(r + 1, n0, n1, n2);
      bf16_t* vp = VAL + (tb + r * 64 + col) * 2816 + c0;
      const u32x4 vv = *(const u32x4*)vp;
      float a[8];
#pragma unroll
      for (int j = 0; j < 8; ++j) {
        float s = bias[j];
        s += w[0][j] * UNPK(p0, j) + w[1][j] * UNPK(p1, j) + w[2][j] * UNPK(p2, j);
        s += w[3][j] * UNPK(q0, j) + w[4][j] * UNPK(q1, j) + w[5][j] * UNPK(q2, j);
        s += w[6][j] * UNPK(n0, j) + w[7][j] * UNPK(n1, j) + w[8][j] * UNPK(n2, j);
        a[j] = silu_f(s) * UNPK(vv, j);
      }
      u32x4 ow; ow.x = cvt_pk_bf16(a[0], a[1]); ow.y = cvt_pk_bf16(a[2], a[3]); ow.z = cvt_pk_bf16(a[4], a[5]); ow.w = cvt_pk_bf16(a[6], a[7]);
      *(u32x4*)vp = ow;
      p0 = q0; p1 = q1; p2 = q2; q0 = n0; q1 = n1; q2 = n2;
    }
#undef LD3
  }
  if (!last) {
    for (int it = gtid; it < 8 * 32 * 352; it += gsz) {
      const int cg8 = it % 352, rest = it / 352, seg = rest & 31, b = rest >> 5, c0 = cg8 * 8, j0 = seg * 8;
      float w3[3][8], bias[8];
#pragma unroll
      for (int k = 0; k < 3; ++k) { const f32x4 wa = *(const f32x4*)(cw + (3 + k) * 2816 + c0), wb = *(const f32x4*)(cw + (3 + k) * 2816 + c0 + 4);
        w3[k][0] = wa[0]; w3[k][1] = wa[1]; w3[k][2] = wa[2]; w3[k][3] = wa[3]; w3[k][4] = wb[0]; w3[k][5] = wb[1]; w3[k][6] = wb[2]; w3[k][7] = wb[3]; }
      { const f32x4 wa = *(const f32x4*)(cb + c0), wb = *(const f32x4*)(cb + c0 + 4); bias[0] = wa[0]; bias[1] = wa[1]; bias[2] = wa[2]; bias[3] = wa[3]; bias[4] = wb[0]; bias[5] = wb[1]; bias[6] = wb[2]; bias[7] = wb[3]; }
      const size_t row0 = (size_t)NLAT + b * 256 + j0;
      const bf16_t* gq = GATE + row0 * 2816 + c0; bf16_t* vq = VAL + row0 * 2816 + c0;
      u32x4 g[10], vv[8];
#pragma unroll
      for (int i = 0; i < 10; ++i) { const int j = j0 - 1 + i; g[i] = (j >= 0 && j <= 255) ? *(const u32x4*)(gq + (ptrdiff_t)(i - 1) * 2816) : Z4; }
#pragma unroll
      for (int i = 0; i < 8; ++i) vv[i] = *(const u32x4*)(vq + (size_t)i * 2816);
#pragma unroll
      for (int i = 0; i < 8; ++i) {
        float a[8];
#pragma unroll
        for (int j = 0; j < 8; ++j) {
          const float sacc = bias[j] + w3[0][j] * UNPK(g[i], j) + w3[1][j] * UNPK(g[i + 1], j) + w3[2][j] * UNPK(g[i + 2], j);
          a[j] = silu_f(sacc) * UNPK(vv[i], j);
        }
        u32x4 ow; ow.x = cvt_pk_bf16(a[0], a[1]); ow.y = cvt_pk_bf16(a[2], a[3]); ow.z = cvt_pk_bf16(a[4], a[5]); ow.w = cvt_pk_bf16(a[6], a[7]);
        *(u32x4*)(vq + (size_t)i * 2816) = ow;
      }
    }
  }
}

__device__ __forceinline__ void ph_final(const P& p) {
  const int tid = tid_(), wave = tid >> 6, lane = tid & 63;
  f32x4 g4[4];
#pragma unroll
  for (int j = 0; j < 4; ++j) g4[j] = *(const GA f32x4*)((const GA float*)p.fn_g + j * 256 + lane * 4);
  for (int row = bid_() * 16 + wave; row < NLAT; row += gridDim.x * 16) {
    GA float* src = (GA float*)(p.out + (size_t)row * 1024);
    f32x4 v[2][4]; float ss0 = 0.f, ss1 = 0.f;
#pragma unroll
    for (int j = 0; j < 4; ++j) { v[0][j] = *(const GA f32x4*)(src + j * 256 + lane * 4); v[1][j] = *(const GA f32x4*)(src + 8 * 1024 + j * 256 + lane * 4); }
#pragma unroll
    for (int j = 0; j < 4; ++j) { ss0 += v[0][j][0] * v[0][j][0] + v[0][j][1] * v[0][j][1] + v[0][j][2] * v[0][j][2] + v[0][j][3] * v[0][j][3];
      ss1 += v[1][j][0] * v[1][j][0] + v[1][j][1] * v[1][j][1] + v[1][j][2] * v[1][j][2] + v[1][j][3] * v[1][j][3]; }
    ss0 = wave_sum(ss0); ss1 = wave_sum(ss1);
    const float rs0 = rsqrtf(ss0 * (1.f / 1024.f) + EPS), rs1 = rsqrtf(ss1 * (1.f / 1024.f) + EPS);
#pragma unroll
    for (int j = 0; j < 4; ++j) { f32x4 o0, o1; for (int q = 0; q < 4; ++q) { o0[q] = v[0][j][q] * rs0 * g4[j][q]; o1[q] = v[1][j][q] * rs1 * g4[j][q]; }
      *(GA f32x4*)(src + j * 256 + lane * 4) = o0; *(GA f32x4*)(src + 8 * 1024 + j * 256 + lane * 4) = o1; }
  }
}

__device__ __forceinline__ void run_phase(const P& p_in, int l, int ph, unsigned char* lds) {
  const bool even = !(l & 1), last = (l == 3); const int e = l >> 1;
  P p = p_in; asm volatile("" : "+s"(p.ws), "+s"(p.out));
  unsigned char* ws = p.ws;
  const float* MOD = (const float*)(ws + OFF_MOD);
  bf16_t* HB = (bf16_t*)(ws + OFF_HB); bf16_t* MIX = (bf16_t*)(ws + OFF_MIX);
  bf16_t* W1 = (bf16_t*)(ws + OFF_W1); bf16_t* W2 = (bf16_t*)(ws + OFF_W2); bf16_t* W3 = (bf16_t*)(ws + OFF_W3); bf16_t* W4 = (bf16_t*)(ws + OFF_W4);
  const int Mres = last ? NLAT : NTOK;
  if (ph == 0) {
    modulate_rows(p, l, 0, NTOK, l == 0, l > 0 ? (const float*)(ws + OFF_GATE) : nullptr, MOD + (size_t)((l > 0 ? l - 1 : 0) * 9 + 8) * 6144 + 5120);
    if (l == 0) { convert_weights(p, 0, lds, bid_(), (int)gridDim.x); fold_dft(p, 0, lds, bid_(), (int)gridDim.x); }
    if (even) gen_cm(p, lds);
  } else if (ph == 7) {
    EpiRes E{p.out, (float*)(ws + OFF_CTXR), MOD + (size_t)l * 9 * 6144 + 2048, l == 0 ? p.x : (const float*)p.out};
    run_gemm(lds, MIX, W2, NLAT, 1024, 1024, E);
    if (!last) { EpiPart Ep{(float*)(ws + OFF_MX), 512}; run_gemm_splitk(lds, MIX + (size_t)NLAT * 1024, W2, NCTX, 1024, 1024, 2, Ep); }
  } else if (ph == 8) {
    modulate_rows(p, l, 1, Mres, false, (const float*)(ws + OFF_MX), MOD + (size_t)(l * 9 + 8) * 6144 + 2048);
  } else if (ph == 9) {
    EpiUp E{(bf16_t*)(ws + OFF_GATE), (bf16_t*)(ws + OFF_VAL)};
    run_gemm(lds, HB, W3, Mres, 5632, 1024, E);
    if (!last) {
      __syncthreads();
      convert_weights(p, l + 1, lds, (int)bid_() - 176, (int)gridDim.x - 176, 0, 2);
    }
  } else if (ph == 10) {
    ph_conv(p, l, last);
  } else if (ph == 11) {
    EpiRes E{p.out, (float*)(ws + OFF_CTXR), MOD + (size_t)l * 9 * 6144 + 5120, (const float*)p.out};
    run_gemm(lds, (const bf16_t*)(ws + OFF_VAL), (const bf16_t*)(ws + ((l & 1) ? OFF_W4B : OFF_W4)), NLAT, 1024, 2816, E);
    if (!last) { EpiPart Ep{(float*)(ws + OFF_GATE), 1408}; run_gemm_splitk(lds, (const bf16_t*)(ws + OFF_VAL) + (size_t)NLAT * 2816, (const bf16_t*)(ws + ((l & 1) ? OFF_W4B : OFF_W4)), NCTX, 1024, 2816, 2, Ep); }
    if (!last) {
      const int wg = (int)bid_() - 64, nwg = (int)gridDim.x - 64;
      __syncthreads();
      convert_weights(p, l + 1, lds, wg, nwg, 2, 4);
      if (l & 1) fold_dft(p, (l + 1) >> 1, lds, wg, nwg);
    }
  } else if (even) {
    if (ph == 1) { EpiAB E{EpiZ{(bf16_t*)(ws + OFF_ZT), (bf16_t*)(ws + OFF_ZTC)},
                           EpiHG{(bf16_t*)(ws + OFF_Q), (bf16_t*)(ws + OFF_V), (bf16_t*)(ws + OFF_G), (_Float16*)(ws + OFF_LF0), (_Float16*)(ws + OFF_LF1), (const float*)(ws + OFF_LB) + e * 1024}};
      run_gemm(lds, HB, W1, NTOK, 3584, 1024, E);
      if (l == 0) { __syncthreads(); mod_gemv(p, lds, 1, 4, (int)bid_() - 112, (int)gridDim.x - 112); } }
    else if (ph == 12) ph_fold(p, lds);
    else if (ph == 2) {
      { EpiDFT E{MIX, 0}; run_gemm(lds, (const bf16_t*)(ws + OFF_CM2), (const bf16_t*)(ws + OFF_ZF), 4096, 4096, 4096, E); }
      { EpiDFT E{MIX, 1}; run_gemm(lds, (const bf16_t*)(ws + OFF_CM256), (const bf16_t*)(ws + OFF_ZTC), 256, 4096, 512, E); }
    }
    else if (ph == 4) ph_h1(p, lds);
    else if (ph == 5) ph_h2(p);
    else if (ph == 6) ph_h3(p, e, lds);
  } else {
    if (ph == 1) { EpiQKV E{(bf16_t*)(ws + OFF_QB), (bf16_t*)(ws + OFF_KB), (bf16_t*)(ws + OFF_VB)}; run_gemm(lds, HB, W1, NTOK, 1536, 1024, E); }
    else if (ph == 2) ph_normrope(p, e);
    else if (ph == 3) ph_attn(p, last, lds);
  }
}

#if MULTI
__global__ void __launch_bounds__(512, 2) k_phase(P p, int l, int ph) {
  extern __shared__ __attribute__((aligned(16))) unsigned char lds[];
  if (l < 0) ph0(p, lds); else if (l >= 4) ph_final(p); else run_phase(p, l, ph, lds);
}
#else
__global__ void __launch_bounds__(512, 2) k_mega(P p) {
  extern __shared__ __attribute__((aligned(16))) unsigned char lds[];
  cg::grid_group grid = cg::this_grid();
  volatile LAS3 unsigned* st = (volatile LAS3 unsigned*)((LAS3 unsigned char*)lds + 131072);
  if (threadIdx.x == 0) { st[0] = 0u; st[1] = 0u; st[2] = 0u; st[3] = 0u; }
  __syncthreads();
  XcdBarrier bar = xcd_barrier_post((unsigned*)(p.ws + OFF_BAR), st);
  grid.sync();
  ph0(p, lds); xcd_barrier(bar);
#pragma unroll 1
  for (int l = 0; l < 4; ++l) {
#pragma unroll 1
    for (int sq = 0; sq <= 12; ++sq) {
      const int ph = sq < 2 ? sq : (sq == 2 ? 12 : sq - 1);
      if ((l & 1) ? ((ph >= 4 && ph <= 6) || ph == 12) : (ph == 3)) continue;
      run_phase(p, l, ph, lds);
      xcd_barrier(bar);
#if REP_MASK != 0
      if (((REP_MASK >> ph) & 1) && !(ph == 2 && (l & 1))) { run_phase(p, l, ph, lds); xcd_barrier(bar); }
#endif
    }
  }
  ph_final(p);
}
#endif

constexpr int LDS_BYTES = 131072 + 16;
extern "C" void kernel_launch(void* const* d_in, const int* in_sizes, int n_in, void* d_out, int out_size, void* d_ws, size_t ws_size, hipStream_t stream) {
  static int ok = 0;
  if (!ok) {
    if (n_in != 19 || ws_size < WS_END) { fprintf(stderr, "kernel_launch: unexpected n_in %d / ws %zu (need %zu)\n", n_in, ws_size, (size_t)WS_END); return; }
#if MULTI
    if (hipFuncSetAttribute((const void*)k_phase, hipFuncAttributeMaxDynamicSharedMemorySize, LDS_BYTES) != hipSuccess) { fprintf(stderr, "hipFuncSetAttribute failed\n"); return; }
#else
    if (hipFuncSetAttribute((const void*)k_mega, hipFuncAttributeMaxDynamicSharedMemorySize, LDS_BYTES) != hipSuccess) { fprintf(stderr, "hipFuncSetAttribute failed\n"); return; }
#endif
    ok = 1;
  }
  P p{};
  p.x = (const float*)d_in[0]; p.c = (const float*)d_in[1]; p.ctx = (const float*)d_in[2]; p.c_ctx = (const float*)d_in[3]; p.w_mod = (const float*)d_in[4]; p.b_mod = (const float*)d_in[5];
  p.w_in_ab = (const float*)d_in[6]; p.w_out_ab = (const float*)d_in[7]; p.hg_lb = (const float*)d_in[8]; p.hg_ng = (const float*)d_in[9]; p.w_qkv = (const float*)d_in[10];
  p.qn_g = (const float*)d_in[11]; p.kn_g = (const float*)d_in[12]; p.w_out_att = (const float*)d_in[13]; p.w_up = (const float*)d_in[14]; p.conv_w = (const float*)d_in[15];
  p.conv_b = (const float*)d_in[16]; p.w_down = (const float*)d_in[17]; p.fn_g = (const float*)d_in[18];
  p.out = (float*)d_out; p.ws = (unsigned char*)d_ws;
#if MULTI
  hipLaunchKernelGGL(k_phase, dim3(256), dim3(512), LDS_BYTES, stream, p, -1, 0);
  for (int l = 0; l < 4; ++l) for (int ph = 0; ph <= 11; ++ph) { if ((l & 1) && (ph >= 4 && ph <= 6)) continue; hipLaunchKernelGGL(k_phase, dim3(256), dim3(512), LDS_BYTES, stream, p, l, ph); }
  hipLaunchKernelGGL(k_phase, dim3(256), dim3(512), LDS_BYTES, stream, p, 4, 0);
#else
  if (hipMemsetAsync((char*)d_ws + OFF_BAR, 0, 16384, stream) != hipSuccess) { fprintf(stderr, "memset failed\n"); return; }
  void* args[] = {&p};
  hipError_t e = hipLaunchCooperativeKernel((const void*)k_mega, dim3(256), dim3(512), args, LDS_BYTES, stream);
  if (e != hipSuccess) fprintf(stderr, "cooperative launch failed: %s\n", hipGetErrorString(e));
#endif
}
```
